# Optimizing an MI355X kernel written in HIP

```python
import jax, jax.numpy as jnp
from jax import lax
import numpy as np

D_MODEL = 2048
BATCH = 2
SEQ = 4096
DEPTH = 1
DEC_BATCH = 8
DEC_SEQ = 1
PAST_LEN = 16384
PAGE_SIZE = 128

HEAD_DIM = 64
D_RWKV = D_MODEL // 2
D_ATT = D_MODEL - D_RWKV
D_MIX = D_RWKV + D_ATT
N_RWKV_HEADS = D_RWKV // HEAD_DIM
N_ATT_HEADS = D_ATT // HEAD_DIM
LORA_W = 96
LORA_A = 96
SHIFT_W = 3 * D_RWKV + LORA_W + LORA_A
D_IN = SHIFT_W + D_RWKV + 4 * D_ATT
DIL_PATTERNS = ((128, 1), (512, 4), (2048, 16))
WIN_MAX = max(w for w, _ in DIL_PATTERNS)
BLK = 128
RMS_EPS = 1e-6
GN_EPS = 64e-5
L2_EPS = 1e-12

kernel_name = 'rwkv7_dilated_swa_parallel_heads_step'


def rms_norm(x, g, eps=RMS_EPS):
    x32 = x.astype(jnp.float32)
    return x32 * lax.rsqrt(jnp.mean(x32 * x32, axis=-1, keepdims=True) + eps) * g.astype(jnp.float32)


def alibi_slopes(n_heads):
    return 2.0 ** (-8.0 * jnp.arange(1, n_heads + 1, dtype=jnp.float32) / n_heads)


def wkv7_scan(S0, r, decay, k, v, a_vec, b_vec):
    def step(S, inp):
        r_t, w_t, k_t, v_t, a_t, b_t = inp
        sa = jnp.einsum('bhij,bhj->bhi', S, a_t)
        S = S * w_t[:, :, None, :] + sa[..., None] * b_t[:, :, None, :] + v_t[..., None] * k_t[:, :, None, :]
        y_t = jnp.einsum('bhij,bhj->bhi', S, r_t)
        return S, y_t
    xs = tuple(jnp.swapaxes(t, 0, 1) for t in (r, decay, k, v, a_vec, b_vec))
    S_T, ys = lax.scan(step, S0, xs)
    return S_T, jnp.swapaxes(ys, 0, 1)


def rwkv7_branch(zs_mix, g_r, S0, w0, w_up, a0, a_up, k_k, k_a, r_k, gn_w, gn_b):
    B, T, _ = zs_mix.shape
    heads = lambda t: t.reshape(B, T, N_RWKV_HEADS, HEAD_DIM)
    r = zs_mix[..., 0:D_RWKV]
    k = zs_mix[..., D_RWKV:2 * D_RWKV]
    v = zs_mix[..., 2 * D_RWKV:3 * D_RWKV]
    wd = zs_mix[..., 3 * D_RWKV:3 * D_RWKV + LORA_W]
    ad = zs_mix[..., 3 * D_RWKV + LORA_W:SHIFT_W]
    w_raw = w0 + jnp.tanh(wd) @ w_up.astype(jnp.float32)
    decay = jnp.exp(-jnp.exp(-jax.nn.softplus(-w_raw) - 0.5))
    a = jax.nn.sigmoid(a0 + ad @ a_up.astype(jnp.float32))
    kk = heads(k * k_k)
    kk = kk / jnp.maximum(jnp.sqrt(jnp.sum(kk * kk, axis=-1, keepdims=True)), L2_EPS)
    k = k * (1.0 + (a - 1.0) * k_a)
    rh, kh, vh, ah = heads(r), heads(k), heads(v), heads(a)
    S_T, y = wkv7_scan(S0, rh, heads(decay), kh, vh, -kk, kk * ah)
    mean = jnp.mean(y, axis=-1, keepdims=True)
    var = jnp.mean(jnp.square(y - mean), axis=-1, keepdims=True)
    y = ((y - mean) * lax.rsqrt(var + GN_EPS)).reshape(B, T, D_RWKV) * gn_w + gn_b
    y = y + (jnp.sum(rh * kh * r_k, axis=-1, keepdims=True) * vh).reshape(B, T, D_RWKV)
    return y * jax.nn.silu(g_r), S_T


def dilated_band_attention(q, k, v, slopes, window, dil):
    B, T, H, D = q.shape
    n_back = window // dil
    L = -(-T // dil)
    nb = -(-L // BLK)
    pad = nb * BLK * dil - T
    blockify = lambda t: jnp.pad(t, ((0, 0), (0, pad), (0, 0), (0, 0))).reshape(B, nb, BLK, dil, H, D)
    with_prev = lambda t: jnp.concatenate(
        [jnp.pad(t, ((0, 0), (1, 0), (0, 0), (0, 0), (0, 0), (0, 0)))[:, :-1], t], axis=2)
    qb = blockify(q)
    kc = with_prev(blockify(k))
    vc = with_prev(blockify(v))
    qi = jnp.arange(BLK)[:, None]
    kj = jnp.arange(2 * BLK)[None, :]
    off = BLK + qi - kj
    valid = ((off >= 0) & (off <= n_back))[None] & ((jnp.arange(nb)[:, None, None] > 0) | (kj[None] >= BLK))
    bias = -slopes[:, None, None] * (off * dil).astype(jnp.float32)[None]
    s = jnp.einsum('bnqrhd,bnkrhd->bnrhqk', qb, kc) + bias[None, None, None]
    s = jnp.where(valid[None, :, None, None], s, -jnp.inf)
    lse = jax.nn.logsumexp(s, axis=-1)
    p = jnp.exp(s - lse[..., None])
    o = jnp.einsum('bnrhqk,bnkrhd->bnqrhd', p, vc).reshape(B, nb * BLK * dil, H, D)[:, :T]
    lse = jnp.transpose(lse, (0, 1, 4, 2, 3)).reshape(B, nb * BLK * dil, H)[:, :T]
    return o, lse


def dilated_gather_attention(q, k_ext, v_ext, slopes, window, dil, buf):
    S = q.shape[1]
    n_keys = window // dil + 1
    offs = jnp.arange(n_keys) * dil
    idx = buf + jnp.arange(S)[:, None] - offs[None, :]
    valid = idx >= 0
    idx = jnp.maximum(idx, 0)
    kg = k_ext[:, idx]
    vg = v_ext[:, idx]
    s = jnp.einsum('bshd,bsjhd->bshj', q, kg) - slopes[None, None, :, None] * offs.astype(jnp.float32)[None, None, None, :]
    s = jnp.where(valid[None, :, None, :], s, -jnp.inf)
    lse = jax.nn.logsumexp(s, axis=-1)
    p = jnp.exp(s - lse[..., None])
    return jnp.einsum('bshj,bsjhd->bshd', p, vg), lse


def mixer_layer(x, shift_prev, S0, k_past, v_past, norm_w, w_in, mu_shift, w0, w_up, a0, a_up,
                k_k, k_a, r_k, gn_w, gn_b, q_norm, k_norm, w_out):
    B, T, _ = x.shape
    xn = rms_norm(x, norm_w).astype(w_in.dtype)
    z = jnp.einsum('btd,de->bte', xn, w_in).astype(jnp.float32)
    zs = z[..., :SHIFT_W]
    zs_prev = jnp.concatenate([shift_prev.astype(jnp.float32)[:, None], zs[:, :-1]], axis=1)
    zs_mix = zs + mu_shift.astype(jnp.float32) * (zs_prev - zs)
    o0 = SHIFT_W
    g_r = z[..., o0:o0 + D_RWKV]
    o0 += D_RWKV
    q = z[..., o0:o0 + D_ATT].reshape(B, T, N_ATT_HEADS, HEAD_DIM)
    ka = z[..., o0 + D_ATT:o0 + 2 * D_ATT].reshape(B, T, N_ATT_HEADS, HEAD_DIM)
    va = z[..., o0 + 2 * D_ATT:o0 + 3 * D_ATT].reshape(B, T, N_ATT_HEADS, HEAD_DIM)
    g_a = z[..., o0 + 3 * D_ATT:o0 + 4 * D_ATT]

    y_r, S_T = rwkv7_branch(zs_mix, g_r, S0, w0, w_up, a0, a_up, k_k, k_a, r_k, gn_w, gn_b)

    qn = rms_norm(q, q_norm) * (HEAD_DIM ** -0.5)
    kn = rms_norm(ka, k_norm)
    slopes = alibi_slopes(N_ATT_HEADS)
    if k_past is None:
        outs = [dilated_band_attention(qn, kn, va, slopes, w, d) for w, d in DIL_PATTERNS]
        keep = min(WIN_MAX, T)
        k_rows, v_rows = kn[:, T - keep:], va[:, T - keep:]
    else:
        buf = k_past.shape[1]
        k_ext = jnp.concatenate([k_past.astype(jnp.float32), kn], axis=1)
        v_ext = jnp.concatenate([v_past.astype(jnp.float32), va], axis=1)
        outs = [dilated_gather_attention(qn, k_ext, v_ext, slopes, w, d, buf) for w, d in DIL_PATTERNS]
        k_rows, v_rows = kn, va
    o_stack = jnp.stack([o for o, _ in outs])
    lse_stack = jnp.stack([l for _, l in outs])
    mix_w = jax.nn.softmax(lse_stack, axis=0)
    o_att = jnp.sum(mix_w[..., None] * o_stack, axis=0).reshape(B, T, D_ATT) * jax.nn.silu(g_a)

    mix = jnp.concatenate([y_r, o_att], axis=-1).astype(w_out.dtype)
    y = x + jnp.einsum('bte,ed->btd', mix, w_out).astype(x.dtype)
    return y, S_T, zs[:, -1], k_rows, v_rows


def setup_inputs(seed: int = 0) -> dict:
    key = jax.random.key(seed)
    ks = jax.random.split(key, 24)
    f32 = jnp.float32
    buf = min(WIN_MAX, PAST_LEN)
    nrm = lambda k, shape, s: s * jax.random.normal(k, shape, f32)
    return {
        'x_prompt': nrm(ks[0], (BATCH, SEQ, D_MODEL), 1.0),
        'x_sample': nrm(ks[1], (DEC_BATCH, DEC_SEQ, D_MODEL), 1.0),
        'state_wkv': nrm(ks[2], (DEC_BATCH, N_RWKV_HEADS, HEAD_DIM, HEAD_DIM), 0.3),
        'state_shift': nrm(ks[3], (DEC_BATCH, SHIFT_W), 1.0),
        'cache_k_win': nrm(ks[4], (DEC_BATCH, buf, N_ATT_HEADS, HEAD_DIM), 1.0),
        'cache_v_win': nrm(ks[5], (DEC_BATCH, buf, N_ATT_HEADS, HEAD_DIM), 1.0),
        'norm_w': 1.0 + nrm(ks[6], (D_MODEL,), 0.05),
        'w_in': nrm(ks[7], (D_MODEL, D_IN), D_MODEL ** -0.5),
        'mu_shift': jax.random.uniform(ks[8], (SHIFT_W,), f32, 0.0, 1.0),
        'w0': jax.random.uniform(ks[9], (D_RWKV,), f32, -2.5, 0.5),
        'w_up': nrm(ks[10], (LORA_W, D_RWKV), 0.5 * LORA_W ** -0.5),
        'a0': nrm(ks[11], (D_RWKV,), 0.5),
        'a_up': nrm(ks[12], (LORA_A, D_RWKV), 0.5 * LORA_A ** -0.5),
        'k_k': 0.85 + nrm(ks[13], (D_RWKV,), 0.05),
        'k_a': 1.0 + nrm(ks[14], (D_RWKV,), 0.05),
        'r_k': nrm(ks[15], (N_RWKV_HEADS, HEAD_DIM), 0.1),
        'gn_w': 1.0 + nrm(ks[16], (D_RWKV,), 0.05),
        'gn_b': nrm(ks[17], (D_RWKV,), 0.05),
        'q_norm': 1.0 + nrm(ks[18], (HEAD_DIM,), 0.05),
        'k_norm': 1.0 + nrm(ks[19], (HEAD_DIM,), 0.05),
        'w_out': nrm(ks[20], (D_MIX, D_MODEL), D_MIX ** -0.5),
    }


def reference(x_prompt, x_sample, state_wkv, state_shift, cache_k_win, cache_v_win,
              norm_w, w_in, mu_shift, w0, w_up, a0, a_up, k_k, k_a, r_k, gn_w, gn_b,
              q_norm, k_norm, w_out):
    weights = (norm_w, w_in, mu_shift, w0, w_up, a0, a_up, k_k, k_a, r_k, gn_w, gn_b, q_norm, k_norm, w_out)
    B = x_prompt.shape[0]
    shift0 = jnp.zeros((B, SHIFT_W), jnp.float32)
    S0 = jnp.zeros((B, N_RWKV_HEADS, HEAD_DIM, HEAD_DIM), jnp.float32)
    y_prompt, wkv_p, shift_p, k_p, v_p = mixer_layer(x_prompt, shift0, S0, None, None, *weights)
    y_sample, wkv_s, shift_s, k_s, v_s = mixer_layer(
        x_sample, state_shift, state_wkv.astype(jnp.float32), cache_k_win, cache_v_win, *weights)
    return (y_prompt, y_sample,
            wkv_p.astype(state_wkv.dtype), shift_p.astype(state_shift.dtype),
            k_p.astype(cache_k_win.dtype), v_p.astype(cache_v_win.dtype),
            wkv_s.astype(state_wkv.dtype), shift_s.astype(state_shift.dtype),
            k_s.astype(cache_k_win.dtype), v_s.astype(cache_v_win.dtype))
```

```cpp
#define PROBE_DUP 0
#include <hip/hip_runtime.h>
#include <hip/hip_cooperative_groups.h>
#include <cstdio>
#include <cstdint>
namespace cg = cooperative_groups;
namespace pg8 {
#define PG8_LAS __attribute__((address_space(3)))
typedef unsigned short bf16_t;
typedef short bf16x8 __attribute__((ext_vector_type(8)));
typedef float f32x4 __attribute__((ext_vector_type(4)));
typedef unsigned u32x4 __attribute__((ext_vector_type(4)));
constexpr int BM = 256, BK = 64, HALF = 128, HTB = HALF * BK * 2, STAGE_BYTES = 8 * HTB, NXCD = 8, WGM = 8;
__host__ __device__ __forceinline__ int lds_byte(int r, int c) { const int st = (r >> 4) * 2 + (c >> 5), rr = r & 15, cc = c & 31, ob = rr * 64 + cc * 2; return st * 1024 + (ob ^ (((ob >> 9) & 1) << 5)); }
__host__ __device__ __forceinline__ void stage_rc(int b, int& R, int& C) { const int st = b / 1024, sb = b % 1024, swz = sb ^ (((sb >> 9) & 1) << 5); R = (st >> 1) * 16 + swz / 64; C = (st & 1) * 32 + (swz % 64) / 2; }
__host__ __device__ __forceinline__ int perm32(int rho) { const int n = rho >> 4, i = rho & 15; return 8 * (i >> 2) + 4 * n + (i & 3); }

struct Unit { int pm, pn; };
struct Gemm { const bf16_t* A; const bf16_t* Bt; int M, N, K; };

struct StaticOrder {
    int nM, nN, nwg, G, c;
    __host__ __device__ void init(int M, int N, int G_, int c_) { nM = M / BM; nN = N / BM; nwg = nM * nN; G = G_; c = c_; }
    __host__ __device__ bool next(int i, Unit& u) const {
        const long L = (long)i * G + c; if (L >= nwg) return false;
        int wgid = (int)L; { const int q = nwg / NXCD, r = nwg % NXCD, xcd = wgid % NXCD, off = wgid / NXCD; wgid = (xcd < r ? xcd * (q + 1) : r * (q + 1) + (xcd - r) * q) + off; }
        const int nig = WGM * nN, gid = wgid / nig, fm = gid * WGM, gsz = (nM - fm) < WGM ? (nM - fm) : WGM;
        u.pm = fm + ((wgid % nig) % gsz); u.pn = (wgid % nig) / gsz; return true;
    }
    __device__ __forceinline__ void a_ready(const Unit&) const {}
    __device__ __forceinline__ void done(const Unit&) const {}
};
template <class Epi, class Sched, bool ALIGN_EPI = false, bool SP2 = false>
__device__ __forceinline__ void gemm_phase(PG8_LAS unsigned char* lds, const Gemm g, const Sched& S, const Epi& E) {
    const int tid = threadIdx.x, wid = __builtin_amdgcn_readfirstlane(tid >> 6), lane = tid & 63, wr = wid >> 2, wc = wid & 3, fr = lane & 15, fq = lane >> 4;
    const int K = g.K, nt = K / BK;
    unsigned voffA[2], voffB[2];
#pragma unroll
    for (int i = 0; i < 2; ++i) { int R, C; stage_rc(tid * 16 + i * 8192, R, C); const int Rb = Epi::PERM ? ((R & ~31) + perm32(R & 31)) : R;
        voffA[i] = (unsigned)(R * K + C) * 2u; voffB[i] = (unsigned)(Rb * K + C) * 2u; }
    const size_t kstep = (size_t)(BK * 2);
    const size_t hstep = (size_t)HALF * K * 2;
    const size_t tstep = 2 * hstep;
    const unsigned ldsw = (unsigned)wid * 1024u;
    const int aoff = lds_byte(wr * 64 + fr, fq * 8), boff = lds_byte(wc * 32 + fr, fq * 8);
#define PG8_SA(b, h) (((b) * 2 + (h)) * HTB)
#define PG8_SB(b, h) ((4 + (b) * 2 + (h)) * HTB)
#define PG8_STAGE(bufoff, gbase, voff) do { _Pragma("unroll") for (int _i = 0; _i < 2; ++_i) \
        __builtin_amdgcn_global_load_lds((const unsigned*)((const char*)(gbase) + (voff)[_i]), (PG8_LAS unsigned*)(lds + (bufoff) + ldsw + _i * 8192), 16, 0, 0); } while (0)
#define PG8_LDA(dst, b, h) do { _Pragma("unroll") for (int m = 0; m < 4; ++m) _Pragma("unroll") for (int k = 0; k < 2; ++k) dst[m][k] = *(const PG8_LAS bf16x8*)(lds + PG8_SA(b, h) + aoff + m * 2048 + k * 1024); } while (0)
#define PG8_LDB(dst, b, h) do { _Pragma("unroll") for (int n = 0; n < 2; ++n) _Pragma("unroll") for (int k = 0; k < 2; ++k) dst[n][k] = *(const PG8_LAS bf16x8*)(lds + PG8_SB(b, h) + boff + n * 2048 + k * 1024); } while (0)
#define PG8_MMA(ai, bj, At, Bt) do { __builtin_amdgcn_s_setprio(1); _Pragma("unroll") for (int m = 0; m < 4; ++m) _Pragma("unroll") for (int n = 0; n < 2; ++n) _Pragma("unroll") for (int k = 0; k < 2; ++k) \
        acc[ai][bj][m][n] = __builtin_amdgcn_mfma_f32_16x16x32_bf16(Bt[n][k], At[m][k], acc[ai][bj][m][n], 0, 0, 0); __builtin_amdgcn_s_setprio(0); } while (0)
#define PG8_WAIT_V(n) asm volatile("s_waitcnt vmcnt(" #n ")" ::: "memory")
#define PG8_WAIT_L(n) asm volatile("s_waitcnt lgkmcnt(" #n ")" ::: "memory")
#define PG8_BAR __builtin_amdgcn_s_barrier()
#define PG8_SCHED __builtin_amdgcn_sched_barrier(0)
    Unit cur, nxt; int ui = 0;
    if (!S.next(0, cur)) return;
    f32x4 acc[2][2][4][2];
#pragma unroll
    for (int a = 0; a < 2; ++a)
#pragma unroll
        for (int b = 0; b < 2; ++b)
#pragma unroll
            for (int m = 0; m < 4; ++m)
#pragma unroll
                for (int n = 0; n < 2; ++n) acc[a][b][m][n] = (f32x4){0.f, 0.f, 0.f, 0.f};
    bf16x8 At[4][2], B0[2][2], B1[2][2];
    const char* cA = (const char*)g.A + (size_t)cur.pm * tstep; const char* cB = (const char*)g.Bt + (size_t)cur.pn * tstep;
    S.a_ready(cur);
    if constexpr (SP2) {
        PG8_STAGE(PG8_SB(0, 0), cB, voffB); PG8_STAGE(PG8_SB(0, 1), cB + hstep, voffB); PG8_STAGE(PG8_SA(0, 0), cA, voffA); PG8_STAGE(PG8_SA(0, 1), cA + hstep, voffA);
        if (wr == 1) PG8_BAR;
        PG8_WAIT_V(2); PG8_BAR;
        PG8_STAGE(PG8_SB(1, 0), cB + kstep, voffB); PG8_STAGE(PG8_SA(1, 0), cA + kstep, voffA); PG8_STAGE(PG8_SB(1, 1), cB + hstep + kstep, voffB);
        PG8_WAIT_V(6); PG8_BAR;
    } else {
        PG8_STAGE(PG8_SB(0, 0), cB, voffB); PG8_STAGE(PG8_SA(0, 0), cA, voffA); PG8_STAGE(PG8_SB(0, 1), cB + hstep, voffB); PG8_STAGE(PG8_SA(0, 1), cA + hstep, voffA);
        if (wr == 1) PG8_BAR;
        PG8_WAIT_V(4); PG8_BAR;
        PG8_STAGE(PG8_SB(1, 0), cB + kstep, voffB); PG8_STAGE(PG8_SA(1, 0), cA + kstep, voffA); PG8_STAGE(PG8_SB(1, 1), cB + hstep + kstep, voffB);
        PG8_WAIT_V(6); PG8_BAR;
    }
    for (;;) {
        const bool has_next = S.next(ui + 1, nxt);
        const char* nA = has_next ? (const char*)g.A + (size_t)nxt.pm * tstep : cA; const char* nB = has_next ? (const char*)g.Bt + (size_t)nxt.pn * tstep : cB;
        for (int t = 0; t < nt; t += 2) {
            const bool last = (t == nt - 2);
            const char* a1 = cA + (size_t)(t + 1) * kstep;
            const char* a2 = last ? nA : cA + (size_t)(t + 2) * kstep; const char* b2 = last ? nB : cB + (size_t)(t + 2) * kstep;
            const char* a3 = a2 + kstep; const char* b3 = b2 + kstep;
            if (last && has_next) S.a_ready(nxt);
            if constexpr (SP2) {
            PG8_LDB(B0, 0, 0); PG8_LDB(B1, 0, 1); PG8_SCHED; PG8_LDA(At, 0, 0); PG8_STAGE(PG8_SA(1, 1), a1 + hstep, voffA);
            PG8_WAIT_V(8); PG8_WAIT_L(0); PG8_BAR; PG8_MMA(0, 0, At, B0); PG8_MMA(0, 1, At, B1); PG8_BAR; PG8_SCHED;
            PG8_LDA(At, 0, 1); PG8_STAGE(PG8_SB(0, 0), b2, voffB); PG8_STAGE(PG8_SB(0, 1), b2 + hstep, voffB); PG8_STAGE(PG8_SA(0, 0), a2, voffA);
            PG8_WAIT_V(8); PG8_WAIT_L(0); PG8_BAR; PG8_MMA(1, 0, At, B0); PG8_MMA(1, 1, At, B1); PG8_BAR; PG8_SCHED;
            PG8_LDB(B0, 1, 0); PG8_LDB(B1, 1, 1); PG8_SCHED; PG8_LDA(At, 1, 0); PG8_STAGE(PG8_SA(0, 1), a2 + hstep, voffA);
            PG8_WAIT_V(8); PG8_WAIT_L(0); PG8_BAR; PG8_MMA(0, 0, At, B0); PG8_MMA(0, 1, At, B1); PG8_BAR; PG8_SCHED;
            PG8_LDA(At, 1, 1); PG8_STAGE(PG8_SB(1, 0), b3, voffB); PG8_STAGE(PG8_SB(1, 1), b3 + hstep, voffB); PG8_STAGE(PG8_SA(1, 0), a3, voffA);
            PG8_WAIT_V(8); PG8_WAIT_L(0); PG8_BAR; PG8_MMA(1, 0, At, B0); PG8_MMA(1, 1, At, B1); PG8_BAR; PG8_SCHED;
            } else {
            PG8_LDB(B0, 0, 0); PG8_SCHED; PG8_LDA(At, 0, 0); PG8_STAGE(PG8_SA(1, 1), a1 + hstep, voffA);
            PG8_WAIT_L(8); PG8_BAR; PG8_WAIT_L(0); PG8_MMA(0, 0, At, B0); PG8_BAR; PG8_SCHED;
            PG8_LDB(B1, 0, 1); PG8_STAGE(PG8_SB(0, 0), b2, voffB);
            PG8_BAR; PG8_WAIT_L(0); PG8_MMA(0, 1, At, B1); PG8_BAR;
            PG8_LDA(At, 0, 1); PG8_STAGE(PG8_SA(0, 0), a2, voffA);
            PG8_BAR; PG8_WAIT_L(0); PG8_MMA(1, 0, At, B0); PG8_BAR; PG8_SCHED;
            PG8_STAGE(PG8_SB(0, 1), b2 + hstep, voffB);
            PG8_WAIT_V(6); PG8_BAR; PG8_MMA(1, 1, At, B1); PG8_BAR;
            PG8_LDB(B0, 1, 0); PG8_SCHED; PG8_LDA(At, 1, 0); PG8_STAGE(PG8_SA(0, 1), a2 + hstep, voffA);
            PG8_WAIT_L(8); PG8_BAR; PG8_WAIT_L(0); PG8_MMA(0, 0, At, B0); PG8_BAR; PG8_SCHED;
            PG8_LDB(B1, 1, 1); PG8_STAGE(PG8_SB(1, 0), b3, voffB);
            PG8_BAR; PG8_WAIT_L(0); PG8_MMA(0, 1, At, B1); PG8_BAR;
            PG8_LDA(At, 1, 1); PG8_STAGE(PG8_SA(1, 0), a3, voffA);
            PG8_BAR; PG8_WAIT_L(0); PG8_MMA(1, 0, At, B0); PG8_BAR; PG8_SCHED;
            PG8_STAGE(PG8_SB(1, 1), b3 + hstep, voffB);
            PG8_WAIT_V(6); PG8_BAR; PG8_MMA(1, 1, At, B1); PG8_BAR;
            }
        }
        if constexpr (ALIGN_EPI) { if (wr == 0) PG8_BAR; }
        if constexpr (!Epi::AFTER_DRAIN) { E(acc, cur, wr, wc, fr, fq); S.done(cur); }
        if (!has_next) break;
#pragma unroll
        for (int a = 0; a < 2; ++a)
#pragma unroll
            for (int b = 0; b < 2; ++b)
#pragma unroll
                for (int m = 0; m < 4; ++m)
#pragma unroll
                    for (int n = 0; n < 2; ++n) acc[a][b][m][n] = (f32x4){0.f, 0.f, 0.f, 0.f};
        cur = nxt; cA = nA; cB = nB; ++ui;
        if constexpr (ALIGN_EPI) { if (wr == 1) PG8_BAR; }
    }
    PG8_WAIT_V(0);
    if constexpr (!ALIGN_EPI) { if (wr == 0) PG8_BAR; }
    PG8_BAR;
    if constexpr (Epi::AFTER_DRAIN) { E.fused(acc, cur, wr, wc, fr, fq, lds, wid, lane); S.done(cur); }
#undef PG8_SA
#undef PG8_SB
#undef PG8_STAGE
#undef PG8_LDA
#undef PG8_LDB
#undef PG8_MMA
#undef PG8_WAIT_V
#undef PG8_WAIT_L
#undef PG8_BAR
#undef PG8_SCHED
}
}
#define GAS __attribute__((address_space(1)))
#define LAS __attribute__((address_space(3)))
typedef unsigned short bf16_t;
typedef short bf16x8 __attribute__((ext_vector_type(8)));
typedef short s16x4 __attribute__((ext_vector_type(4)));
typedef float f32x4 __attribute__((ext_vector_type(4)));
typedef unsigned u32x4 __attribute__((ext_vector_type(4)));
typedef unsigned u32x2 __attribute__((ext_vector_type(2)));
typedef _Float16 h16;
typedef _Float16 h16x4 __attribute__((ext_vector_type(4)));

constexpr int NW = 8, NT = 512;
constexpr int DM = 2048, TSEQ = 4096, MP = 8192, MS = 8, MTOT = 8200, MPAD = 8448;
constexpr int SHW = 3264, NPAD = 8448, DR = 1024;
constexpr size_t MiB = 1u << 20;
constexpr size_t WS_XN = 0, WS_WIN = 33 * MiB, WS_E = 0, WS_WOUT = 97 * MiB, WS_WUP = 105 * MiB, WS_AUP = 105 * MiB + 512 * 1024;
constexpr size_t WS_ZS = 106 * MiB, WS_YR = 106 * MiB, WS_MIX = 159 * MiB, WS_QN = 192 * MiB, WS_KN = WS_QN + 17301504, WS_VA = WS_KN + 17301504, WS_PART = 242 * MiB, WS_END = 243 * MiB;
constexpr int O_Y = 0, O_YS = 16777216, O_WKVP = 16793600, O_SHP = 16924672, O_KP = 16931200, O_VP = 21125504, O_WKVS = 25319808, O_SHS = 25844096, O_KS = 25870208, O_VS = 25878400;
constexpr int LDS_BYTES = 147456;
constexpr int ESTRIDE = 768;

__device__ __forceinline__ unsigned f2bf(float f) { unsigned u = __builtin_bit_cast(unsigned, f); return (u + 0x7fffu + ((u >> 16) & 1u)) >> 16; }
__device__ __forceinline__ unsigned pk2(float lo, float hi) { return f2bf(lo) | (f2bf(hi) << 16); }
__device__ __forceinline__ float bf2f(unsigned short b) { return __builtin_bit_cast(float, (unsigned)b << 16); }
__device__ __forceinline__ float bflo(unsigned w) { return __builtin_bit_cast(float, w << 16); }
__device__ __forceinline__ float bfhi(unsigned w) { return __builtin_bit_cast(float, w & 0xffff0000u); }
__device__ __forceinline__ float wave_sum(float v) {
#pragma unroll
    for (int o = 1; o < 64; o <<= 1) v += __shfl_xor(v, o);
    return v;
}
__device__ __forceinline__ float wave_max(float v) {
#pragma unroll
    for (int o = 1; o < 64; o <<= 1) v = fmaxf(v, __shfl_xor(v, o));
    return v;
}
__device__ __forceinline__ float silu_f(float x) { return x / (1.f + __expf(-x)); }
__device__ __forceinline__ float sigmoid_f(float x) { return 1.f / (1.f + __expf(-x)); }
#define LDS_WAIT() asm volatile("s_waitcnt lgkmcnt(0)" ::: "memory")

struct EpiIn {
    static constexpr bool PERM = true, AFTER_DRAIN = false;
    bf16_t *zs, *mixg, *qn, *kn, *va; float* out; const float *qnw, *knw;
    __device__ __forceinline__ void shift_out(int row, int col, f32x4 v0, f32x4 v1) const {
        float* dst = nullptr;
        if (row == TSEQ - 1) dst = out + O_SHP + col;
        else if (row == 2 * TSEQ - 1) dst = out + O_SHP + SHW + col;
        else if (row >= MP && row < MTOT) dst = out + O_SHS + (row - MP) * SHW + col;
        if (dst) { *(f32x4*)dst = v0; *(f32x4*)(dst + 4) = v1; }
    }
    __device__ __forceinline__ void operator()(const f32x4 (&acc)[2][2][4][2], const pg8::Unit& u, int wr, int wc, int fr, int fq) const {
        const int pn = u.pn, sec = pn >> 2;
        const int rowb = u.pm * 256 + wr * 64 + fr;
        if (pn == 32) {
#pragma unroll
            for (int ai = 0; ai < 2; ++ai)
#pragma unroll
                for (int m = 0; m < 4; ++m) { const int row = rowb + ai * 128 + m * 16;
#pragma unroll
                    for (int bj = 0; bj < 2; ++bj) { const int p0 = 128 * bj + 32 * wc + 8 * fq;
                        if (p0 < 192) { const f32x4 v0 = acc[ai][bj][m][0], v1 = acc[ai][bj][m][1];
                            u32x4 w; w.x = pk2(v0[0], v0[1]); w.y = pk2(v0[2], v0[3]); w.z = pk2(v1[0], v1[1]); w.w = pk2(v1[2], v1[3]);
                            *(u32x4*)(zs + (size_t)row * SHW + 3072 + p0) = w;
                            shift_out(row, 3072 + p0, v0, v1); } } }
            return;
        }
        const int lcb = (pn & 3) * 256 + wc * 64 + fq * 8;
        if (sec <= 2) {
#pragma unroll
            for (int ai = 0; ai < 2; ++ai)
#pragma unroll
                for (int m = 0; m < 4; ++m) { const int row = rowb + ai * 128 + m * 16;
#pragma unroll
                    for (int bj = 0; bj < 2; ++bj) { const int col = sec * 1024 + lcb + bj * 32; const f32x4 v0 = acc[ai][bj][m][0], v1 = acc[ai][bj][m][1];
                        u32x4 w; w.x = pk2(v0[0], v0[1]); w.y = pk2(v0[2], v0[3]); w.z = pk2(v1[0], v1[1]); w.w = pk2(v1[2], v1[3]);
                        *(u32x4*)(zs + (size_t)row * SHW + col) = w;
                        shift_out(row, col, v0, v1); } }
        } else if (sec == 3 || sec == 7) {
            const int cb = (sec == 7 ? 1024 : 0) + lcb;
#pragma unroll
            for (int ai = 0; ai < 2; ++ai)
#pragma unroll
                for (int m = 0; m < 4; ++m) { const int row = rowb + ai * 128 + m * 16;
#pragma unroll
                    for (int bj = 0; bj < 2; ++bj) { const f32x4 v0 = acc[ai][bj][m][0], v1 = acc[ai][bj][m][1];
                        u32x4 w; w.x = pk2(silu_f(v0[0]), silu_f(v0[1])); w.y = pk2(silu_f(v0[2]), silu_f(v0[3])); w.z = pk2(silu_f(v1[0]), silu_f(v1[1])); w.w = pk2(silu_f(v1[2]), silu_f(v1[3]));
                        *(u32x4*)(mixg + (size_t)row * 2048 + cb + bj * 32) = w; } }
        } else if (sec == 6) {
#pragma unroll
            for (int ai = 0; ai < 2; ++ai)
#pragma unroll
                for (int m = 0; m < 4; ++m) { const int row = rowb + ai * 128 + m * 16;
                    float* dst = nullptr; const int t = row & (TSEQ - 1);
                    if (row < MP) { if (t >= 2048) dst = out + O_VP + ((size_t)((row >> 12) * 2048 + (t - 2048))) * 1024; }
                    else if (row < MTOT) dst = out + O_VS + (size_t)(row - MP) * 1024;
#pragma unroll
                    for (int bj = 0; bj < 2; ++bj) { const int col = lcb + bj * 32; const f32x4 v0 = acc[ai][bj][m][0], v1 = acc[ai][bj][m][1];
                        u32x4 w; w.x = pk2(v0[0], v0[1]); w.y = pk2(v0[2], v0[3]); w.z = pk2(v1[0], v1[1]); w.w = pk2(v1[2], v1[3]);
                        *(u32x4*)(va + (size_t)row * 1024 + col) = w;
                        if (dst) { *(f32x4*)(dst + col) = v0; *(f32x4*)(dst + col + 4) = v1; } } }
        } else {
            const bool isq = (sec == 4);
            const float* nwp = isq ? qnw : knw; const float sc = isq ? 0.125f : 1.0f;
            f32x4 nw[2][2];
#pragma unroll
            for (int bj = 0; bj < 2; ++bj) { nw[bj][0] = *(const f32x4*)(nwp + bj * 32 + fq * 8); nw[bj][1] = *(const f32x4*)(nwp + bj * 32 + fq * 8 + 4); }
            bf16_t* ob = isq ? qn : kn;
#pragma unroll
            for (int ai = 0; ai < 2; ++ai)
#pragma unroll
                for (int m = 0; m < 4; ++m) { const int row = rowb + ai * 128 + m * 16;
                    float ss = 0.f;
#pragma unroll
                    for (int bj = 0; bj < 2; ++bj)
#pragma unroll
                        for (int n = 0; n < 2; ++n) { const f32x4 x = acc[ai][bj][m][n]; ss += (x[0] * x[0] + x[1] * x[1]) + (x[2] * x[2] + x[3] * x[3]); }
                    ss += __shfl_xor(ss, 16); ss += __shfl_xor(ss, 32);
                    const float rs = rsqrtf(ss * (1.f / 64.f) + 1e-6f) * sc;
                    float* dst = nullptr; const int t = row & (TSEQ - 1);
                    if (!isq) { if (row < MP) { if (t >= 2048) dst = out + O_KP + ((size_t)((row >> 12) * 2048 + (t - 2048))) * 1024; }
                                else if (row < MTOT) dst = out + O_KS + (size_t)(row - MP) * 1024; }
#pragma unroll
                    for (int bj = 0; bj < 2; ++bj) { const int col = lcb + bj * 32; const f32x4 v0 = acc[ai][bj][m][0] * rs * nw[bj][0], v1 = acc[ai][bj][m][1] * rs * nw[bj][1];
                        u32x4 w; w.x = pk2(v0[0], v0[1]); w.y = pk2(v0[2], v0[3]); w.z = pk2(v1[0], v1[1]); w.w = pk2(v1[2], v1[3]);
                        *(u32x4*)(ob + (size_t)row * 1024 + col) = w;
                        if (dst) { *(f32x4*)(dst + col) = v0; *(f32x4*)(dst + col + 4) = v1; } } }
        }
    }
};
struct EpiOut {
    static constexpr bool PERM = true, AFTER_DRAIN = false;
    const float *xp, *xs; float* out;
    __device__ __forceinline__ void operator()(const f32x4 (&acc)[2][2][4][2], const pg8::Unit& u, int wr, int wc, int fr, int fq) const {
        const int rowb = u.pm * 256 + wr * 64 + fr, colb = u.pn * 256 + wc * 32 + fq * 8;
#pragma unroll
        for (int ai = 0; ai < 2; ++ai)
#pragma unroll
            for (int m = 0; m < 4; ++m) { const int row = rowb + ai * 128 + m * 16;
                const float* xr; float* orow;
                if (row < MP) { xr = xp + (size_t)row * DM; orow = out + O_Y + (size_t)row * DM; }
                else if (row < MTOT) { xr = xs + (size_t)(row - MP) * DM; orow = out + O_YS + (size_t)(row - MP) * DM; }
                else continue;
#pragma unroll
                for (int bj = 0; bj < 2; ++bj) { const int col = colb + bj * 128;
                    *(f32x4*)(orow + col) = acc[ai][bj][m][0] + *(const f32x4*)(xr + col);
                    *(f32x4*)(orow + col + 4) = acc[ai][bj][m][1] + *(const f32x4*)(xr + col + 4); } }
    }
};

__device__ __forceinline__ void p0_transpose_item(const float* W, int Nsrc, int src_n0, int k0, bf16_t* WT, int dst_row0, int Kdst, LAS float* scr, int lane) {
    if (src_n0 < 0) {
        const int c = lane & 7;
#pragma unroll
        for (int j = 0; j < 4; ++j) { const int n = (lane >> 3) + 8 * j; *(u32x4*)(WT + (size_t)(dst_row0 + n) * Kdst + k0 + 8 * c) = (u32x4){0u, 0u, 0u, 0u}; }
        return;
    }
#pragma unroll 8
    for (int i = 0; i < 32; ++i) { const int kk = 2 * i + (lane >> 5); scr[kk * 33 + (lane & 31)] = W[(size_t)(k0 + kk) * Nsrc + src_n0 + (lane & 31)]; }
    LDS_WAIT(); asm volatile("" ::: "memory");
    const int c = lane & 7;
#pragma unroll
    for (int j = 0; j < 4; ++j) { const int n = (lane >> 3) + 8 * j; const LAS float* s = scr + (8 * c) * 33 + n;
        u32x4 o; o.x = pk2(s[0 * 33], s[1 * 33]); o.y = pk2(s[2 * 33], s[3 * 33]); o.z = pk2(s[4 * 33], s[5 * 33]); o.w = pk2(s[6 * 33], s[7 * 33]);
        *(u32x4*)(WT + (size_t)(dst_row0 + n) * Kdst + k0 + 8 * c) = o; }
    LDS_WAIT(); asm volatile("" ::: "memory");
}
__device__ __forceinline__ int win_src_col(int n0) {
    const int T = n0 >> 8, p = n0 & 255;
    if (T < 32) { const int s = T >> 2, ts = T & 3, bj = p >> 7, wc = (p & 127) >> 5; const int lc = ts * 256 + wc * 64 + bj * 32;
        return (s < 3 ? s * 1024 : SHW + (s - 3) * 1024) + lc; }
    return p < 192 ? 3072 + p : -1;
}
__device__ __forceinline__ void p0_prologue(const float* xp, const float* xs, const float* nwp, const float* w_in, const float* w_up, const float* a_up, const float* w_out, unsigned char* ws, LAS unsigned char* lds, int G, int bx, int wave, int lane, int tid) {
    LAS float* scr = (LAS float*)(lds + wave * 16384);
    const int gw = bx * NW + wave, NGW = G * NW;
    bf16_t* winT = (bf16_t*)(ws + WS_WIN); bf16_t* woutT = (bf16_t*)(ws + WS_WOUT);
    constexpr int I_IN = 32 * (NPAD / 32), I_OUT = 32 * (DM / 32);
    for (int it = gw; it < I_IN + I_OUT; it += NGW) {
        if (it < I_IN) { const int kb = it / (NPAD / 32), nb = it % (NPAD / 32); p0_transpose_item(w_in, 8384, win_src_col(nb * 32), kb * 64, winT, nb * 32, DM, scr, lane); }
        else { const int r = it - I_IN; const int kb = r / (DM / 32), nb = r % (DM / 32); p0_transpose_item(w_out, DM, nb * 32, kb * 64, woutT, nb * 32, DM, scr, lane); }
    }
    { bf16_t* wupT = (bf16_t*)(ws + WS_WUP); bf16_t* aupT = (bf16_t*)(ws + WS_AUP);
      for (int i = bx * NT + tid; i < 2 * 1024 * 12; i += G * NT) { const int which = i / 12288, r = i % 12288, n = r / 12, c = r % 12;
          const float* W = which ? a_up : w_up; bf16_t* D = which ? aupT : wupT;
          u32x4 o; o.x = pk2(W[(8 * c + 0) * 1024 + n], W[(8 * c + 1) * 1024 + n]); o.y = pk2(W[(8 * c + 2) * 1024 + n], W[(8 * c + 3) * 1024 + n]);
          o.z = pk2(W[(8 * c + 4) * 1024 + n], W[(8 * c + 5) * 1024 + n]); o.w = pk2(W[(8 * c + 6) * 1024 + n], W[(8 * c + 7) * 1024 + n]);
          *(u32x4*)(D + n * 96 + 8 * c) = o; } }
    bf16_t* xn = (bf16_t*)(ws + WS_XN);
    for (int m = gw; m < MPAD; m += NGW) {
        u32x2* o8 = (u32x2*)(xn + (size_t)m * DM) + lane;
        if (m >= MTOT) {
#pragma unroll
            for (int j = 0; j < 8; ++j) o8[64 * j] = (u32x2){0u, 0u};
            continue; }
        const float* xrow = m < MP ? xp + (size_t)m * DM : xs + (size_t)(m - MP) * DM;
        const f32x4* xr = (const f32x4*)xrow + lane;
        f32x4 v[8]; float s = 0.f;
#pragma unroll
        for (int j = 0; j < 8; ++j) { v[j] = xr[64 * j]; s += (v[j].x * v[j].x + v[j].y * v[j].y) + (v[j].z * v[j].z + v[j].w * v[j].w); }
        const float rstd = rsqrtf(wave_sum(s) * (1.f / DM) + 1e-6f);
#pragma unroll
        for (int j = 0; j < 8; ++j) { const f32x4 g = ((const f32x4*)nwp)[lane + 64 * j]; const f32x4 y = v[j] * rstd * g;
            o8[64 * j] = (u32x2){pk2(y.x, y.y), pk2(y.z, y.w)}; }
    }
}
__device__ __forceinline__ size_t e_rec(int m, int h) { return m < MP ? ((size_t)((m >> 12) * 16 + h) * TSEQ + (m & (TSEQ - 1))) : ((size_t)32 * TSEQ + (size_t)(m - MP) * 16 + h); }
struct F8 { f32x4 a, b; };
__device__ __forceinline__ F8 ld_bf8(const bf16_t* p) { const u32x4 w = *(const u32x4*)p; F8 r; r.a = (f32x4){bflo(w.x), bfhi(w.x), bflo(w.y), bfhi(w.y)}; r.b = (f32x4){bflo(w.z), bfhi(w.z), bflo(w.w), bfhi(w.w)}; return r; }
__device__ __forceinline__ F8 ld_prev8(const bf16_t* zs, const float* sst, int m, int col) {
    F8 r;
    if (m >= MP) { const float* p = sst + (m - MP) * SHW + col; r.a = *(const f32x4*)p; r.b = *(const f32x4*)(p + 4); return r; }
    if ((m & (TSEQ - 1)) == 0) { r.a = (f32x4){0.f, 0.f, 0.f, 0.f}; r.b = r.a; return r; }
    return ld_bf8(zs + (size_t)(m - 1) * SHW + col);
}
__device__ __forceinline__ float ld_prev1(const bf16_t* zs, const float* sst, int m, int col) {
    if (m >= MP) return sst[(m - MP) * SHW + col];
    if ((m & (TSEQ - 1)) == 0) return 0.f;
    return bf2f(zs[(size_t)(m - 1) * SHW + col]);
}
__device__ __forceinline__ float tanh_f(float x) { return 1.f - 2.f / (1.f + __expf(2.f * x)); }
__device__ __forceinline__ bf16x8 pack_bf8(f32x4 a, f32x4 b) { u32x4 w; w.x = pk2(a[0], a[1]); w.y = pk2(a[2], a[3]); w.z = pk2(b[0], b[1]); w.w = pk2(b[2], b[3]); return __builtin_bit_cast(bf16x8, w); }

struct F4 { float v[4]; };
__device__ __forceinline__ f32x4 ld_bf4(const bf16_t* p) { const u32x2 w = *(const u32x2*)p; return (f32x4){bflo(w.x), bfhi(w.x), bflo(w.y), bfhi(w.y)}; }
__device__ __forceinline__ f32x4 ld_prev4(const bf16_t* zs, const float* sst, int m, int col) {
    if (m >= MP) return *(const f32x4*)(sst + (m - MP) * SHW + col);
    if ((m & (TSEQ - 1)) == 0) return (f32x4){0.f, 0.f, 0.f, 0.f};
    return ld_bf4(zs + (size_t)(m - 1) * SHW + col);
}
typedef _Float16 h16x4s __attribute__((ext_vector_type(4)));
__device__ __forceinline__ void st_h4(unsigned char* p, f32x4 v) { h16x4s h; h[0] = (h16)v[0]; h[1] = (h16)v[1]; h[2] = (h16)v[2]; h[3] = (h16)v[3]; *(h16x4s*)p = h; }
__device__ __forceinline__ int m_of(int tg, int lane) { return 16 * tg + (lane & 15); }
template <bool SAMP> __device__ __forceinline__ F8 prev8(const bf16_t* zs, const float* sst, int m, int col, bool first) {
    if (SAMP) { const float* p = sst + (m - MP) * SHW + col; F8 r; r.a = *(const f32x4*)p; r.b = *(const f32x4*)(p + 4); return r; }
    F8 r = ld_bf8(zs + (size_t)(m - (first ? 0 : 1)) * SHW + col); const float z = first ? 0.f : 1.f; r.a = r.a * z; r.b = r.b * z; return r;
}
template <bool SAMP> __device__ __forceinline__ f32x4 prev4(const bf16_t* zs, const float* sst, int m, int col, bool first) {
    if (SAMP) return *(const f32x4*)(sst + (m - MP) * SHW + col);
    const f32x4 r = ld_bf4(zs + (size_t)(m - (first ? 0 : 1)) * SHW + col); return r * (first ? 0.f : 1.f);
}
template <bool SAMP> __device__ __forceinline__ void prep_unit_t(int tg, const bf16_t* zs, unsigned char* Eb, const bf16_t* wupT, const bf16_t* aupT, const float* sst, const float* mu,
                                          const float* w0, const float* a0, const float* k_k, const float* k_a, int wave, int lane) {
    const int q = lane & 15, g = lane >> 4;
    constexpr bool samp = SAMP;
    const bool first = !SAMP && ((m_of(tg, lane) & (TSEQ - 1)) == 0);
    const int m = samp ? MP + (q < 8 ? q : 7) : 16 * tg + q;
    const bool wr_ok = !(samp && q >= 8);
    bf16x8 Bw[3], Ba[3];
#pragma unroll
    for (int ks = 0; ks < 3; ++ks) {
        { const int col = 3072 + 32 * ks + 8 * g; const F8 c = ld_bf8(zs + (size_t)m * SHW + col), p = prev8<SAMP>(zs, sst, m, col, first);
          const f32x4 m0 = *(const f32x4*)(mu + col), m1 = *(const f32x4*)(mu + col + 4);
          f32x4 xa = c.a + m0 * (p.a - c.a), xb = c.b + m1 * (p.b - c.b);
#pragma unroll
          for (int i = 0; i < 4; ++i) { xa[i] = tanh_f(xa[i]); xb[i] = tanh_f(xb[i]); }
          Bw[ks] = pack_bf8(xa, xb); }
        { const int col = 3168 + 32 * ks + 8 * g; const F8 c = ld_bf8(zs + (size_t)m * SHW + col), p = prev8<SAMP>(zs, sst, m, col, first);
          const f32x4 m0 = *(const f32x4*)(mu + col), m1 = *(const f32x4*)(mu + col + 4);
          const f32x4 xa = c.a + m0 * (p.a - c.a), xb = c.b + m1 * (p.b - c.b);
          Ba[ks] = pack_bf8(xa, xb); }
    }
#pragma unroll 1
    for (int hh = 0; hh < 2; ++hh) {
        const int h = 2 * wave + hh;
        unsigned char* erec = Eb + e_rec(m, h) * ESTRIDE;
        f32x4 kkr[4], av[4]; float ss = 0.f;
#pragma unroll
        for (int j = 0; j < 4; ++j) {
            const int chA = h * 64 + 16 * j + q;
            const int ch = h * 64 + 16 * j + 4 * g;
            f32x4 cw = (f32x4){0.f, 0.f, 0.f, 0.f}, ca = cw;
#pragma unroll
            for (int ks = 0; ks < 3; ++ks) {
                const bf16x8 aw = *(const bf16x8*)(wupT + chA * 96 + 32 * ks + 8 * g), aa = *(const bf16x8*)(aupT + chA * 96 + 32 * ks + 8 * g);
                cw = __builtin_amdgcn_mfma_f32_16x16x32_bf16(aw, Bw[ks], cw, 0, 0, 0);
                ca = __builtin_amdgcn_mfma_f32_16x16x32_bf16(aa, Ba[ks], ca, 0, 0, 0);
            }
            const f32x4 w0c = *(const f32x4*)(w0 + ch), a0c = *(const f32x4*)(a0 + ch), kkc = *(const f32x4*)(k_k + ch), kac = *(const f32x4*)(k_a + ch);
            const f32x4 mur = *(const f32x4*)(mu + ch), muk = *(const f32x4*)(mu + 1024 + ch), muv = *(const f32x4*)(mu + 2048 + ch);
            const f32x4 rc = ld_bf4(zs + (size_t)m * SHW + ch), kc = ld_bf4(zs + (size_t)m * SHW + 1024 + ch), vc = ld_bf4(zs + (size_t)m * SHW + 2048 + ch);
            const f32x4 rp = prev4<SAMP>(zs, sst, m, ch, first), kp = prev4<SAMP>(zs, sst, m, 1024 + ch, first), vp = prev4<SAMP>(zs, sst, m, 2048 + ch, first);
            const f32x4 rv = rc + mur * (rp - rc), vv = vc + muv * (vp - vc), km = kc + muk * (kp - kc);
            f32x4 a, u;
#pragma unroll
            for (int c = 0; c < 4; ++c) { a[c] = sigmoid_f(a0c[c] + ca[c]); u[c] = -expm1f(-0.60653065971f * sigmoid_f(w0c[c] + cw[c])); }
            const f32x4 kr = km * kkc; kkr[j] = kr; av[j] = a; ss += (kr[0] * kr[0] + kr[1] * kr[1]) + (kr[2] * kr[2] + kr[3] * kr[3]);
            if (wr_ok) { unsigned char* e = erec + (16 * j + 4 * g) * 2;
                st_h4(e, u); st_h4(e + 128, km * (1.f + (a - 1.f) * kac)); st_h4(e + 512, rv); st_h4(e + 640, vv); }
        }
        ss += __shfl_xor(ss, 16); ss += __shfl_xor(ss, 32);
        const float inv = 1.f / fmaxf(sqrtf(ss), 1e-12f);
        if (wr_ok) {
#pragma unroll
            for (int j = 0; j < 4; ++j) { unsigned char* e = erec + (16 * j + 4 * g) * 2; const f32x4 kk = kkr[j] * inv;
                st_h4(e + 256, -kk); st_h4(e + 384, kk * av[j]); }
        }
    }
}

__device__ __forceinline__ void prep_unit(int tg, const bf16_t* zs, unsigned char* Eb, const bf16_t* wupT, const bf16_t* aupT, const float* sst, const float* mu,
                                          const float* w0, const float* a0, const float* k_k, const float* k_a, int wave, int lane) {
    if (tg >= 512) prep_unit_t<true>(tg, zs, Eb, wupT, aupT, sst, mu, w0, a0, k_k, k_a, wave, lane);
    else prep_unit_t<false>(tg, zs, Eb, wupT, aupT, sst, mu, w0, a0, k_k, k_a, wave, lane);
}

__device__ __forceinline__ s16x4 tr_read(LAS unsigned char* p) { return __builtin_bit_cast(s16x4, __builtin_amdgcn_ds_read_tr16_b64_v4i16((LAS s16x4*)p)); }
constexpr int ACC_PITCH = 68;
__device__ __forceinline__ void attn_unit(int unit, const bf16_t* qn, const bf16_t* kn, const bf16_t* va, const bf16_t* mixg, bf16_t* mixo, LAS unsigned char* lds, int wave, int lane, int tid) {
    const int b = unit >> 8, h = (unit >> 4) & 15, sp = unit & 15;
    const int mb = b * TSEQ, tb = sp * 256;
    LAS float* accL = (LAS float*)lds; LAS float* mL = (LAS float*)(lds + 256 * ACC_PITCH * 4); LAS float* lL = mL + 256;
    LAS unsigned char* vst = lds + 256 * ACC_PITCH * 4 + 2048 + wave * 2304;
    const int q = lane & 15, g = lane >> 4;
    const float slope = exp2f(-0.5f * (float)(h + 1));
#pragma unroll 1
    for (int p = 0; p < 3; ++p) {
        const int d = p == 0 ? 1 : (p == 1 ? 4 : 16);
        const float sd = slope * (float)d;
#pragma unroll 1
        for (int tt = 0; tt < 2; ++tt) {
            const int tile = 2 * wave + tt;
            const int base = p == 0 ? 16 * tile : (p == 1 ? 64 * (tile >> 2) + (tile & 3) : tile);
            const int tok0 = tb + base;
            const bf16_t* qp = qn + (size_t)(mb + tok0 + q * d) * 1024 + h * 64 + 8 * g;
            const bf16x8 qa = *(const bf16x8*)qp, qb = *(const bf16x8*)(qp + 32);
            float m_run = -INFINITY, l_run = 0.f;
            f32x4 O[4];
#pragma unroll
            for (int i = 0; i < 4; ++i) O[i] = (f32x4){0.f, 0.f, 0.f, 0.f};
#define AT_LOADKV(KS, KA, KB, V0, V1) do { int _kt = tok0 + (16 * (KS) + q - 128) * d; _kt = _kt < 0 ? 0 : _kt; const bf16_t* _kp = kn + (size_t)(mb + _kt) * 1024 + h * 64 + 8 * g; \
                KA = *(const bf16x8*)_kp; KB = *(const bf16x8*)(_kp + 32); int _vt = tok0 + (16 * (KS) + (lane >> 2) - 128) * d; _vt = _vt < 0 ? 0 : _vt; \
                const bf16_t* _vp = va + (size_t)(mb + _vt) * 1024 + h * 64 + 16 * (lane & 3); V0 = *(const u32x4*)_vp; V1 = *(const u32x4*)(_vp + 8); } while (0)
            bf16x8 nka, nkb; u32x4 nv0, nv1;
            AT_LOADKV(0, nka, nkb, nv0, nv1);
#pragma unroll 1
            for (int ks = 0; ks < 9; ++ks) {
                const bf16x8 ka = nka, kb = nkb; const u32x4 v0 = nv0, v1 = nv1;
                { const int kn1 = ks < 8 ? ks + 1 : 8; AT_LOADKV(kn1, nka, nkb, nv0, nv1); }
                asm volatile("" ::: "memory");
                *(LAS u32x4*)(vst + (lane >> 2) * 144 + (lane & 3) * 32) = v0; *(LAS u32x4*)(vst + (lane >> 2) * 144 + (lane & 3) * 32 + 16) = v1;
                f32x4 S = (f32x4){0.f, 0.f, 0.f, 0.f};
                S = __builtin_amdgcn_mfma_f32_16x16x32_bf16(ka, qa, S, 0, 0, 0);
                S = __builtin_amdgcn_mfma_f32_16x16x32_bf16(kb, qb, S, 0, 0, 0);
                float s[4]; float mx = -INFINITY;
#pragma unroll
                for (int c = 0; c < 4; ++c) { const int ki = 16 * ks + 4 * g + c; const int off = q + 128 - ki; const int ktok = tok0 + (ki - 128) * d;
                    const bool valid = (off >= 0) && (off <= 128) && (ktok >= 0);
                    s[c] = valid ? S[c] - sd * (float)off : -INFINITY; mx = fmaxf(mx, s[c]); }
                mx = fmaxf(mx, __shfl_xor(mx, 16)); mx = fmaxf(mx, __shfl_xor(mx, 32));
                const float m_new = fmaxf(m_run, mx);
                float sc = 1.f, pe[4] = {0.f, 0.f, 0.f, 0.f};
                if (m_new > -INFINITY) { sc = __expf(m_run - m_new);
#pragma unroll
                    for (int c = 0; c < 4; ++c) pe[c] = __expf(s[c] - m_new); }
                l_run = l_run * sc + ((pe[0] + pe[1]) + (pe[2] + pe[3])); m_run = m_new;
#pragma unroll
                for (int i = 0; i < 4; ++i) O[i] = O[i] * sc;
                u32x2 pw; pw.x = pk2(pe[0], pe[1]); pw.y = pk2(pe[2], pe[3]);
                const s16x4 pb = __builtin_bit_cast(s16x4, pw);
                LDS_WAIT(); asm volatile("" ::: "memory");
#pragma unroll
                for (int blk = 0; blk < 4; ++blk) {
                    const s16x4 vtr = tr_read(vst + (4 * g + ((lane & 15) >> 2)) * 144 + (16 * blk + 4 * (lane & 3)) * 2);
                    O[blk] = __builtin_amdgcn_mfma_f32_16x16x16bf16_1k(vtr, pb, O[blk], 0, 0, 0);
                }
                LDS_WAIT(); asm volatile("" ::: "memory");
            }
            l_run += __shfl_xor(l_run, 16); l_run += __shfl_xor(l_run, 32);
            const int ti = base + q * d;
            LAS float* ar = accL + ti * ACC_PITCH + 4 * g;
            if (p == 0) {
#pragma unroll
                for (int blk = 0; blk < 4; ++blk) *(LAS f32x4*)(ar + 16 * blk) = O[blk];
                if (g == 0) { mL[ti] = m_run; lL[ti] = l_run; }
            } else {
                const float mo = mL[ti], lo = lL[ti];
                const float mn = fmaxf(mo, m_run), ao = __expf(mo - mn), an = __expf(m_run - mn);
#pragma unroll
                for (int blk = 0; blk < 4; ++blk) { const f32x4 old = *(LAS f32x4*)(ar + 16 * blk); *(LAS f32x4*)(ar + 16 * blk) = old * ao + O[blk] * an; }
                LDS_WAIT(); asm volatile("" ::: "memory");
                if (g == 0) { mL[ti] = mn; lL[ti] = lo * ao + l_run * an; }
            }
        }
        __syncthreads();
    }
    {
        const int ti = tid >> 1, hf = tid & 1;
        const float inv = 1.f / lL[ti];
        const size_t go = (size_t)(mb + tb + ti) * 2048 + 1024 + h * 64 + 32 * hf; const bf16_t* gp = mixg + go; bf16_t* op = mixo + go;
        const LAS float* ar = accL + ti * ACC_PITCH + 32 * hf;
#pragma unroll
        for (int c8 = 0; c8 < 4; ++c8) { const F8 gt = ld_bf8(gp + 8 * c8); const f32x4 o0 = *(const LAS f32x4*)(ar + 8 * c8) * inv * gt.a, o1 = *(const LAS f32x4*)(ar + 8 * c8 + 4) * inv * gt.b;
            u32x4 w; w.x = pk2(o0[0], o0[1]); w.y = pk2(o0[2], o0[3]); w.z = pk2(o1[0], o1[1]); w.w = pk2(o1[2], o1[3]);
            *(u32x4*)(op + 8 * c8) = w; }
    }
    __syncthreads();
}

constexpr int SA_KC = 26, SA_NKC = 5, SA_NPART = 15, SA_TASKS = 128 * SA_NPART, SA_PSTRIDE = 66;
__device__ __forceinline__ void attn_sample_part(int task, const bf16_t* qn, const bf16_t* kn, const bf16_t* va, const float* ck, const float* cv, float* part, int lane) {
    const int sbh = task / SA_NPART, pk = task % SA_NPART, p = pk / SA_NKC, kc = pk % SA_NKC;
    const int sb = sbh >> 4, h = sbh & 15, m = MP + sb; const int d = p == 0 ? 1 : (p == 1 ? 4 : 16);
    const float ql = bf2f(qn[(size_t)m * 1024 + h * 64 + lane]);
    const float slope = exp2f(-0.5f * (float)(h + 1));
    float kv[SA_KC];
#pragma unroll
    for (int jj = 0; jj < SA_KC; ++jj) { const int j = SA_KC * kc + jj; const int jc = j > 128 ? 128 : j;
        kv[jj] = (jc == 0) ? bf2f(kn[(size_t)m * 1024 + h * 64 + lane]) : ck[(((size_t)sb * 2048 + (2048 - jc * d)) * 16 + h) * 64 + lane]; }
    float sc[SA_KC]; float mx = -INFINITY;
#pragma unroll
    for (int jj = 0; jj < SA_KC; ++jj) { const int j = SA_KC * kc + jj; const float dot = wave_sum(ql * kv[jj]);
        sc[jj] = (j <= 128) ? dot - slope * (float)(j * d) : -INFINITY; mx = fmaxf(mx, sc[jj]); }
#pragma unroll
    for (int jj = 0; jj < SA_KC; ++jj) { const int j = SA_KC * kc + jj; const int jc = j > 128 ? 128 : j;
        kv[jj] = (jc == 0) ? bf2f(va[(size_t)m * 1024 + h * 64 + lane]) : cv[(((size_t)sb * 2048 + (2048 - jc * d)) * 16 + h) * 64 + lane]; }
    float o = 0.f, l = 0.f;
#pragma unroll
    for (int jj = 0; jj < SA_KC; ++jj) { const float pe = __expf(sc[jj] - mx); l += pe; o = fmaf(pe, kv[jj], o); }
    float* pp = part + (size_t)task * SA_PSTRIDE;
    pp[lane] = o; if (lane == 0) { pp[64] = mx; pp[65] = l; }
}
__device__ __forceinline__ void attn_sample_combine(int sbh, const float* part, bf16_t* mixg, int lane) {
    const float* pp = part + (size_t)sbh * SA_NPART * SA_PSTRIDE;
    float M = -INFINITY;
#pragma unroll
    for (int i = 0; i < SA_NPART; ++i) M = fmaxf(M, pp[i * SA_PSTRIDE + 64]);
    float o = 0.f, l = 0.f;
#pragma unroll
    for (int i = 0; i < SA_NPART; ++i) { const float w = __expf(pp[i * SA_PSTRIDE + 64] - M); o = fmaf(w, pp[i * SA_PSTRIDE + lane], o); l = fmaf(w, pp[i * SA_PSTRIDE + 65], l); }
    const size_t go = (size_t)(MP + (sbh >> 4)) * 2048 + 1024 + (sbh & 15) * 64 + lane;
    mixg[go] = (bf16_t)f2bf(o / l * bf2f(mixg[go]));
}

template <int CTRL> __device__ __forceinline__ float dpp_mov(float v) { return __builtin_bit_cast(float, __builtin_amdgcn_update_dpp(0, __builtin_bit_cast(int, v), CTRL, 0xF, 0xF, true)); }
__device__ __forceinline__ float red16(float v) { v += dpp_mov<0xB1>(v); v += dpp_mov<0x4E>(v); v += dpp_mov<0x141>(v); v += dpp_mov<0x140>(v); return v; }
struct StepIn { h16x4 w, k, a, b, r; h16 v; };
__device__ __forceinline__ float do_step(float (&S)[4], const StepIn& in) {
    float sa = 0.f;
#pragma unroll
    for (int c = 0; c < 4; ++c) sa = fmaf(S[c], (float)in.a[c], sa);
    sa = red16(sa);
    const float v = (float)in.v; float y = 0.f;
#pragma unroll
    for (int c = 0; c < 4; ++c) { float t = fmaf(v, (float)in.k[c], S[c]); asm("" : "+v"(t)); t = fmaf(sa, (float)in.b[c], t); asm("" : "+v"(t));
        S[c] = fmaf(-(float)in.w[c], S[c], t); asm("" : "+v"(S[c])); y = fmaf(S[c], (float)in.r[c], y); }
    return red16(y);
}
__device__ __forceinline__ void scan_one(const unsigned char* rec, int rq, const float* S0, float* Sout, float* yp, int lane) {
    const int rr = lane >> 4, jq = lane & 15, i = 4 * rq + rr;
    float S[4]; { const f32x4 s = *(const f32x4*)(S0 + i * 64 + 4 * jq); S[0] = s.x; S[1] = s.y; S[2] = s.z; S[3] = s.w; }
    StepIn in; in.w = *(const h16x4*)(rec + jq * 8); in.k = *(const h16x4*)(rec + 128 + jq * 8); in.a = *(const h16x4*)(rec + 256 + jq * 8); in.b = *(const h16x4*)(rec + 384 + jq * 8);
    in.r = *(const h16x4*)(rec + 512 + jq * 8); in.v = *(const h16*)(rec + 640 + i * 2);
    const float y = do_step(S, in); if (jq == 0) yp[i] = y;
    *(f32x4*)(Sout + i * 64 + 4 * jq) = (f32x4){S[0], S[1], S[2], S[3]};
}
constexpr int SC_CH = 32, SC_CHB = SC_CH * ESTRIDE, SC_NCH = TSEQ / SC_CH;
__device__ __forceinline__ void scan_pair(int pair, const unsigned char* Eb, float* out, float* yraw, LAS unsigned char* lds, int wave, int lane) {
    const int bh = pair >> 3, rq = ((pair & 7) << 1) + (wave & 1);
    const unsigned char* base = Eb + (size_t)bh * TSEQ * ESTRIDE;
    const int rr = lane >> 4, jq = lane & 15, i = 4 * rq + rr;
    float S[4] = {0.f, 0.f, 0.f, 0.f};
    float* yp = yraw + (size_t)((bh >> 4) * TSEQ) * 1024 + (bh & 15) * 64 + i;
#define SC_ISSUE(kc) do { const int _kc = (kc) < SC_NCH ? (kc) : SC_NCH - 1; const unsigned char* _g = base + (size_t)_kc * SC_CHB; LAS unsigned char* _l = lds + ((kc) & 3) * SC_CHB; \
        _Pragma("unroll") for (int _p = 0; _p < 4; ++_p) { const int _x = (4 * (wave - 2) + _p) * 64; \
            __builtin_amdgcn_global_load_lds((const unsigned*)(_g + (size_t)(_x + lane) * 16), (LAS unsigned*)(_l + _x * 16), 16, 0, 0); } } while (0)
    if (wave >= 2) { SC_ISSUE(0); SC_ISSUE(1); SC_ISSUE(2); asm volatile("s_waitcnt vmcnt(8)" ::: "memory"); }
    __builtin_amdgcn_s_barrier(); asm volatile("" ::: "memory");
#pragma unroll 1
    for (int k = 0; k < SC_NCH; ++k) {
        if (wave >= 2) { SC_ISSUE(k + 3); asm volatile("s_waitcnt vmcnt(8)" ::: "memory"); }
        else {
            const LAS unsigned char* bp = lds + (k & 3) * SC_CHB;
#pragma unroll 8
            for (int s = 0; s < SC_CH; ++s) {
                const LAS unsigned char* p = bp + s * ESTRIDE;
                StepIn in; in.w = *(const LAS h16x4*)(p + jq * 8); in.k = *(const LAS h16x4*)(p + 128 + jq * 8); in.a = *(const LAS h16x4*)(p + 256 + jq * 8); in.b = *(const LAS h16x4*)(p + 384 + jq * 8);
                in.r = *(const LAS h16x4*)(p + 512 + jq * 8); in.v = *(const LAS h16*)(p + 640 + i * 2);
                const float y = do_step(S, in); yp[(size_t)(k * SC_CH + s) * 1024] = y;
            }
        }
        asm volatile("" ::: "memory"); __builtin_amdgcn_s_barrier(); asm volatile("" ::: "memory");
    }
    if (wave >= 2) asm volatile("s_waitcnt vmcnt(0)" ::: "memory");
    if (wave < 2) *(f32x4*)(out + O_WKVP + (size_t)bh * 4096 + i * 64 + 4 * jq) = (f32x4){S[0], S[1], S[2], S[3]};
    __builtin_amdgcn_s_barrier(); asm volatile("" ::: "memory");
#undef SC_ISSUE
}

template <int CTRL> __device__ __forceinline__ float dpp_mov(float v);
__device__ __forceinline__ float quad_sum(float v) { v += dpp_mov<0xB1>(v); v += dpp_mov<0x4E>(v); return v; }
__device__ __forceinline__ void fin_token(int m, const float* yraw, const unsigned char* Eb, bf16_t* mixg, const float* gn_w, const float* gn_b, const float* r_k, int lane) {
    const int h = lane >> 2, qt = lane & 3, ch0 = lane * 16;
    f32x4 y[4];
#pragma unroll
    for (int i = 0; i < 4; ++i) y[i] = *(const f32x4*)(yraw + (size_t)m * 1024 + ch0 + 4 * i);
    const unsigned char* e = Eb + e_rec(m, h) * ESTRIDE + qt * 32;
    const u32x4 rr0 = *(const u32x4*)(e + 512), rr1 = *(const u32x4*)(e + 528), kk0 = *(const u32x4*)(e + 128), kk1 = *(const u32x4*)(e + 144), vv0 = *(const u32x4*)(e + 640), vv1 = *(const u32x4*)(e + 656);
    bf16_t* gp = mixg + (size_t)m * 2048 + ch0;
    const F8 g0 = ld_bf8(gp), g1 = ld_bf8(gp + 8);
    float s = 0.f;
#pragma unroll
    for (int i = 0; i < 4; ++i) s += (y[i].x + y[i].y) + (y[i].z + y[i].w);
    const float mean = quad_sum(s) * (1.f / 64.f);
    float q = 0.f;
#pragma unroll
    for (int i = 0; i < 4; ++i) { y[i] = y[i] - mean; q += (y[i].x * y[i].x + y[i].y * y[i].y) + (y[i].z * y[i].z + y[i].w * y[i].w); }
    const float rstd = rsqrtf(quad_sum(q) * (1.f / 64.f) + 64e-5f);
    typedef _Float16 h16x8 __attribute__((ext_vector_type(8)));
    const h16x8 r0 = __builtin_bit_cast(h16x8, rr0), r1 = __builtin_bit_cast(h16x8, rr1), k0 = __builtin_bit_cast(h16x8, kk0), k1 = __builtin_bit_cast(h16x8, kk1), v0 = __builtin_bit_cast(h16x8, vv0), v1 = __builtin_bit_cast(h16x8, vv1);
    float bs = 0.f;
#pragma unroll
    for (int i = 0; i < 8; ++i) { bs = fmaf((float)r0[i] * (float)k0[i], r_k[ch0 + i], bs); bs = fmaf((float)r1[i] * (float)k1[i], r_k[ch0 + 8 + i], bs); }
    bs = quad_sum(bs);
    float o[16];
#pragma unroll
    for (int i = 0; i < 16; ++i) { const float yn = y[i >> 2][i & 3] * rstd * gn_w[ch0 + i] + gn_b[ch0 + i];
        const float vv = i < 8 ? (float)v0[i & 7] : (float)v1[i & 7]; const float gt = i < 4 ? g0.a[i & 3] : (i < 8 ? g0.b[i & 3] : (i < 12 ? g1.a[i & 3] : g1.b[i & 3]));
        o[i] = (yn + bs * vv) * gt; }
    u32x4 w0, w1; w0.x = pk2(o[0], o[1]); w0.y = pk2(o[2], o[3]); w0.z = pk2(o[4], o[5]); w0.w = pk2(o[6], o[7]); w1.x = pk2(o[8], o[9]); w1.y = pk2(o[10], o[11]); w1.z = pk2(o[12], o[13]); w1.w = pk2(o[14], o[15]);
    *(u32x4*)gp = w0; *(u32x4*)(gp + 8) = w1;
}
__device__ __forceinline__ void outproj_sample_col(int d, const bf16_t* mixg, const bf16_t* woutT, const float* xs, float* out, int lane) {
    float acc[8] = {0.f, 0.f, 0.f, 0.f, 0.f, 0.f, 0.f, 0.f};
#pragma unroll
    for (int i = 0; i < 4; ++i) { const int e0 = 8 * lane + 512 * i; const F8 w = ld_bf8(woutT + (size_t)d * DM + e0);
#pragma unroll
        for (int r = 0; r < 8; ++r) { const F8 x = ld_bf8(mixg + (size_t)(MP + r) * DM + e0);
            acc[r] += (w.a[0] * x.a[0] + w.a[1] * x.a[1]) + (w.a[2] * x.a[2] + w.a[3] * x.a[3]) + (w.b[0] * x.b[0] + w.b[1] * x.b[1]) + (w.b[2] * x.b[2] + w.b[3] * x.b[3]); } }
#pragma unroll
    for (int r = 0; r < 8; ++r) { const float t = wave_sum(acc[r]); if (lane == r) out[O_YS + r * DM + d] = t + xs[r * DM + d]; }
}

struct Args { const float* in[21]; float* out; unsigned char* ws; };
__global__ void __launch_bounds__(NT, 2) mk_fwd(Args a) {
    extern __shared__ __attribute__((aligned(16))) unsigned char lds_raw[];
    LAS unsigned char* lds = (LAS unsigned char*)lds_raw;
    cg::grid_group grid = cg::this_grid();
    const int tid = threadIdx.x, lane = tid & 63, wave = __builtin_amdgcn_readfirstlane(tid >> 6);
    const int G = gridDim.x, bx = blockIdx.x;
    unsigned char* ws = a.ws; float* out = a.out;
    bf16_t* xn = (bf16_t*)(ws + WS_XN); bf16_t* winT = (bf16_t*)(ws + WS_WIN); bf16_t* woutT = (bf16_t*)(ws + WS_WOUT);
    bf16_t* wupT = (bf16_t*)(ws + WS_WUP); bf16_t* aupT = (bf16_t*)(ws + WS_AUP);
    bf16_t* zs = (bf16_t*)(ws + WS_ZS); float* yraw = (float*)(ws + WS_YR); bf16_t* mixg = (bf16_t*)(ws + WS_MIX);
    bf16_t* qn = (bf16_t*)(ws + WS_QN); bf16_t* kn = (bf16_t*)(ws + WS_KN); bf16_t* va = (bf16_t*)(ws + WS_VA);
    unsigned char* Eb = ws + WS_E; float* part = (float*)(ws + WS_PART);

#ifndef PROBE_DUP
#define PROBE_DUP 0
#endif
    for (int rep = 0; rep < (PROBE_DUP == 7 ? 2 : 1); ++rep)
    p0_prologue(a.in[0], a.in[1], a.in[6], a.in[7], a.in[10], a.in[12], a.in[20], ws, lds, G, bx, wave, lane, tid);
    grid.sync();
    for (int rep = 0; rep < (PROBE_DUP == 5 ? 2 : 1); ++rep)
    { pg8::Gemm g{xn, winT, MPAD, NPAD, DM}; pg8::StaticOrder S; S.init(MPAD, NPAD, G, bx);
      EpiIn E{zs, mixg, qn, kn, va, out, a.in[18], a.in[19]};
      pg8::gemm_phase<EpiIn, pg8::StaticOrder, true, true>(lds, g, S, E); }
    grid.sync();
    for (int t = bx * NW + wave; t < SA_TASKS; t += G * NW) attn_sample_part(t, qn, kn, va, a.in[4], a.in[5], part, lane);
    for (int rep = 0; rep < (PROBE_DUP == 3 ? 2 : 1); ++rep)
    for (int u = bx; u < 513; u += G) prep_unit(u, zs, Eb, wupT, aupT, a.in[3], a.in[8], a.in[9], a.in[11], a.in[13], a.in[14], wave, lane);
#if PROBE_DUP == 2 || PROBE_DUP == 4
    grid.sync();
#endif
#if PROBE_DUP == 2
    for (int u = bx; u < 512; u += G) attn_unit(u, qn, kn, va, mixg, zs, lds, wave, lane, tid);
#endif
    for (int u = bx; u < 512; u += G) attn_unit(u, qn, kn, va, mixg, mixg, lds, wave, lane, tid);
    grid.sync();
    for (int rep = 0; rep < (PROBE_DUP == 1 ? 2 : 1); ++rep) {
        for (int gw = bx * NW + wave; gw < 2048; gw += G * NW) { const int sbh = gw >> 4, rq = gw & 15, sb = sbh >> 4, h = sbh & 15;
            scan_one(Eb + e_rec(MP + sb, h) * ESTRIDE, rq, a.in[2] + (size_t)sbh * 4096, out + O_WKVS + (size_t)sbh * 4096, yraw + (size_t)(MP + sb) * 1024 + h * 64, lane); }
        const int vcu = (G % 8 == 0) ? (bx % 8) * (G / 8) + bx / 8 : bx;
        for (int pair = vcu; pair < 256; pair += G) scan_pair(pair, Eb, out, yraw, lds, wave, lane);
    }
    grid.sync();
    for (int t = bx * NW + wave; t < MTOT + 128; t += G * NW) { if (t < MTOT) fin_token(t, yraw, Eb, mixg, a.in[16], a.in[17], a.in[15], lane); else attn_sample_combine(t - MTOT, part, mixg, lane); }
    grid.sync();
    for (int rep = 0; rep < (PROBE_DUP == 6 ? 2 : 1); ++rep)
    { pg8::Gemm g{mixg, woutT, MP, DM, DM}; pg8::StaticOrder S; S.init(MP, DM, G, bx);
      EpiOut E{a.in[0], a.in[1], out};
      pg8::gemm_phase<EpiOut, pg8::StaticOrder, true, true>(lds, g, S, E); }
    for (int d = bx * NW + wave; d < DM; d += G * NW) outproj_sample_col(d, mixg, woutT, a.in[1], out, lane);
}

extern "C" void kernel_launch(void* const* d_in, const int* in_sizes, int n_in, void* d_out, int out_size, void* d_ws, size_t ws_size, hipStream_t stream) {
    static int grid = 0;
    if (grid == 0) {
        if (n_in != 21 || ws_size < WS_END) { fprintf(stderr, "kernel_launch: unexpected n_in %d / ws %zu\n", n_in, ws_size); grid = -1; return; }
        int dev = 0, cus = 0, per_cu = 0;
        (void)hipGetDevice(&dev); (void)hipDeviceGetAttribute(&cus, hipDeviceAttributeMultiprocessorCount, dev);
        (void)hipFuncSetAttribute((const void*)mk_fwd, hipFuncAttributeMaxDynamicSharedMemorySize, LDS_BYTES);
        (void)hipOccupancyMaxActiveBlocksPerMultiprocessor(&per_cu, (const void*)mk_fwd, NT, LDS_BYTES);
        if (per_cu < 1) { fprintf(stderr, "kernel_launch: occupancy query reports %d\n", per_cu); per_cu = 1; }
        grid = cus * 1;
        (void)hipGetLastError();
    }
    if (grid < 0) return;
    Args a{};
    for (int i = 0; i < 21; ++i) a.in[i] = (const float*)d_in[i];
    a.out = (float*)d_out; a.ws = (unsigned char*)d_ws;
    void* args[] = {&a};
    hipError_t e = hipLaunchCooperativeKernel((const void*)mk_fwd, dim3(grid), dim3(NT), args, LDS_BYTES, stream);
    if (e != hipSuccess) fprintf(stderr, "cooperative launch failed: %s (grid %d)\n", hipGetErrorString(e), grid);
}
```

```cpp
#include <hip/hip_runtime.h>
#include <hip/hip_cooperative_groups.h>
#include <cstdio>
#include <cstdint>
namespace cg = cooperative_groups;
namespace pg8 {
#define PG8_LAS __attribute__((address_space(3)))
typedef unsigned short bf16_t;
typedef short bf16x8 __attribute__((ext_vector_type(8)));
typedef float f32x4 __attribute__((ext_vector_type(4)));
typedef unsigned u32x4 __attribute__((ext_vector_type(4)));
constexpr int BM = 256, BK = 64, HALF = 128, HTB = HALF * BK * 2, STAGE_BYTES = 8 * HTB, NXCD = 8, WGM = 8;
__host__ __device__ __forceinline__ int lds_byte(int r, int c) { const int st = (r >> 4) * 2 + (c >> 5), rr = r & 15, cc = c & 31, ob = rr * 64 + cc * 2; return st * 1024 + (ob ^ (((ob >> 9) & 1) << 5)); }
__host__ __device__ __forceinline__ void stage_rc(int b, int& R, int& C) { const int st = b / 1024, sb = b % 1024, swz = sb ^ (((sb >> 9) & 1) << 5); R = (st >> 1) * 16 + swz / 64; C = (st & 1) * 32 + (swz % 64) / 2; }
__host__ __device__ __forceinline__ int perm32(int rho) { const int n = rho >> 4, i = rho & 15; return 8 * (i >> 2) + 4 * n + (i & 3); }

struct Unit { int pm, pn; };
struct Gemm { const bf16_t* A; const bf16_t* Bt; int M, N, K; };

struct StaticOrder {
    int nM, nN, nwg, G, c;
    __host__ __device__ void init(int M, int N, int G_, int c_) { nM = M / BM; nN = N / BM; nwg = nM * nN; G = G_; c = c_; }
    __host__ __device__ bool next(int i, Unit& u) const {
        const long L = (long)i * G + c; if (L >= nwg) return false;
        int wgid = (int)L; { const int q = nwg / NXCD, r = nwg % NXCD, xcd = wgid % NXCD, off = wgid / NXCD; wgid = (xcd < r ? xcd * (q + 1) : r * (q + 1) + (xcd - r) * q) + off; }
        const int nig = WGM * nN, gid = wgid / nig, fm = gid * WGM, gsz = (nM - fm) < WGM ? (nM - fm) : WGM;
        u.pm = fm + ((wgid % nig) % gsz); u.pn = (wgid % nig) / gsz; return true;
    }
    __device__ __forceinline__ void a_ready(const Unit&) const {}
    __device__ __forceinline__ void done(const Unit&) const {}
};
template <class Epi, class Sched, bool ALIGN_EPI = false, bool SP2 = false>
__device__ __forceinline__ void gemm_phase(PG8_LAS unsigned char* lds, const Gemm g, const Sched& S, const Epi& E) {
    const int tid = threadIdx.x, wid = __builtin_amdgcn_readfirstlane(tid >> 6), lane = tid & 63, wr = wid >> 2, wc = wid & 3, fr = lane & 15, fq = lane >> 4;
    const int K = g.K, nt = K / BK;
    unsigned voffA[2], voffB[2];
#pragma unroll
    for (int i = 0; i < 2; ++i) { int R, C; stage_rc(tid * 16 + i * 8192, R, C); const int Rb = Epi::PERM ? ((R & ~31) + perm32(R & 31)) : R;
        voffA[i] = (unsigned)(R * K + C) * 2u; voffB[i] = (unsigned)(Rb * K + C) * 2u; }
    const size_t kstep = (size_t)(BK * 2);
    const size_t hstep = (size_t)HALF * K * 2;
    const size_t tstep = 2 * hstep;
    const unsigned ldsw = (unsigned)wid * 1024u;
    const int aoff = lds_byte(wr * 64 + fr, fq * 8), boff = lds_byte(wc * 32 + fr, fq * 8);
#define PG8_SA(b, h) (((b) * 2 + (h)) * HTB)
#define PG8_SB(b, h) ((4 + (b) * 2 + (h)) * HTB)
#define PG8_STAGE(bufoff, gbase, voff) do { _Pragma("unroll") for (int _i = 0; _i < 2; ++_i) \
        __builtin_amdgcn_global_load_lds((const unsigned*)((const char*)(gbase) + (voff)[_i]), (PG8_LAS unsigned*)(lds + (bufoff) + ldsw + _i * 8192), 16, 0, 0); } while (0)
#define PG8_LDA(dst, b, h) do { _Pragma("unroll") for (int m = 0; m < 4; ++m) _Pragma("unroll") for (int k = 0; k < 2; ++k) dst[m][k] = *(const PG8_LAS bf16x8*)(lds + PG8_SA(b, h) + aoff + m * 2048 + k * 1024); } while (0)
#define PG8_LDB(dst, b, h) do { _Pragma("unroll") for (int n = 0; n < 2; ++n) _Pragma("unroll") for (int k = 0; k < 2; ++k) dst[n][k] = *(const PG8_LAS bf16x8*)(lds + PG8_SB(b, h) + boff + n * 2048 + k * 1024); } while (0)
#define PG8_MMA(ai, bj, At, Bt) do { __builtin_amdgcn_s_setprio(1); _Pragma("unroll") for (int m = 0; m < 4; ++m) _Pragma("unroll") for (int n = 0; n < 2; ++n) _Pragma("unroll") for (int k = 0; k < 2; ++k) \
        acc[ai][bj][m][n] = __builtin_amdgcn_mfma_f32_16x16x32_bf16(Bt[n][k], At[m][k], acc[ai][bj][m][n], 0, 0, 0); __builtin_amdgcn_s_setprio(0); } while (0)
#define PG8_WAIT_V(n) asm volatile("s_waitcnt vmcnt(" #n ")" ::: "memory")
#define PG8_WAIT_L(n) asm volatile("s_waitcnt lgkmcnt(" #n ")" ::: "memory")
#define PG8_BAR __builtin_amdgcn_s_barrier()
#define PG8_SCHED __builtin_amdgcn_sched_barrier(0)
    Unit cur, nxt; int ui = 0;
    if (!S.next(0, cur)) return;
    f32x4 acc[2][2][4][2];
#pragma unroll
    for (int a = 0; a < 2; ++a)
#pragma unroll
        for (int b = 0; b < 2; ++b)
#pragma unroll
            for (int m = 0; m < 4; ++m)
#pragma unroll
                for (int n = 0; n < 2; ++n) acc[a][b][m][n] = (f32x4){0.f, 0.f, 0.f, 0.f};
    bf16x8 At[4][2], B0[2][2], B1[2][2];
    const char* cA = (const char*)g.A + (size_t)cur.pm * tstep; const char* cB = (const char*)g.Bt + (size_t)cur.pn * tstep;
    S.a_ready(cur);
    if constexpr (SP2) {
        PG8_STAGE(PG8_SB(0, 0), cB, voffB); PG8_STAGE(PG8_SB(0, 1), cB + hstep, voffB); PG8_STAGE(PG8_SA(0, 0), cA, voffA); PG8_STAGE(PG8_SA(0, 1), cA + hstep, voffA);
        if (wr == 1) PG8_BAR;
        PG8_WAIT_V(2); PG8_BAR;
        PG8_STAGE(PG8_SB(1, 0), cB + kstep, voffB); PG8_STAGE(PG8_SA(1, 0), cA + kstep, voffA); PG8_STAGE(PG8_SB(1, 1), cB + hstep + kstep, voffB);
        PG8_WAIT_V(6); PG8_BAR;
    } else {
        PG8_STAGE(PG8_SB(0, 0), cB, voffB); PG8_STAGE(PG8_SA(0, 0), cA, voffA); PG8_STAGE(PG8_SB(0, 1), cB + hstep, voffB); PG8_STAGE(PG8_SA(0, 1), cA + hstep, voffA);
        if (wr == 1) PG8_BAR;
        PG8_WAIT_V(4); PG8_BAR;
        PG8_STAGE(PG8_SB(1, 0), cB + kstep, voffB); PG8_STAGE(PG8_SA(1, 0), cA + kstep, voffA); PG8_STAGE(PG8_SB(1, 1), cB + hstep + kstep, voffB);
        PG8_WAIT_V(6); PG8_BAR;
    }
    for (;;) {
        const bool has_next = S.next(ui + 1, nxt);
        const char* nA = has_next ? (const char*)g.A + (size_t)nxt.pm * tstep : cA; const char* nB = has_next ? (const char*)g.Bt + (size_t)nxt.pn * tstep : cB;
        for (int t = 0; t < nt; t += 2) {
            const bool last = (t == nt - 2);
            const char* a1 = cA + (size_t)(t + 1) * kstep;
            const char* a2 = last ? nA : cA + (size_t)(t + 2) * kstep; const char* b2 = last ? nB : cB + (size_t)(t + 2) * kstep;
            const char* a3 = a2 + kstep; const char* b3 = b2 + kstep;
            if (last && has_next) S.a_ready(nxt);
            if constexpr (SP2) {
            PG8_LDB(B0, 0, 0); PG8_LDB(B1, 0, 1); PG8_SCHED; PG8_LDA(At, 0, 0); PG8_STAGE(PG8_SA(1, 1), a1 + hstep, voffA);
            PG8_WAIT_V(8); PG8_WAIT_L(0); PG8_BAR; PG8_MMA(0, 0, At, B0); PG8_MMA(0, 1, At, B1); PG8_BAR; PG8_SCHED;
            PG8_LDA(At, 0, 1); PG8_STAGE(PG8_SB(0, 0), b2, voffB); PG8_STAGE(PG8_SB(0, 1), b2 + hstep, voffB); PG8_STAGE(PG8_SA(0, 0), a2, voffA);
            PG8_WAIT_V(8); PG8_WAIT_L(0); PG8_BAR; PG8_MMA(1, 0, At, B0); PG8_MMA(1, 1, At, B1); PG8_BAR; PG8_SCHED;
            PG8_LDB(B0, 1, 0); PG8_LDB(B1, 1, 1); PG8_SCHED; PG8_LDA(At, 1, 0); PG8_STAGE(PG8_SA(0, 1), a2 + hstep, voffA);
            PG8_WAIT_V(8); PG8_WAIT_L(0); PG8_BAR; PG8_MMA(0, 0, At, B0); PG8_MMA(0, 1, At, B1); PG8_BAR; PG8_SCHED;
            PG8_LDA(At, 1, 1); PG8_STAGE(PG8_SB(1, 0), b3, voffB); PG8_STAGE(PG8_SB(1, 1), b3 + hstep, voffB); PG8_STAGE(PG8_SA(1, 0), a3, voffA);
            PG8_WAIT_V(8); PG8_WAIT_L(0); PG8_BAR; PG8_MMA(1, 0, At, B0); PG8_MMA(1, 1, At, B1); PG8_BAR; PG8_SCHED;
            } else {
            PG8_LDB(B0, 0, 0); PG8_SCHED; PG8_LDA(At, 0, 0); PG8_STAGE(PG8_SA(1, 1), a1 + hstep, voffA);
            PG8_WAIT_L(8); PG8_BAR; PG8_WAIT_L(0); PG8_MMA(0, 0, At, B0); PG8_BAR; PG8_SCHED;
            PG8_LDB(B1, 0, 1); PG8_STAGE(PG8_SB(0, 0), b2, voffB);
            PG8_BAR; PG8_WAIT_L(0); PG8_MMA(0, 1, At, B1); PG8_BAR;
            PG8_LDA(At, 0, 1); PG8_STAGE(PG8_SA(0, 0), a2, voffA);
            PG8_BAR; PG8_WAIT_L(0); PG8_MMA(1, 0, At, B0); PG8_BAR; PG8_SCHED;
            PG8_STAGE(PG8_SB(0, 1), b2 + hstep, voffB);
            PG8_WAIT_V(6); PG8_BAR; PG8_MMA(1, 1, At, B1); PG8_BAR;
            PG8_LDB(B0, 1, 0); PG8_SCHED; PG8_LDA(At, 1, 0); PG8_STAGE(PG8_SA(0, 1), a2 + hstep, voffA);
            PG8_WAIT_L(8); PG8_BAR; PG8_WAIT_L(0); PG8_MMA(0, 0, At, B0); PG8_BAR; PG8_SCHED;
            PG8_LDB(B1, 1, 1); PG8_STAGE(PG8_SB(1, 0), b3, voffB);
            PG8_BAR; PG8_WAIT_L(0); PG8_MMA(0, 1, At, B1); PG8_BAR;
            PG8_LDA(At, 1, 1); PG8_STAGE(PG8_SA(1, 0), a3, voffA);
            PG8_BAR; PG8_WAIT_L(0); PG8_MMA(1, 0, At, B0); PG8_BAR; PG8_SCHED;
            PG8_STAGE(PG8_SB(1, 1), b3 + hstep, voffB);
            PG8_WAIT_V(6); PG8_BAR; PG8_MMA(1, 1, At, B1); PG8_BAR;
            }
        }
        if constexpr (ALIGN_EPI) { if (wr == 0) PG8_BAR; }
        if constexpr (!Epi::AFTER_DRAIN) { E(acc, cur, wr, wc, fr, fq); S.done(cur); }
        if (!has_next) break;
#pragma unroll
        for (int a = 0; a < 2; ++a)
#pragma unroll
            for (int b = 0; b < 2; ++b)
#pragma unroll
                for (int m = 0; m < 4; ++m)
#pragma unroll
                    for (int n = 0; n < 2; ++n) acc[a][b][m][n] = (f32x4){0.f, 0.f, 0.f, 0.f};
        cur = nxt; cA = nA; cB = nB; ++ui;
        if constexpr (ALIGN_EPI) { if (wr == 1) PG8_BAR; }
    }
    PG8_WAIT_V(0);
    if constexpr (!ALIGN_EPI) { if (wr == 0) PG8_BAR; }
    PG8_BAR;
    if constexpr (Epi::AFTER_DRAIN) { E.fused(acc, cur, wr, wc, fr, fq, lds, wid, lane); S.done(cur); }
#undef PG8_SA
#undef PG8_SB
#undef PG8_STAGE
#undef PG8_LDA
#undef PG8_LDB
#undef PG8_MMA
#undef PG8_WAIT_V
#undef PG8_WAIT_L
#undef PG8_BAR
#undef PG8_SCHED
}
}
#define GAS __attribute__((address_space(1)))
#define LAS __attribute__((address_space(3)))
typedef unsigned short bf16_t;
typedef short bf16x8 __attribute__((ext_vector_type(8)));
typedef short s16x4 __attribute__((ext_vector_type(4)));
typedef float f32x4 __attribute__((ext_vector_type(4)));
typedef unsigned u32x4 __attribute__((ext_vector_type(4)));
typedef unsigned u32x2 __attribute__((ext_vector_type(2)));
typedef _Float16 h16;
typedef _Float16 h16x4 __attribute__((ext_vector_type(4)));

constexpr int NW = 8, NT = 512;
constexpr int DM = 2048, TSEQ = 4096, MP = 8192, MS = 8, MTOT = 8200, MPAD = 8448;
constexpr int SHW = 3264, NPAD = 8448, DR = 1024;
constexpr size_t MiB = 1u << 20;
constexpr size_t WS_XN = 0, WS_WIN = 33 * MiB, WS_E = 0, WS_WOUT = 97 * MiB, WS_WUP = 105 * MiB, WS_AUP = 105 * MiB + 512 * 1024;
constexpr size_t WS_ZS = 106 * MiB, WS_YR = 106 * MiB, WS_MIX = 159 * MiB, WS_QN = 192 * MiB, WS_KN = WS_QN + 17301504, WS_VA = WS_KN + 17301504, WS_PART = 242 * MiB, WS_BAR = 243 * MiB, WS_END = 244 * MiB;
constexpr int O_Y = 0, O_YS = 16777216, O_WKVP = 16793600, O_SHP = 16924672, O_KP = 16931200, O_VP = 21125504, O_WKVS = 25319808, O_SHS = 25844096, O_KS = 25870208, O_VS = 25878400;
constexpr int LDS_BYTES = 147456;
constexpr int ESTRIDE = 768;

__device__ __forceinline__ unsigned f2bf(float f) { unsigned u = __builtin_bit_cast(unsigned, f); return (u + 0x7fffu + ((u >> 16) & 1u)) >> 16; }
typedef __bf16 bf16x2_hw __attribute__((ext_vector_type(2)));
typedef float f32x2_hw __attribute__((ext_vector_type(2)));
__device__ __forceinline__ unsigned pk2(float lo, float hi) { const f32x2_hw v = {lo, hi}; const bf16x2_hw b = __builtin_convertvector(v, bf16x2_hw); return __builtin_bit_cast(unsigned, b); }
__device__ __forceinline__ float bf2f(unsigned short b) { return __builtin_bit_cast(float, (unsigned)b << 16); }
__device__ __forceinline__ float bflo(unsigned w) { return __builtin_bit_cast(float, w << 16); }
__device__ __forceinline__ float bfhi(unsigned w) { return __builtin_bit_cast(float, w & 0xffff0000u); }
__device__ __forceinline__ float wave_sum(float v) {
#pragma unroll
    for (int o = 1; o < 64; o <<= 1) v += __shfl_xor(v, o);
    return v;
}
__device__ __forceinline__ float wave_max(float v) {
#pragma unroll
    for (int o = 1; o < 64; o <<= 1) v = fmaxf(v, __shfl_xor(v, o));
    return v;
}
__device__ __forceinline__ float silu_f(float x) { return x / (1.f + __expf(-x)); }
__device__ __forceinline__ float sigmoid_f(float x) { return 1.f / (1.f + __expf(-x)); }
#define LDS_WAIT() asm volatile("s_waitcnt lgkmcnt(0)" ::: "memory")

struct EpiIn {
    static constexpr bool PERM = true, AFTER_DRAIN = false;
    bf16_t *zs, *mixg, *qn, *kn, *va; float* out; const float *qnw, *knw;
    __device__ __forceinline__ void shift_out(int row, int col, f32x4 v0, f32x4 v1) const {
        float* dst = nullptr;
        if (row == TSEQ - 1) dst = out + O_SHP + col;
        else if (row == 2 * TSEQ - 1) dst = out + O_SHP + SHW + col;
        else if (row >= MP && row < MTOT) dst = out + O_SHS + (row - MP) * SHW + col;
        if (dst) { *(f32x4*)dst = v0; *(f32x4*)(dst + 4) = v1; }
    }
    __device__ __forceinline__ void operator()(const f32x4 (&acc)[2][2][4][2], const pg8::Unit& u, int wr, int wc, int fr, int fq) const {
        const int pn = u.pn, sec = pn >> 2;
        const int rowb = u.pm * 256 + wr * 64 + fr;
        if (pn == 32) {
#pragma unroll
            for (int ai = 0; ai < 2; ++ai)
#pragma unroll
                for (int m = 0; m < 4; ++m) { const int row = rowb + ai * 128 + m * 16;
#pragma unroll
                    for (int bj = 0; bj < 2; ++bj) { const int p0 = 128 * bj + 32 * wc + 8 * fq;
                        if (p0 < 192) { const f32x4 v0 = acc[ai][bj][m][0], v1 = acc[ai][bj][m][1];
                            u32x4 w; w.x = pk2(v0[0], v0[1]); w.y = pk2(v0[2], v0[3]); w.z = pk2(v1[0], v1[1]); w.w = pk2(v1[2], v1[3]);
                            *(u32x4*)(zs + (size_t)row * SHW + 3072 + p0) = w;
                            shift_out(row, 3072 + p0, v0, v1); } } }
            return;
        }
        const int lcb = (pn & 3) * 256 + wc * 64 + fq * 8;
        if (sec <= 2) {
#pragma unroll
            for (int ai = 0; ai < 2; ++ai)
#pragma unroll
                for (int m = 0; m < 4; ++m) { const int row = rowb + ai * 128 + m * 16;
#pragma unroll
                    for (int bj = 0; bj < 2; ++bj) { const int col = sec * 1024 + lcb + bj * 32; const f32x4 v0 = acc[ai][bj][m][0], v1 = acc[ai][bj][m][1];
                        u32x4 w; w.x = pk2(v0[0], v0[1]); w.y = pk2(v0[2], v0[3]); w.z = pk2(v1[0], v1[1]); w.w = pk2(v1[2], v1[3]);
                        *(u32x4*)(zs + (size_t)row * SHW + col) = w;
                        shift_out(row, col, v0, v1); } }
        } else if (sec == 3 || sec == 7) {
            const int cb = (sec == 7 ? 1024 : 0) + lcb;
#pragma unroll
            for (int ai = 0; ai < 2; ++ai)
#pragma unroll
                for (int m = 0; m < 4; ++m) { const int row = rowb + ai * 128 + m * 16;
#pragma unroll
                    for (int bj = 0; bj < 2; ++bj) { const f32x4 v0 = acc[ai][bj][m][0], v1 = acc[ai][bj][m][1];
                        u32x4 w; w.x = pk2(silu_f(v0[0]), silu_f(v0[1])); w.y = pk2(silu_f(v0[2]), silu_f(v0[3])); w.z = pk2(silu_f(v1[0]), silu_f(v1[1])); w.w = pk2(silu_f(v1[2]), silu_f(v1[3]));
                        *(u32x4*)(mixg + (size_t)row * 2048 + cb + bj * 32) = w; } }
        } else if (sec == 6) {
#pragma unroll
            for (int ai = 0; ai < 2; ++ai)
#pragma unroll
                for (int m = 0; m < 4; ++m) { const int row = rowb + ai * 128 + m * 16;
                    float* dst = nullptr; const int t = row & (TSEQ - 1);
                    if (row < MP) { if (t >= 2048) dst = out + O_VP + ((size_t)((row >> 12) * 2048 + (t - 2048))) * 1024; }
                    else if (row < MTOT) dst = out + O_VS + (size_t)(row - MP) * 1024;
#pragma unroll
                    for (int bj = 0; bj < 2; ++bj) { const int col = lcb + bj * 32; const f32x4 v0 = acc[ai][bj][m][0], v1 = acc[ai][bj][m][1];
                        u32x4 w; w.x = pk2(v0[0], v0[1]); w.y = pk2(v0[2], v0[3]); w.z = pk2(v1[0], v1[1]); w.w = pk2(v1[2], v1[3]);
                        *(u32x4*)(va + (size_t)row * 1024 + col) = w;
                        if (dst) { *(f32x4*)(dst + col) = v0; *(f32x4*)(dst + col + 4) = v1; } } }
        } else {
            const bool isq = (sec == 4);
            const float* nwp = isq ? qnw : knw; const float sc = isq ? 0.125f : 1.0f;
            f32x4 nw[2][2];
#pragma unroll
            for (int bj = 0; bj < 2; ++bj) { nw[bj][0] = *(const f32x4*)(nwp + bj * 32 + fq * 8); nw[bj][1] = *(const f32x4*)(nwp + bj * 32 + fq * 8 + 4); }
            bf16_t* ob = isq ? qn : kn;
#pragma unroll
            for (int ai = 0; ai < 2; ++ai)
#pragma unroll
                for (int m = 0; m < 4; ++m) { const int row = rowb + ai * 128 + m * 16;
                    float ss = 0.f;
#pragma unroll
                    for (int bj = 0; bj < 2; ++bj)
#pragma unroll
                        for (int n = 0; n < 2; ++n) { const f32x4 x = acc[ai][bj][m][n]; ss += (x[0] * x[0] + x[1] * x[1]) + (x[2] * x[2] + x[3] * x[3]); }
                    ss += __shfl_xor(ss, 16); ss += __shfl_xor(ss, 32);
                    const float rs = rsqrtf(ss * (1.f / 64.f) + 1e-6f) * sc;
                    float* dst = nullptr; const int t = row & (TSEQ - 1);
                    if (!isq) { if (row < MP) { if (t >= 2048) dst = out + O_KP + ((size_t)((row >> 12) * 2048 + (t - 2048))) * 1024; }
                                else if (row < MTOT) dst = out + O_KS + (size_t)(row - MP) * 1024; }
#pragma unroll
                    for (int bj = 0; bj < 2; ++bj) { const int col = lcb + bj * 32; const f32x4 v0 = acc[ai][bj][m][0] * rs * nw[bj][0], v1 = acc[ai][bj][m][1] * rs * nw[bj][1];
                        u32x4 w; w.x = pk2(v0[0], v0[1]); w.y = pk2(v0[2], v0[3]); w.z = pk2(v1[0], v1[1]); w.w = pk2(v1[2], v1[3]);
                        *(u32x4*)(ob + (size_t)row * 1024 + col) = w;
                        if (dst) { *(f32x4*)(dst + col) = v0; *(f32x4*)(dst + col + 4) = v1; } } }
        }
    }
};
struct EpiOut {
    static constexpr bool PERM = true, AFTER_DRAIN = false;
    const float *xp, *xs; float* out;
    __device__ __forceinline__ void operator()(const f32x4 (&acc)[2][2][4][2], const pg8::Unit& u, int wr, int wc, int fr, int fq) const {
        const int rowb = u.pm * 256 + wr * 64 + fr, colb = u.pn * 256 + wc * 32 + fq * 8;
#pragma unroll
        for (int ai = 0; ai < 2; ++ai)
#pragma unroll
            for (int m = 0; m < 4; ++m) { const int row = rowb + ai * 128 + m * 16;
                const float* xr; float* orow;
                if (row < MP) { xr = xp + (size_t)row * DM; orow = out + O_Y + (size_t)row * DM; }
                else if (row < MTOT) { xr = xs + (size_t)(row - MP) * DM; orow = out + O_YS + (size_t)(row - MP) * DM; }
                else continue;
#pragma unroll
                for (int bj = 0; bj < 2; ++bj) { const int col = colb + bj * 128;
                    *(f32x4*)(orow + col) = acc[ai][bj][m][0] + *(const f32x4*)(xr + col);
                    *(f32x4*)(orow + col + 4) = acc[ai][bj][m][1] + *(const f32x4*)(xr + col + 4); } }
    }
};

__device__ __forceinline__ void p0_transpose_item(const float* W, int Nsrc, int src_n0, int k0, bf16_t* WT, int dst_row0, int Kdst, LAS float* scr, int lane) {
    if (src_n0 < 0) {
        const int c = lane & 7;
#pragma unroll
        for (int j = 0; j < 4; ++j) { const int n = (lane >> 3) + 8 * j; *(u32x4*)(WT + (size_t)(dst_row0 + n) * Kdst + k0 + 8 * c) = (u32x4){0u, 0u, 0u, 0u}; }
        return;
    }
    {
        f32x4 t[8];
#pragma unroll
        for (int i = 0; i < 8; ++i) { const int kk = 8 * i + (lane >> 3); t[i] = *(const f32x4*)(W + (size_t)(k0 + kk) * Nsrc + src_n0 + 4 * (lane & 7)); }
#pragma unroll
        for (int i = 0; i < 8; ++i) { const int kk = 8 * i + (lane >> 3); LAS float* d = scr + kk * 33 + 4 * (lane & 7); d[0] = t[i].x; d[1] = t[i].y; d[2] = t[i].z; d[3] = t[i].w; }
    }
    LDS_WAIT(); asm volatile("" ::: "memory");
    const int c = lane & 7;
#pragma unroll
    for (int j = 0; j < 4; ++j) { const int n = (lane >> 3) + 8 * j; const LAS float* s = scr + (8 * c) * 33 + n;
        u32x4 o; o.x = pk2(s[0 * 33], s[1 * 33]); o.y = pk2(s[2 * 33], s[3 * 33]); o.z = pk2(s[4 * 33], s[5 * 33]); o.w = pk2(s[6 * 33], s[7 * 33]);
        *(u32x4*)(WT + (size_t)(dst_row0 + n) * Kdst + k0 + 8 * c) = o; }
    LDS_WAIT(); asm volatile("" ::: "memory");
}
__device__ __forceinline__ int win_src_col(int n0) {
    const int T = n0 >> 8, p = n0 & 255;
    if (T < 32) { const int s = T >> 2, ts = T & 3, bj = p >> 7, wc = (p & 127) >> 5; const int lc = ts * 256 + wc * 64 + bj * 32;
        return (s < 3 ? s * 1024 : SHW + (s - 3) * 1024) + lc; }
    return p < 192 ? 3072 + p : -1;
}
__device__ __forceinline__ void p0_prologue(const float* xp, const float* xs, const float* nwp, const float* w_in, const float* w_up, const float* a_up, const float* w_out, unsigned char* ws, LAS unsigned char* lds, int G, int bx, int wave, int lane, int tid) {
    LAS float* scr = (LAS float*)(lds + wave * 16384);
    const int gw = bx * NW + wave, NGW = G * NW;
    bf16_t* winT = (bf16_t*)(ws + WS_WIN); bf16_t* woutT = (bf16_t*)(ws + WS_WOUT);
    constexpr int I_IN = 32 * (NPAD / 32), I_OUT = 32 * (DM / 32);
    for (int it = gw; it < I_IN + I_OUT; it += NGW) {
        if (it < I_IN) { const int kb = it / (NPAD / 32), nb = it % (NPAD / 32); p0_transpose_item(w_in, 8384, win_src_col(nb * 32), kb * 64, winT, nb * 32, DM, scr, lane); }
        else { const int r = it - I_IN; const int kb = r / (DM / 32), nb = r % (DM / 32); p0_transpose_item(w_out, DM, nb * 32, kb * 64, woutT, nb * 32, DM, scr, lane); }
    }
    { bf16_t* wupT = (bf16_t*)(ws + WS_WUP); bf16_t* aupT = (bf16_t*)(ws + WS_AUP);
      for (int i = bx * NT + tid; i < 2 * 1024 * 12; i += G * NT) { const int which = i / 12288, r = i % 12288, n = r / 12, c = r % 12;
          const float* W = which ? a_up : w_up; bf16_t* D = which ? aupT : wupT;
          u32x4 o; o.x = pk2(W[(8 * c + 0) * 1024 + n], W[(8 * c + 1) * 1024 + n]); o.y = pk2(W[(8 * c + 2) * 1024 + n], W[(8 * c + 3) * 1024 + n]);
          o.z = pk2(W[(8 * c + 4) * 1024 + n], W[(8 * c + 5) * 1024 + n]); o.w = pk2(W[(8 * c + 6) * 1024 + n], W[(8 * c + 7) * 1024 + n]);
          *(u32x4*)(D + n * 96 + 8 * c) = o; } }
    bf16_t* xn = (bf16_t*)(ws + WS_XN);
    for (int m = gw; m < MPAD; m += NGW) {
        u32x2* o8 = (u32x2*)(xn + (size_t)m * DM) + lane;
        if (m >= MTOT) {
#pragma unroll
            for (int j = 0; j < 8; ++j) o8[64 * j] = (u32x2){0u, 0u};
            continue; }
        const float* xrow = m < MP ? xp + (size_t)m * DM : xs + (size_t)(m - MP) * DM;
        const f32x4* xr = (const f32x4*)xrow + lane;
        f32x4 v[8]; float s = 0.f;
#pragma unroll
        for (int j = 0; j < 8; ++j) { v[j] = xr[64 * j]; s += (v[j].x * v[j].x + v[j].y * v[j].y) + (v[j].z * v[j].z + v[j].w * v[j].w); }
        const float rstd = rsqrtf(wave_sum(s) * (1.f / DM) + 1e-6f);
#pragma unroll
        for (int j = 0; j < 8; ++j) { const f32x4 g = ((const f32x4*)nwp)[lane + 64 * j]; const f32x4 y = v[j] * rstd * g;
            o8[64 * j] = (u32x2){pk2(y.x, y.y), pk2(y.z, y.w)}; }
    }
}
__device__ __forceinline__ size_t e_rec(int m, int h) { return m < MP ? ((size_t)((m >> 12) * 16 + h) * TSEQ + (m & (TSEQ - 1))) : ((size_t)32 * TSEQ + (size_t)(m - MP) * 16 + h); }
struct F8 { f32x4 a, b; };
__device__ __forceinline__ F8 ld_bf8(const bf16_t* p) { const u32x4 w = *(const u32x4*)p; F8 r; r.a = (f32x4){bflo(w.x), bfhi(w.x), bflo(w.y), bfhi(w.y)}; r.b = (f32x4){bflo(w.z), bfhi(w.z), bflo(w.w), bfhi(w.w)}; return r; }
__device__ __forceinline__ F8 ld_prev8(const bf16_t* zs, const float* sst, int m, int col) {
    F8 r;
    if (m >= MP) { const float* p = sst + (m - MP) * SHW + col; r.a = *(const f32x4*)p; r.b = *(const f32x4*)(p + 4); return r; }
    if ((m & (TSEQ - 1)) == 0) { r.a = (f32x4){0.f, 0.f, 0.f, 0.f}; r.b = r.a; return r; }
    return ld_bf8(zs + (size_t)(m - 1) * SHW + col);
}
__device__ __forceinline__ float ld_prev1(const bf16_t* zs, const float* sst, int m, int col) {
    if (m >= MP) return sst[(m - MP) * SHW + col];
    if ((m & (TSEQ - 1)) == 0) return 0.f;
    return bf2f(zs[(size_t)(m - 1) * SHW + col]);
}
__device__ __forceinline__ float tanh_f(float x) { return 1.f - 2.f / (1.f + __expf(2.f * x)); }
__device__ __forceinline__ bf16x8 pack_bf8(f32x4 a, f32x4 b) { u32x4 w; w.x = pk2(a[0], a[1]); w.y = pk2(a[2], a[3]); w.z = pk2(b[0], b[1]); w.w = pk2(b[2], b[3]); return __builtin_bit_cast(bf16x8, w); }

struct F4 { float v[4]; };
__device__ __forceinline__ f32x4 cv_bf4(u32x2 w) { return (f32x4){bflo(w.x), bfhi(w.x), bflo(w.y), bfhi(w.y)}; }
__device__ __forceinline__ f32x4 ld_bf4(const bf16_t* p) { const u32x2 w = *(const u32x2*)p; return (f32x4){bflo(w.x), bfhi(w.x), bflo(w.y), bfhi(w.y)}; }
__device__ __forceinline__ f32x4 ld_prev4(const bf16_t* zs, const float* sst, int m, int col) {
    if (m >= MP) return *(const f32x4*)(sst + (m - MP) * SHW + col);
    if ((m & (TSEQ - 1)) == 0) return (f32x4){0.f, 0.f, 0.f, 0.f};
    return ld_bf4(zs + (size_t)(m - 1) * SHW + col);
}
typedef _Float16 h16x4s __attribute__((ext_vector_type(4)));
__device__ __forceinline__ void st_h4l(LAS unsigned char* p, f32x4 v) { h16x4s h; h[0] = (h16)v[0]; h[1] = (h16)v[1]; h[2] = (h16)v[2]; h[3] = (h16)v[3]; *(LAS h16x4s*)p = h; }
__device__ __forceinline__ void st_h4(unsigned char* p, f32x4 v) { h16x4s h; h[0] = (h16)v[0]; h[1] = (h16)v[1]; h[2] = (h16)v[2]; h[3] = (h16)v[3]; *(h16x4s*)p = h; }
__device__ __forceinline__ int m_of(int tg, int lane) { return 16 * tg + (lane & 15); }
template <bool SAMP> __device__ __forceinline__ F8 prev8(const bf16_t* zs, const float* sst, int m, int col, bool first) {
    if (SAMP) { const float* p = sst + (m - MP) * SHW + col; F8 r; r.a = *(const f32x4*)p; r.b = *(const f32x4*)(p + 4); return r; }
    F8 r = ld_bf8(zs + (size_t)(m - (first ? 0 : 1)) * SHW + col); const float z = first ? 0.f : 1.f; r.a = r.a * z; r.b = r.b * z; return r;
}
template <bool SAMP> __device__ __forceinline__ f32x4 prev4(const bf16_t* zs, const float* sst, int m, int col, bool first) {
    if (SAMP) return *(const f32x4*)(sst + (m - MP) * SHW + col);
    const f32x4 r = ld_bf4(zs + (size_t)(m - (first ? 0 : 1)) * SHW + col); return r * (first ? 0.f : 1.f);
}
template <bool SAMP> __device__ __forceinline__ void prep_unit_t(int tg, const bf16_t* __restrict__ zs, unsigned char* __restrict__ Eb, const bf16_t* wupT, const bf16_t* aupT, const float* sst, const float* mu,
                                          const float* w0, const float* a0, const float* k_k, const float* k_a, int wave, int lane, LAS unsigned char* stg, bool do_store = true) {
    const int q = lane & 15, g = lane >> 4;
    constexpr bool samp = SAMP;
    const bool first = !SAMP && ((m_of(tg, lane) & (TSEQ - 1)) == 0);
    const int m = samp ? MP + (q < 8 ? q : 7) : 16 * tg + q;
    const bool wr_ok = !(samp && q >= 8) && do_store;
    bf16x8 Bw[3], Ba[3];
#pragma unroll
    for (int ks = 0; ks < 3; ++ks) {
        { const int col = 3072 + 32 * ks + 8 * g; const F8 c = ld_bf8(zs + (size_t)m * SHW + col), p = prev8<SAMP>(zs, sst, m, col, first);
          const f32x4 m0 = *(const f32x4*)(mu + col), m1 = *(const f32x4*)(mu + col + 4);
          f32x4 xa = c.a + m0 * (p.a - c.a), xb = c.b + m1 * (p.b - c.b);
#pragma unroll
          for (int i = 0; i < 4; ++i) { xa[i] = tanh_f(xa[i]); xb[i] = tanh_f(xb[i]); }
          Bw[ks] = pack_bf8(xa, xb); }
        { const int col = 3168 + 32 * ks + 8 * g; const F8 c = ld_bf8(zs + (size_t)m * SHW + col), p = prev8<SAMP>(zs, sst, m, col, first);
          const f32x4 m0 = *(const f32x4*)(mu + col), m1 = *(const f32x4*)(mu + col + 4);
          const f32x4 xa = c.a + m0 * (p.a - c.a), xb = c.b + m1 * (p.b - c.b);
          Ba[ks] = pack_bf8(xa, xb); }
    }
#pragma unroll 1
    for (int hh = 0; hh < (SAMP ? 1 : 2); ++hh) {
        const int h = SAMP ? wave : 2 * wave + hh;
        unsigned char* erec = Eb + e_rec(m, h) * ESTRIDE;
        f32x4 kkr[4], av[4]; float ss = 0.f;
        u32x2 zrc[4], zkc[4], zvc[4], zrp[4], zkp[4], zvp[4];
        const size_t prow = (size_t)(SAMP ? m : m - (first ? 0 : 1)) * SHW;
#pragma unroll
        for (int j = 0; j < 4; ++j) { const int ch = h * 64 + 16 * j + 4 * g;
            zrc[j] = *(const u32x2*)(zs + (size_t)m * SHW + ch); zkc[j] = *(const u32x2*)(zs + (size_t)m * SHW + 1024 + ch); zvc[j] = *(const u32x2*)(zs + (size_t)m * SHW + 2048 + ch);
            zrp[j] = *(const u32x2*)(zs + prow + ch); zkp[j] = *(const u32x2*)(zs + prow + 1024 + ch); zvp[j] = *(const u32x2*)(zs + prow + 2048 + ch); }
#pragma unroll
        for (int j = 0; j < 4; ++j) {
            const int chA = h * 64 + 16 * j + q;
            const int ch = h * 64 + 16 * j + 4 * g;
            f32x4 cw = (f32x4){0.f, 0.f, 0.f, 0.f}, ca = cw;
#pragma unroll
            for (int ks = 0; ks < 3; ++ks) {
                const bf16x8 aw = *(const bf16x8*)(wupT + chA * 96 + 32 * ks + 8 * g), aa = *(const bf16x8*)(aupT + chA * 96 + 32 * ks + 8 * g);
                cw = __builtin_amdgcn_mfma_f32_16x16x32_bf16(aw, Bw[ks], cw, 0, 0, 0);
                ca = __builtin_amdgcn_mfma_f32_16x16x32_bf16(aa, Ba[ks], ca, 0, 0, 0);
            }
            const f32x4 w0c = *(const f32x4*)(w0 + ch), a0c = *(const f32x4*)(a0 + ch), kkc = *(const f32x4*)(k_k + ch), kac = *(const f32x4*)(k_a + ch);
            const f32x4 mur = *(const f32x4*)(mu + ch), muk = *(const f32x4*)(mu + 1024 + ch), muv = *(const f32x4*)(mu + 2048 + ch);
            const f32x4 rc = cv_bf4(zrc[j]), kc = cv_bf4(zkc[j]), vc = cv_bf4(zvc[j]);
            f32x4 rp, kp, vp;
            if (SAMP) { rp = *(const f32x4*)(sst + (m - MP) * SHW + ch); kp = *(const f32x4*)(sst + (m - MP) * SHW + 1024 + ch); vp = *(const f32x4*)(sst + (m - MP) * SHW + 2048 + ch); }
            else { const float z = first ? 0.f : 1.f; rp = cv_bf4(zrp[j]) * z; kp = cv_bf4(zkp[j]) * z; vp = cv_bf4(zvp[j]) * z; }
            const f32x4 rv = rc + mur * (rp - rc), vv = vc + muv * (vp - vc), km = kc + muk * (kp - kc);
            f32x4 a, u;
#pragma unroll
            for (int c = 0; c < 4; ++c) { a[c] = sigmoid_f(a0c[c] + ca[c]); u[c] = expm1f(-0.60653065971f * sigmoid_f(w0c[c] + cw[c])); }
            const f32x4 kr = km * kkc; kkr[j] = kr; av[j] = a; ss += (kr[0] * kr[0] + kr[1] * kr[1]) + (kr[2] * kr[2] + kr[3] * kr[3]);
            if (SAMP) { if (wr_ok) { unsigned char* e = erec + (16 * j + 4 * g) * 2;
                st_h4(e, u); st_h4(e + 128, km * (1.f + (a - 1.f) * kac)); st_h4(e + 512, rv); st_h4(e + 640, vv); } }
            else { LAS unsigned char* e = stg + q * 784 + (16 * j + 4 * g) * 2;
                st_h4l(e, u); st_h4l(e + 128, km * (1.f + (a - 1.f) * kac)); st_h4l(e + 512, rv); st_h4l(e + 640, vv); }
        }
        ss += __shfl_xor(ss, 16); ss += __shfl_xor(ss, 32);
        const float inv = 1.f / fmaxf(sqrtf(ss), 1e-12f);
        if (SAMP) { if (wr_ok) {
#pragma unroll
            for (int j = 0; j < 4; ++j) { unsigned char* e = erec + (16 * j + 4 * g) * 2; const f32x4 kk = kkr[j] * inv;
                st_h4(e + 256, -kk); st_h4(e + 384, kk * av[j]); } } }
        else {
#pragma unroll
            for (int j = 0; j < 4; ++j) { LAS unsigned char* e = stg + q * 784 + (16 * j + 4 * g) * 2; const f32x4 kk = kkr[j] * inv;
                st_h4l(e + 256, -kk); st_h4l(e + 384, kk * av[j]); }
            LDS_WAIT(); asm volatile("" ::: "memory");
            unsigned char* gb = Eb + e_rec(16 * tg, h) * ESTRIDE;
            if (do_store) {
#pragma unroll
                for (int it = 0; it < 12; ++it) { const int x = it * 64 + lane; const u32x4 w = *(const LAS u32x4*)(stg + (x / 48) * 784 + (x % 48) * 16); *(u32x4*)(gb + (size_t)x * 16) = w; }
            }
            LDS_WAIT(); asm volatile("" ::: "memory");
        }
    }
}

__device__ __forceinline__ void prep_unit(int tg, const bf16_t* zs, unsigned char* Eb, const bf16_t* wupT, const bf16_t* aupT, const float* sst, const float* mu,
                                          const float* w0, const float* a0, const float* k_k, const float* k_a, int wave, int lane, LAS unsigned char* lds, bool do_store = true) {
    LAS unsigned char* stg = lds + wave * (16 * 784);
    if (tg >= 512) prep_unit_t<true>(tg, zs, Eb, wupT, aupT, sst, mu, w0, a0, k_k, k_a, wave  , lane, stg, do_store);
    else prep_unit_t<false>(tg, zs, Eb, wupT, aupT, sst, mu, w0, a0, k_k, k_a, wave, lane, stg, do_store);
}

__device__ __forceinline__ s16x4 tr_read(LAS unsigned char* p) { return __builtin_bit_cast(s16x4, __builtin_amdgcn_ds_read_tr16_b64_v4i16((LAS s16x4*)p)); }
constexpr int ACC_PITCH = 68;
__device__ __forceinline__ void attn_pair_shared(int p, int wave, int mb, int tb, int h, float slope, const bf16_t* qn, const bf16_t* kn, const bf16_t* va,
                                                 LAS float* accL, LAS float* mL, LAS float* lL, LAS unsigned char* vst, int lane) {
    const int q = lane & 15, g = lane >> 4;
    const int d = p == 0 ? 1 : 4;
    const float sd = slope * (float)d;
    const int base = p == 0 ? 32 * wave : (wave & 3) + 128 * (wave >> 2);
    const int tok0 = tb + base;
    bf16x8 qa[2], qb[2]; float m_run[2], l_run[2]; f32x4 O[2][4];
#pragma unroll
    for (int j = 0; j < 2; ++j) {
        const bf16_t* qp = qn + (size_t)(mb + tok0 + (16 * j + q) * d) * 1024 + h * 64 + 8 * g;
        qa[j] = *(const bf16x8*)qp; qb[j] = *(const bf16x8*)(qp + 32);
        m_run[j] = -INFINITY; l_run[j] = 0.f;
#pragma unroll
        for (int i = 0; i < 4; ++i) O[j][i] = (f32x4){0.f, 0.f, 0.f, 0.f};
    }
#define AP_LOADKV(KS, KA, KB, V0, V1) do { int _kt = tok0 + (16 * (KS) + q - 128) * d; _kt = _kt < 0 ? 0 : _kt; const bf16_t* _kp = kn + (size_t)(mb + _kt) * 1024 + h * 64 + 8 * g; \
        KA = *(const bf16x8*)_kp; KB = *(const bf16x8*)(_kp + 32); int _vt = tok0 + (16 * (KS) + (lane >> 2) - 128) * d; _vt = _vt < 0 ? 0 : _vt; \
        const bf16_t* _vp = va + (size_t)(mb + _vt) * 1024 + h * 64 + 16 * (lane & 3); V0 = *(const u32x4*)_vp; V1 = *(const u32x4*)(_vp + 8); } while (0)
    bf16x8 nka, nkb; u32x4 nv0, nv1;
    AP_LOADKV(0, nka, nkb, nv0, nv1);
#pragma unroll 1
    for (int ks = 0; ks < 10; ++ks) {
        const bf16x8 ka = nka, kb = nkb; const u32x4 v0 = nv0, v1 = nv1;
        { const int kn1 = ks < 9 ? ks + 1 : 9; AP_LOADKV(kn1, nka, nkb, nv0, nv1); }
        asm volatile("" ::: "memory");
        *(LAS u32x4*)(vst + (lane >> 2) * 144 + (lane & 3) * 32) = v0; *(LAS u32x4*)(vst + (lane >> 2) * 144 + (lane & 3) * 32 + 16) = v1;
        s16x4 pb[2];
#pragma unroll
        for (int j = 0; j < 2; ++j) {
            f32x4 S = (f32x4){0.f, 0.f, 0.f, 0.f};
            S = __builtin_amdgcn_mfma_f32_16x16x32_bf16(ka, qa[j], S, 0, 0, 0);
            S = __builtin_amdgcn_mfma_f32_16x16x32_bf16(kb, qb[j], S, 0, 0, 0);
            float s[4]; float mx = -INFINITY;
#pragma unroll
            for (int c = 0; c < 4; ++c) { const int ki = 16 * ks + 4 * g + c; const int off = 16 * j + q + 128 - ki; const int ktok = tok0 + (ki - 128) * d;
                const bool valid = (off >= 0) && (off <= 128) && (ktok >= 0);
                s[c] = valid ? S[c] - sd * (float)off : -INFINITY; mx = fmaxf(mx, s[c]); }
            mx = fmaxf(mx, __shfl_xor(mx, 16)); mx = fmaxf(mx, __shfl_xor(mx, 32));
            const float m_new = fmaxf(m_run[j], mx);
            float sc = 1.f, pe[4] = {0.f, 0.f, 0.f, 0.f};
            if (m_new > -INFINITY) { sc = __expf(m_run[j] - m_new);
#pragma unroll
                for (int c = 0; c < 4; ++c) pe[c] = __expf(s[c] - m_new); }
            l_run[j] = l_run[j] * sc + ((pe[0] + pe[1]) + (pe[2] + pe[3])); m_run[j] = m_new;
#pragma unroll
            for (int i = 0; i < 4; ++i) O[j][i] = O[j][i] * sc;
            u32x2 pw; pw.x = pk2(pe[0], pe[1]); pw.y = pk2(pe[2], pe[3]);
            pb[j] = __builtin_bit_cast(s16x4, pw);
        }
        LDS_WAIT(); asm volatile("" ::: "memory");
#pragma unroll
        for (int blk = 0; blk < 4; ++blk) {
            const s16x4 vtr = tr_read(vst + (4 * g + ((lane & 15) >> 2)) * 144 + (16 * blk + 4 * (lane & 3)) * 2);
            O[0][blk] = __builtin_amdgcn_mfma_f32_16x16x16bf16_1k(vtr, pb[0], O[0][blk], 0, 0, 0);
            O[1][blk] = __builtin_amdgcn_mfma_f32_16x16x16bf16_1k(vtr, pb[1], O[1][blk], 0, 0, 0);
        }
        LDS_WAIT(); asm volatile("" ::: "memory");
    }
#undef AP_LOADKV
#pragma unroll
    for (int j = 0; j < 2; ++j) {
        float lr = l_run[j]; lr += __shfl_xor(lr, 16); lr += __shfl_xor(lr, 32);
        const int ti = base + (16 * j + q) * d;
        LAS float* ar = accL + ti * ACC_PITCH + 4 * g;
        if (p == 0) {
#pragma unroll
            for (int blk = 0; blk < 4; ++blk) *(LAS f32x4*)(ar + 16 * blk) = O[j][blk];
            if (g == 0) { mL[ti] = m_run[j]; lL[ti] = lr; }
        } else {
            const float mo = mL[ti], lo = lL[ti];
            const float mn = fmaxf(mo, m_run[j]), ao = __expf(mo - mn), an = __expf(m_run[j] - mn);
#pragma unroll
            for (int blk = 0; blk < 4; ++blk) { const f32x4 old = *(LAS f32x4*)(ar + 16 * blk); *(LAS f32x4*)(ar + 16 * blk) = old * ao + O[j][blk] * an; }
            LDS_WAIT(); asm volatile("" ::: "memory");
            if (g == 0) { mL[ti] = mn; lL[ti] = lo * ao + lr * an; }
        }
    }
}
__device__ __forceinline__ void attn_unit(int unit, const bf16_t* qn, const bf16_t* kn, const bf16_t* va, const bf16_t* mixg, bf16_t* mixo, LAS unsigned char* lds, int wave, int lane, int tid) {
    const int b = unit >> 8, h = (unit >> 4) & 15, sp = unit & 15;
    const int mb = b * TSEQ, tb = sp * 256;
    LAS float* accL = (LAS float*)lds; LAS float* mL = (LAS float*)(lds + 256 * ACC_PITCH * 4); LAS float* lL = mL + 256;
    LAS unsigned char* vst = lds + 256 * ACC_PITCH * 4 + 2048 + wave * 2304;
    const int q = lane & 15, g = lane >> 4;
    const float slope = exp2f(-0.5f * (float)(h + 1));
#pragma unroll 1
    for (int p = 0; p < 3; ++p) {
        const int d = p == 0 ? 1 : (p == 1 ? 4 : 16);
        const float sd = slope * (float)d;
        if (p < 2) { attn_pair_shared(p, wave, mb, tb, h, slope, qn, kn, va, accL, mL, lL, vst, lane); __syncthreads(); continue; }
#pragma unroll 1
        for (int tt = 0; tt < 2; ++tt) {
            const int tile = 2 * wave + tt;
            const int base = p == 0 ? 16 * tile : (p == 1 ? 64 * (tile >> 2) + (tile & 3) : tile);
            const int tok0 = tb + base;
            const bf16_t* qp = qn + (size_t)(mb + tok0 + q * d) * 1024 + h * 64 + 8 * g;
            const bf16x8 qa = *(const bf16x8*)qp, qb = *(const bf16x8*)(qp + 32);
            float m_run = -INFINITY, l_run = 0.f;
            f32x4 O[4];
#pragma unroll
            for (int i = 0; i < 4; ++i) O[i] = (f32x4){0.f, 0.f, 0.f, 0.f};
#define AT_LOADKV(KS, KA, KB, V0, V1) do { int _kt = tok0 + (16 * (KS) + q - 128) * d; _kt = _kt < 0 ? 0 : _kt; const bf16_t* _kp = kn + (size_t)(mb + _kt) * 1024 + h * 64 + 8 * g; \
                KA = *(const bf16x8*)_kp; KB = *(const bf16x8*)(_kp + 32); int _vt = tok0 + (16 * (KS) + (lane >> 2) - 128) * d; _vt = _vt < 0 ? 0 : _vt; \
                const bf16_t* _vp = va + (size_t)(mb + _vt) * 1024 + h * 64 + 16 * (lane & 3); V0 = *(const u32x4*)_vp; V1 = *(const u32x4*)(_vp + 8); } while (0)
            bf16x8 nka, nkb; u32x4 nv0, nv1;
            AT_LOADKV(0, nka, nkb, nv0, nv1);
#pragma unroll 1
            for (int ks = 0; ks < 9; ++ks) {
                const bf16x8 ka = nka, kb = nkb; const u32x4 v0 = nv0, v1 = nv1;
                { const int kn1 = ks < 8 ? ks + 1 : 8; AT_LOADKV(kn1, nka, nkb, nv0, nv1); }
                asm volatile("" ::: "memory");
                *(LAS u32x4*)(vst + (lane >> 2) * 144 + (lane & 3) * 32) = v0; *(LAS u32x4*)(vst + (lane >> 2) * 144 + (lane & 3) * 32 + 16) = v1;
                f32x4 S = (f32x4){0.f, 0.f, 0.f, 0.f};
                S = __builtin_amdgcn_mfma_f32_16x16x32_bf16(ka, qa, S, 0, 0, 0);
                S = __builtin_amdgcn_mfma_f32_16x16x32_bf16(kb, qb, S, 0, 0, 0);
                float s[4]; float mx = -INFINITY;
                if (ks >= 1 && ks <= 7 && tok0 >= 128 * d) {
#pragma unroll
                    for (int c = 0; c < 4; ++c) { const int off = q + 128 - (16 * ks + 4 * g + c); s[c] = S[c] - sd * (float)off; mx = fmaxf(mx, s[c]); }
                } else {
#pragma unroll
                for (int c = 0; c < 4; ++c) { const int ki = 16 * ks + 4 * g + c; const int off = q + 128 - ki; const int ktok = tok0 + (ki - 128) * d;
                    const bool valid = (off >= 0) && (off <= 128) && (ktok >= 0);
                    s[c] = valid ? S[c] - sd * (float)off : -INFINITY; mx = fmaxf(mx, s[c]); }
                }
                mx = fmaxf(mx, __shfl_xor(mx, 16)); mx = fmaxf(mx, __shfl_xor(mx, 32));
                const float m_new = fmaxf(m_run, mx);
                float sc = 1.f, pe[4] = {0.f, 0.f, 0.f, 0.f};
                if (m_new > -INFINITY) { sc = __expf(m_run - m_new);
#pragma unroll
                    for (int c = 0; c < 4; ++c) pe[c] = __expf(s[c] - m_new); }
                l_run = l_run * sc + ((pe[0] + pe[1]) + (pe[2] + pe[3])); m_run = m_new;
#pragma unroll
                for (int i = 0; i < 4; ++i) O[i] = O[i] * sc;
                u32x2 pw; pw.x = pk2(pe[0], pe[1]); pw.y = pk2(pe[2], pe[3]);
                const s16x4 pb = __builtin_bit_cast(s16x4, pw);
                LDS_WAIT(); asm volatile("" ::: "memory");
#pragma unroll
                for (int blk = 0; blk < 4; ++blk) {
                    const s16x4 vtr = tr_read(vst + (4 * g + ((lane & 15) >> 2)) * 144 + (16 * blk + 4 * (lane & 3)) * 2);
                    O[blk] = __builtin_amdgcn_mfma_f32_16x16x16bf16_1k(vtr, pb, O[blk], 0, 0, 0);
                }
                LDS_WAIT(); asm volatile("" ::: "memory");
            }
            l_run += __shfl_xor(l_run, 16); l_run += __shfl_xor(l_run, 32);
            const int ti = base + q * d;
            LAS float* ar = accL + ti * ACC_PITCH + 4 * g;
            if (p == 0) {
#pragma unroll
                for (int blk = 0; blk < 4; ++blk) *(LAS f32x4*)(ar + 16 * blk) = O[blk];
                if (g == 0) { mL[ti] = m_run; lL[ti] = l_run; }
            } else {
                const float mo = mL[ti], lo = lL[ti];
                const float mn = fmaxf(mo, m_run), ao = __expf(mo - mn), an = __expf(m_run - mn);
#pragma unroll
                for (int blk = 0; blk < 4; ++blk) { const f32x4 old = *(LAS f32x4*)(ar + 16 * blk); *(LAS f32x4*)(ar + 16 * blk) = old * ao + O[blk] * an; }
                LDS_WAIT(); asm volatile("" ::: "memory");
                if (g == 0) { mL[ti] = mn; lL[ti] = lo * ao + l_run * an; }
            }
        }
        __syncthreads();
    }
    {
        const int ti = tid >> 1, hf = tid & 1;
        const float inv = 1.f / lL[ti];
        const size_t go = (size_t)(mb + tb + ti) * 2048 + 1024 + h * 64 + 32 * hf; const bf16_t* gp = mixg + go; bf16_t* op = mixo + go;
        const LAS float* ar = accL + ti * ACC_PITCH + 32 * hf;
#pragma unroll
        for (int c8 = 0; c8 < 4; ++c8) { const F8 gt = ld_bf8(gp + 8 * c8); const f32x4 o0 = *(const LAS f32x4*)(ar + 8 * c8) * inv * gt.a, o1 = *(const LAS f32x4*)(ar + 8 * c8 + 4) * inv * gt.b;
            u32x4 w; w.x = pk2(o0[0], o0[1]); w.y = pk2(o0[2], o0[3]); w.z = pk2(o1[0], o1[1]); w.w = pk2(o1[2], o1[3]);
            *(u32x4*)(op + 8 * c8) = w; }
    }
    __syncthreads();
}

constexpr int SA_KC = 26, SA_NKC = 5, SA_NPART = 15, SA_TASKS = 128 * SA_NPART, SA_PSTRIDE = 66;
__device__ __forceinline__ void attn_sample_part(int task, const bf16_t* qn, const bf16_t* kn, const bf16_t* va, const float* ck, const float* cv, float* part, int lane) {
    const int sbh = task / SA_NPART, pk = task % SA_NPART, p = pk / SA_NKC, kc = pk % SA_NKC;
    const int sb = sbh >> 4, h = sbh & 15, m = MP + sb; const int d = p == 0 ? 1 : (p == 1 ? 4 : 16);
    const float ql = bf2f(qn[(size_t)m * 1024 + h * 64 + lane]);
    const float slope = exp2f(-0.5f * (float)(h + 1));
    float kv[SA_KC];
#pragma unroll
    for (int jj = 0; jj < SA_KC; ++jj) { const int j = SA_KC * kc + jj; const int jc = j > 128 ? 128 : j;
        kv[jj] = (jc == 0) ? bf2f(kn[(size_t)m * 1024 + h * 64 + lane]) : ck[(((size_t)sb * 2048 + (2048 - jc * d)) * 16 + h) * 64 + lane]; }
    float sc[SA_KC]; float mx = -INFINITY;
#pragma unroll
    for (int jj = 0; jj < SA_KC; ++jj) { const int j = SA_KC * kc + jj; const float dot = wave_sum(ql * kv[jj]);
        sc[jj] = (j <= 128) ? dot - slope * (float)(j * d) : -INFINITY; mx = fmaxf(mx, sc[jj]); }
#pragma unroll
    for (int jj = 0; jj < SA_KC; ++jj) { const int j = SA_KC * kc + jj; const int jc = j > 128 ? 128 : j;
        kv[jj] = (jc == 0) ? bf2f(va[(size_t)m * 1024 + h * 64 + lane]) : cv[(((size_t)sb * 2048 + (2048 - jc * d)) * 16 + h) * 64 + lane]; }
    float o = 0.f, l = 0.f;
#pragma unroll
    for (int jj = 0; jj < SA_KC; ++jj) { const float pe = __expf(sc[jj] - mx); l += pe; o = fmaf(pe, kv[jj], o); }
    float* pp = part + (size_t)task * SA_PSTRIDE;
    pp[lane] = o; if (lane == 0) { pp[64] = mx; pp[65] = l; }
}
__device__ __forceinline__ void attn_sample_combine(int sbh, const float* part, bf16_t* mixg, int lane) {
    const float* pp = part + (size_t)sbh * SA_NPART * SA_PSTRIDE;
    float M = -INFINITY;
#pragma unroll
    for (int i = 0; i < SA_NPART; ++i) M = fmaxf(M, pp[i * SA_PSTRIDE + 64]);
    float o = 0.f, l = 0.f;
#pragma unroll
    for (int i = 0; i < SA_NPART; ++i) { const float w = __expf(pp[i * SA_PSTRIDE + 64] - M); o = fmaf(w, pp[i * SA_PSTRIDE + lane], o); l = fmaf(w, pp[i * SA_PSTRIDE + 65], l); }
    const size_t go = (size_t)(MP + (sbh >> 4)) * 2048 + 1024 + (sbh & 15) * 64 + lane;
    mixg[go] = (bf16_t)f2bf(o / l * bf2f(mixg[go]));
}

template <int CTRL> __device__ __forceinline__ float dpp_mov(float v) { return __builtin_bit_cast(float, __builtin_amdgcn_update_dpp(0, __builtin_bit_cast(int, v), CTRL, 0xF, 0xF, true)); }
__device__ __forceinline__ float red16(float v) { v += dpp_mov<0xB1>(v); v += dpp_mov<0x4E>(v); v += dpp_mov<0x141>(v); v += dpp_mov<0x140>(v); return v; }
struct StepIn { h16x4 w, k, a, b, r; h16 v; };
__device__ __forceinline__ float do_step(float (&S)[4], const StepIn& in) {
    float sa = 0.f;
#pragma unroll
    for (int c = 0; c < 4; ++c) sa = fmaf(S[c], (float)in.a[c], sa);
    sa = red16(sa);
    const float v = (float)in.v; float y = 0.f;
#pragma unroll
    for (int c = 0; c < 4; ++c) { float t = fmaf(v, (float)in.k[c], S[c]); asm("" : "+v"(t)); t = fmaf(sa, (float)in.b[c], t); asm("" : "+v"(t));
        S[c] = fmaf((float)in.w[c], S[c], t); asm("" : "+v"(S[c])); y = fmaf(S[c], (float)in.r[c], y); }
    return red16(y);
}
#define FMIX_DECL(NAME, MODS, ZERO) \
__device__ __forceinline__ float NAME(float a, unsigned h, float c) { float d; asm("v_fma_mix_f32 %0, %1, %2, " ZERO " " MODS : "=v"(d) : "v"(a), "v"(h), "v"(c)); return d; }
FMIX_DECL(mix_lo, "op_sel_hi:[0,1,0]", "%3")
FMIX_DECL(mix_hi, "op_sel:[0,1,0] op_sel_hi:[0,1,0]", "%3")
__device__ __forceinline__ float mix0_lo(float a, unsigned h) { float d; asm("v_fma_mix_f32 %0, %1, %2, 0 op_sel_hi:[0,1,0]" : "=v"(d) : "v"(a), "v"(h)); return d; }
__device__ __forceinline__ float mix0_hi(float a, unsigned h) { float d; asm("v_fma_mix_f32 %0, %1, %2, 0 op_sel:[0,1,0] op_sel_hi:[0,1,0]" : "=v"(d) : "v"(a), "v"(h)); return d; }
__device__ __forceinline__ float mixh_lo(unsigned vh, unsigned h, float c) { float d; asm("v_fma_mix_f32 %0, %1, %2, %3 op_sel_hi:[1,1,0]" : "=v"(d) : "v"(vh), "v"(h), "v"(c)); return d; }
__device__ __forceinline__ float mixh_hi(unsigned vh, unsigned h, float c) { float d; asm("v_fma_mix_f32 %0, %1, %2, %3 op_sel:[0,1,0] op_sel_hi:[1,1,0]" : "=v"(d) : "v"(vh), "v"(h), "v"(c)); return d; }
struct StepRaw { u32x2 w, k, a, b, r; unsigned v; };
__device__ __forceinline__ float do_step2(float (&S)[4], const StepRaw& in, float& yprev) {
    float pre[4];
    pre[0] = mix_lo(S[0], in.w.x, mixh_lo(in.v, in.k.x, S[0])); pre[1] = mix_hi(S[1], in.w.x, mixh_hi(in.v, in.k.x, S[1]));
    pre[2] = mix_lo(S[2], in.w.y, mixh_lo(in.v, in.k.y, S[2])); pre[3] = mix_hi(S[3], in.w.y, mixh_hi(in.v, in.k.y, S[3]));
    const float s01 = mix_hi(S[1], in.a.x, mix0_lo(S[0], in.a.x)), s23 = mix_hi(S[3], in.a.y, mix0_lo(S[2], in.a.y));
    float sa = s01 + s23, yp = yprev;
    sa += dpp_mov<0xB1>(sa); yp += dpp_mov<0xB1>(yp);
    sa += dpp_mov<0x4E>(sa); yp += dpp_mov<0x4E>(yp);
    sa += dpp_mov<0x141>(sa); yp += dpp_mov<0x141>(yp);
    sa += dpp_mov<0x140>(sa); yp += dpp_mov<0x140>(yp);
    yprev = yp;
    S[0] = mix_lo(sa, in.b.x, pre[0]); S[1] = mix_hi(sa, in.b.x, pre[1]); S[2] = mix_lo(sa, in.b.y, pre[2]); S[3] = mix_hi(sa, in.b.y, pre[3]);
    const float y01 = mix_hi(S[1], in.r.x, mix0_lo(S[0], in.r.x)), y23 = mix_hi(S[3], in.r.y, mix0_lo(S[2], in.r.y));
    return y01 + y23;
}
__device__ __forceinline__ void scan_one(const unsigned char* rec, int rq, const float* S0, float* Sout, float* yp, int lane) {
    const int rr = lane >> 4, jq = lane & 15, i = 4 * rq + rr;
    float S[4]; { const f32x4 s = *(const f32x4*)(S0 + i * 64 + 4 * jq); S[0] = s.x; S[1] = s.y; S[2] = s.z; S[3] = s.w; }
    StepIn in; in.w = *(const h16x4*)(rec + jq * 8); in.k = *(const h16x4*)(rec + 128 + jq * 8); in.a = *(const h16x4*)(rec + 256 + jq * 8); in.b = *(const h16x4*)(rec + 384 + jq * 8);
    in.r = *(const h16x4*)(rec + 512 + jq * 8); in.v = *(const h16*)(rec + 640 + i * 2);
    const float y = do_step(S, in); if (jq == 0) yp[i] = y;
    *(f32x4*)(Sout + i * 64 + 4 * jq) = (f32x4){S[0], S[1], S[2], S[3]};
}
constexpr int SC_CH = 64, SC_CHB = SC_CH * ESTRIDE, SC_NCH = TSEQ / SC_CH;
__device__ __forceinline__ void scan_pair(int pair, const unsigned char* Eb, float* out, float* yraw, LAS unsigned char* lds, int wave, int lane) {
    const int bh = pair >> 3, rq = ((pair & 7) << 1) + (wave & 1);
    const unsigned char* base = Eb + (size_t)bh * TSEQ * ESTRIDE;
    const int rr = lane >> 4, jq = lane & 15, i = 4 * rq + rr;
    float S[4] = {0.f, 0.f, 0.f, 0.f};
    float* yp = yraw + (size_t)((bh >> 4) * TSEQ) * 1024 + (bh & 15) * 64 + i;
    float ypart = 0.f, ycap = 0.f; float* dummy = yraw + (size_t)(MPAD - 1) * 1024 + (bh & 15) * 64 + i;
#define SC_ISSUE(kc) do { const int _kc = (kc) < SC_NCH ? (kc) : SC_NCH - 1; const unsigned char* _g = base + (size_t)_kc * SC_CHB; LAS unsigned char* _l = lds + ((kc) & 1) * SC_CHB; \
        _Pragma("unroll") for (int _p = 0; _p < 8; ++_p) { const int _x = (8 * (wave - 2) + _p) * 64; \
            __builtin_amdgcn_global_load_lds((const unsigned*)(_g + (size_t)(_x + lane) * 16), (LAS unsigned*)(_l + _x * 16), 16, 0, 0); } } while (0)
    if (wave >= 2) { SC_ISSUE(0); asm volatile("s_waitcnt vmcnt(0)" ::: "memory"); }
    __builtin_amdgcn_s_barrier(); asm volatile("" ::: "memory");
#pragma unroll 1
    for (int k = 0; k < SC_NCH; ++k) {
        if (wave >= 2) { SC_ISSUE(k + 1); asm volatile("s_waitcnt vmcnt(0)" ::: "memory"); }
        else {
            const LAS unsigned char* bp = lds + (k & 1) * SC_CHB;
            StepRaw bA[4], bB[4];
#define SC_LDG(BUF, G) do { _Pragma("unroll") for (int _u = 0; _u < 4; ++_u) { const LAS unsigned char* p = bp + ((G) * 4 + _u) * ESTRIDE; \
                BUF[_u].w = *(const LAS u32x2*)(p + jq * 8); BUF[_u].k = *(const LAS u32x2*)(p + 128 + jq * 8); BUF[_u].a = *(const LAS u32x2*)(p + 256 + jq * 8); BUF[_u].b = *(const LAS u32x2*)(p + 384 + jq * 8); \
                BUF[_u].r = *(const LAS u32x2*)(p + 512 + jq * 8); BUF[_u].v = *(const LAS unsigned short*)(p + 640 + i * 2); } } while (0)
#define SC_CMP(BUF, G) do { _Pragma("unroll") for (int _u = 0; _u < 4; ++_u) { const int s = (G) * 4 + _u; float yr = ypart; ypart = do_step2(S, BUF[_u], yr); \
                const int tp = k * SC_CH + s - 1; ycap = ((jq & 3) == (tp & 3)) ? yr : ycap; \
                if (_u == 0) { float* dst = tp < 0 ? dummy : yp + (size_t)(tp - 3 + (jq & 3)) * 1024; *dst = ycap; } } } while (0)
            SC_LDG(bA, 0);
#pragma unroll 1
            for (int g2 = 0; g2 < SC_CH / 8; ++g2) {
                SC_LDG(bB, 2 * g2 + 1);
                SC_CMP(bA, 2 * g2);
                if (g2 + 1 < SC_CH / 8) SC_LDG(bA, 2 * g2 + 2);
                SC_CMP(bB, 2 * g2 + 1);
            }
#undef SC_LDG
#undef SC_CMP
        }
        asm volatile("" ::: "memory"); __builtin_amdgcn_s_barrier(); asm volatile("" ::: "memory");
    }
    if (wave >= 2) asm volatile("s_waitcnt vmcnt(0)" ::: "memory");
    if (wave < 2) { const float yl = red16(ypart); ycap = ((jq & 3) == 3) ? yl : ycap; yp[(size_t)(TSEQ - 4 + (jq & 3)) * 1024] = ycap; *(f32x4*)(out + O_WKVP + (size_t)bh * 4096 + i * 64 + 4 * jq) = (f32x4){S[0], S[1], S[2], S[3]}; }
    __builtin_amdgcn_s_barrier(); asm volatile("" ::: "memory");
#undef SC_ISSUE
}

template <int CTRL> __device__ __forceinline__ float dpp_mov(float v);
__device__ __forceinline__ float quad_sum(float v) { v += dpp_mov<0xB1>(v); v += dpp_mov<0x4E>(v); return v; }
__device__ __forceinline__ void fin_token(int m, const float* yraw, const unsigned char* Eb, bf16_t* mixg, const float* gn_w, const float* gn_b, const float* r_k, int lane) {
    const int h = lane >> 2, qt = lane & 3, ch0 = lane * 16;
    f32x4 y[4];
#pragma unroll
    for (int i = 0; i < 4; ++i) y[i] = *(const f32x4*)(yraw + (size_t)m * 1024 + ch0 + 4 * i);
    const unsigned char* e = Eb + e_rec(m, h) * ESTRIDE + qt * 32;
    const u32x4 rr0 = *(const u32x4*)(e + 512), rr1 = *(const u32x4*)(e + 528), kk0 = *(const u32x4*)(e + 128), kk1 = *(const u32x4*)(e + 144), vv0 = *(const u32x4*)(e + 640), vv1 = *(const u32x4*)(e + 656);
    bf16_t* gp = mixg + (size_t)m * 2048 + ch0;
    const F8 g0 = ld_bf8(gp), g1 = ld_bf8(gp + 8);
    float s = 0.f;
#pragma unroll
    for (int i = 0; i < 4; ++i) s += (y[i].x + y[i].y) + (y[i].z + y[i].w);
    const float mean = quad_sum(s) * (1.f / 64.f);
    float q = 0.f;
#pragma unroll
    for (int i = 0; i < 4; ++i) { y[i] = y[i] - mean; q += (y[i].x * y[i].x + y[i].y * y[i].y) + (y[i].z * y[i].z + y[i].w * y[i].w); }
    const float rstd = rsqrtf(quad_sum(q) * (1.f / 64.f) + 64e-5f);
    typedef _Float16 h16x8 __attribute__((ext_vector_type(8)));
    const h16x8 r0 = __builtin_bit_cast(h16x8, rr0), r1 = __builtin_bit_cast(h16x8, rr1), k0 = __builtin_bit_cast(h16x8, kk0), k1 = __builtin_bit_cast(h16x8, kk1), v0 = __builtin_bit_cast(h16x8, vv0), v1 = __builtin_bit_cast(h16x8, vv1);
    float bs = 0.f;
#pragma unroll
    for (int i = 0; i < 8; ++i) { bs = fmaf((float)r0[i] * (float)k0[i], r_k[ch0 + i], bs); bs = fmaf((float)r1[i] * (float)k1[i], r_k[ch0 + 8 + i], bs); }
    bs = quad_sum(bs);
    float o[16];
#pragma unroll
    for (int i = 0; i < 16; ++i) { const float yn = y[i >> 2][i & 3] * rstd * gn_w[ch0 + i] + gn_b[ch0 + i];
        const float vv = i < 8 ? (float)v0[i & 7] : (float)v1[i & 7]; const float gt = i < 4 ? g0.a[i & 3] : (i < 8 ? g0.b[i & 3] : (i < 12 ? g1.a[i & 3] : g1.b[i & 3]));
        o[i] = (yn + bs * vv) * gt; }
    u32x4 w0, w1; w0.x = pk2(o[0], o[1]); w0.y = pk2(o[2], o[3]); w0.z = pk2(o[4], o[5]); w0.w = pk2(o[6], o[7]); w1.x = pk2(o[8], o[9]); w1.y = pk2(o[10], o[11]); w1.z = pk2(o[12], o[13]); w1.w = pk2(o[14], o[15]);
    *(u32x4*)gp = w0; *(u32x4*)(gp + 8) = w1;
}
__device__ __forceinline__ void outproj_sample_col(int d, const bf16_t* mixg, const bf16_t* woutT, const float* xs, float* out, int lane) {
    float acc[8] = {0.f, 0.f, 0.f, 0.f, 0.f, 0.f, 0.f, 0.f};
#pragma unroll
    for (int i = 0; i < 4; ++i) { const int e0 = 8 * lane + 512 * i; const F8 w = ld_bf8(woutT + (size_t)d * DM + e0);
#pragma unroll
        for (int r = 0; r < 8; ++r) { const F8 x = ld_bf8(mixg + (size_t)(MP + r) * DM + e0);
            acc[r] += (w.a[0] * x.a[0] + w.a[1] * x.a[1]) + (w.a[2] * x.a[2] + w.a[3] * x.a[3]) + (w.b[0] * x.b[0] + w.b[1] * x.b[1]) + (w.b[2] * x.b[2] + w.b[3] * x.b[3]); } }
#pragma unroll
    for (int r = 0; r < 8; ++r) { const float t = wave_sum(acc[r]); if (lane == r) out[O_YS + r * DM + d] = t + xs[r * DM + d]; }
}

#define XB_TMO      128
#define XB_XCNT(j)  (256  + 64 * (j))
#define XB_XSUB(j)  (1280 + 64 * (j))
#define XB_XGEN(j)  (2304 + 64 * (j))
#define XB_TOP      3328
#define XB_TOPGEN   3392
#define XCD_BAR_WORDS 3456
#define XB_SPIN_CAP (1u << 18)

__device__ __forceinline__ unsigned xb_ld(unsigned* p)              { return __hip_atomic_load(p, __ATOMIC_RELAXED, __HIP_MEMORY_SCOPE_AGENT); }
__device__ __forceinline__ unsigned xb_add(unsigned* p, unsigned v) { return __hip_atomic_fetch_add(p, v, __ATOMIC_RELAXED, __HIP_MEMORY_SCOPE_AGENT); }
__device__ __forceinline__ unsigned xb_xcc_id() { return (unsigned)__builtin_amdgcn_s_getreg((3 << 11) | 20) & 0xFu; }
#define XB_SPIN(cond, bar) do { unsigned _sp = 0; while (cond) { __builtin_amdgcn_s_sleep(1); \
    if ((++_sp & 255u) == 0u) { if (xb_ld(&(bar)[XB_TMO])) break; if (_sp > XB_SPIN_CAP) { atomicAdd(&(bar)[XB_TMO], 1u); break; } } } } while (0)

struct XcdBarrier {
    unsigned* bar; unsigned x;
    volatile LAS unsigned* st;
};

__device__ __forceinline__ XcdBarrier xcd_barrier_post(unsigned* bar, volatile LAS unsigned* st) {
    XcdBarrier b; b.bar = bar; b.x = xb_xcc_id(); b.st = st;
    if (threadIdx.x == 0) (void)xb_add(&bar[XB_XCNT(b.x)], 1u);
    return b;
}
__device__ __forceinline__ void xcd_barrier_complete(unsigned* bar, unsigned x, unsigned& nloc, unsigned& nx) {
    const unsigned G = gridDim.x * gridDim.y * gridDim.z;
    unsigned sum, cnt, mine, sp = 0u;
    for (;;) {
        sum = 0u; cnt = 0u; mine = 0u;
#pragma unroll
        for (unsigned j = 0; j < 16; ++j) { const unsigned c = xb_ld(&bar[XB_XCNT(j)]); sum += c; cnt += (c > 0u) ? 1u : 0u; mine = (j == x) ? c : mine; }
        if (sum == G) break;
        __builtin_amdgcn_s_sleep(1);
        if ((++sp & 255u) == 0u) { if (xb_ld(&bar[XB_TMO])) break; if (sp > XB_SPIN_CAP) { atomicAdd(&bar[XB_TMO], 1u); break; } }
    }
    nloc = mine > 0u ? mine : 1u; nx = cnt > 0u ? cnt : 1u;
}

__device__ __forceinline__ void xcd_barrier(const XcdBarrier& b) {
    asm volatile("s_waitcnt vmcnt(0)" ::: "memory");
    __syncthreads();
    if (threadIdx.x == 0) {
        unsigned* bar = b.bar;
        __builtin_amdgcn_s_waitcnt(0);
        unsigned nloc = b.st[0], nx = b.st[1];
        if (nloc == 0u) { xcd_barrier_complete(bar, b.x, nloc, nx); b.st[0] = nloc; b.st[1] = nx; }
        const unsigned old = xb_add(&bar[XB_XSUB(b.x)], 1u);
        const unsigned gen = old / nloc;
        if (old + 1u == (gen + 1u) * nloc) {
            __builtin_amdgcn_fence(__ATOMIC_RELEASE, "agent");
            asm volatile("s_waitcnt vmcnt(0)" ::: "memory");
            const unsigned og = xb_add(&bar[XB_TOP], 1u);
            const unsigned tg = og / nx;
            if (og + 1u == (tg + 1u) * nx) xb_add(&bar[XB_TOPGEN], 1u);
            else XB_SPIN(xb_ld(&bar[XB_TOPGEN]) == tg, bar);
            __builtin_amdgcn_fence(__ATOMIC_ACQUIRE, "agent");
            xb_add(&bar[XB_XGEN(b.x)], 1u);
            asm volatile("s_waitcnt vmcnt(0)" ::: "memory");
        } else {
            XB_SPIN(xb_ld(&bar[XB_XGEN(b.x)]) == gen, bar);
            __builtin_amdgcn_fence(__ATOMIC_ACQUIRE, "agent");
            asm volatile("s_waitcnt vmcnt(0)" ::: "memory");
        }
    }
    __syncthreads();
}


struct Args { const float* in[21]; float* out; unsigned char* ws; };
__global__ void __launch_bounds__(NT, 2) mk_fwd(Args a) {
    extern __shared__ __attribute__((aligned(16))) unsigned char lds_raw[];
    LAS unsigned char* lds = (LAS unsigned char*)lds_raw;
    cg::grid_group grid = cg::this_grid();
    const int tid = threadIdx.x, lane = tid & 63, wave = __builtin_amdgcn_readfirstlane(tid >> 6);
    const int G = gridDim.x, bx = blockIdx.x;
    unsigned char* ws = a.ws; float* out = a.out;
    bf16_t* xn = (bf16_t*)(ws + WS_XN); bf16_t* winT = (bf16_t*)(ws + WS_WIN); bf16_t* woutT = (bf16_t*)(ws + WS_WOUT);
    bf16_t* wupT = (bf16_t*)(ws + WS_WUP); bf16_t* aupT = (bf16_t*)(ws + WS_AUP);
    bf16_t* zs = (bf16_t*)(ws + WS_ZS); float* yraw = (float*)(ws + WS_YR); bf16_t* mixg = (bf16_t*)(ws + WS_MIX);
    bf16_t* qn = (bf16_t*)(ws + WS_QN); bf16_t* kn = (bf16_t*)(ws + WS_KN); bf16_t* va = (bf16_t*)(ws + WS_VA);
    unsigned char* Eb = ws + WS_E; float* part = (float*)(ws + WS_PART);
    { volatile LAS unsigned* xst = (volatile LAS unsigned*)(lds + 147328);
      if (tid == 0) { xst[0] = 0u; xst[1] = 0u; }
      __syncthreads();
      (void)xcd_barrier_post((unsigned*)(ws + WS_BAR), xst); }
#define GBAR() do { XcdBarrier _b; _b.bar = (unsigned*)(a.ws + WS_BAR); _b.x = xb_xcc_id(); _b.st = (volatile LAS unsigned*)(lds + 147328); xcd_barrier(_b); } while (0)

#ifndef PROBE_DUP
#define PROBE_DUP 0
#endif
    p0_prologue(a.in[0], a.in[1], a.in[6], a.in[7], a.in[10], a.in[12], a.in[20], ws, lds, G, bx, wave, lane, tid);
    if (a.out == nullptr) grid.sync();
    GBAR();
    { pg8::Gemm g{xn, winT, MPAD, NPAD, DM}; pg8::StaticOrder S; S.init(MPAD, NPAD, G, bx);
      EpiIn E{zs, mixg, qn, kn, va, out, a.in[18], a.in[19]};
      pg8::gemm_phase<EpiIn, pg8::StaticOrder, true, true>(lds, g, S, E); }
    GBAR();
    for (int t = bx * NW + wave; t < SA_TASKS; t += G * NW) attn_sample_part(t, qn, kn, va, a.in[4], a.in[5], part, lane);
    for (int u = bx; u < 512; u += G) prep_unit(u, zs, Eb, wupT, aupT, a.in[3], a.in[8], a.in[9], a.in[11], a.in[13], a.in[14], wave, lane, lds);
    if (G >= 16) { if (bx >= G - 16 && wave == 0) prep_unit(512, zs, Eb, wupT, aupT, a.in[3], a.in[8], a.in[9], a.in[11], a.in[13], a.in[14], bx - (G - 16), lane, lds); }
    else if (bx == G - 1) { for (int hd = wave; hd < 16; hd += NW) prep_unit(512, zs, Eb, wupT, aupT, a.in[3], a.in[8], a.in[9], a.in[11], a.in[13], a.in[14], hd, lane, lds); }
    __syncthreads();
    { const int vcu2 = (G % 8 == 0) ? (bx % 8) * (G / 8) + bx / 8 : bx;
      for (int u = vcu2; u < 512; u += G) attn_unit(u, qn, kn, va, mixg, mixg, lds, wave, lane, tid); }
    GBAR();
    {
        for (int gw = bx * NW + wave; gw < 2048; gw += G * NW) { const int sbh = gw >> 4, rq = gw & 15, sb = sbh >> 4, h = sbh & 15;
            scan_one(Eb + e_rec(MP + sb, h) * ESTRIDE, rq, a.in[2] + (size_t)sbh * 4096, out + O_WKVS + (size_t)sbh * 4096, yraw + (size_t)(MP + sb) * 1024 + h * 64, lane); }
        const int vcu = (G % 8 == 0) ? (bx % 8) * (G / 8) + bx / 8 : bx;
        for (int pair = vcu; pair < 256; pair += G) scan_pair(pair, Eb, out, yraw, lds, wave, lane);
    }
    GBAR();
    for (int t = bx * NW + wave; t < MTOT + 128; t += G * NW) { if (t < MTOT) fin_token(t, yraw, Eb, mixg, a.in[16], a.in[17], a.in[15], lane); else attn_sample_combine(t - MTOT, part, mixg, lane); }
    GBAR();
    { pg8::Gemm g{mixg, woutT, MP, DM, DM}; pg8::StaticOrder S; S.init(MP, DM, G, bx);
      EpiOut E{a.in[0], a.in[1], out};
      pg8::gemm_phase<EpiOut, pg8::StaticOrder, true, true>(lds, g, S, E); }
    for (int d = bx * NW + wave; d < DM; d += G * NW) outproj_sample_col(d, mixg, woutT, a.in[1], out, lane);
}

extern "C" void kernel_launch(void* const* d_in, const int* in_sizes, int n_in, void* d_out, int out_size, void* d_ws, size_t ws_size, hipStream_t stream) {
    static int grid = 0;
    if (grid == 0) {
        if (n_in != 21 || ws_size < WS_END) { fprintf(stderr, "kernel_launch: unexpected n_in %d / ws %zu\n", n_in, ws_size); grid = -1; return; }
        int dev = 0, cus = 0, per_cu = 0;
        (void)hipGetDevice(&dev); (void)hipDeviceGetAttribute(&cus, hipDeviceAttributeMultiprocessorCount, dev);
        (void)hipFuncSetAttribute((const void*)mk_fwd, hipFuncAttributeMaxDynamicSharedMemorySize, LDS_BYTES);
        (void)hipOccupancyMaxActiveBlocksPerMultiprocessor(&per_cu, (const void*)mk_fwd, NT, LDS_BYTES);
        if (per_cu < 1) { fprintf(stderr, "kernel_launch: occupancy query reports %d\n", per_cu); per_cu = 1; }
        grid = cus * 1;
        (void)hipGetLastError();
    }
    if (grid < 0) return;
    if (hipMemsetAsync((char*)d_ws + WS_BAR, 0, 16384, stream) != hipSuccess) { fprintf(stderr, "kernel_launch: memset of barrier words failed\n"); return; }
    Args a{};
    for (int i = 0; i < 21; ++i) a.in[i] = (const float*)d_in[i];
    a.out = (float*)d_out; a.ws = (unsigned char*)d_ws;
    void* args[] = {&a};
    hipError_t e = hipLaunchCooperativeKernel((const void*)mk_fwd, dim3(grid), dim3(NT), args, LDS_BYTES, stream);
    if (e != hipSuccess) fprintf(stderr, "cooperative launch failed: %s (grid %d)\n", hipGetErrorString(e), grid);
}
```

```cpp
#include <hip/hip_runtime.h>
#include <hip/hip_cooperative_groups.h>
#include <cstdio>
#include <cstdint>
namespace cg = cooperative_groups;
namespace pg8 {
#define PG8_LAS __attribute__((address_space(3)))
typedef unsigned short bf16_t;
typedef short bf16x8 __attribute__((ext_vector_type(8)));
typedef float f32x4 __attribute__((ext_vector_type(4)));
typedef unsigned u32x4 __attribute__((ext_vector_type(4)));
constexpr int BM = 256, BK = 64, HALF = 128, HTB = HALF * BK * 2, STAGE_BYTES = 8 * HTB, NXCD = 8, WGM = 8;
__host__ __device__ __forceinline__ int lds_byte(int r, int c) { const int st = (r >> 4) * 2 + (c >> 5), rr = r & 15, cc = c & 31, ob = rr * 64 + cc * 2; return st * 1024 + (ob ^ (((ob >> 9) & 1) << 5)); }
__host__ __device__ __forceinline__ void stage_rc(int b, int& R, int& C) { const int st = b / 1024, sb = b % 1024, swz = sb ^ (((sb >> 9) & 1) << 5); R = (st >> 1) * 16 + swz / 64; C = (st & 1) * 32 + (swz % 64) / 2; }
__host__ __device__ __forceinline__ int perm32(int rho) { const int n = rho >> 4, i = rho & 15; return 8 * (i >> 2) + 4 * n + (i & 3); }

struct Unit { int pm, pn; };
struct Gemm { const bf16_t* A; const bf16_t* Bt; int M, N, K; };

struct StaticOrder {
    int nM, nN, nwg, G, c;
    __host__ __device__ void init(int M, int N, int G_, int c_) { nM = M / BM; nN = N / BM; nwg = nM * nN; G = G_; c = c_; }
    __host__ __device__ bool next(int i, Unit& u) const {
        const long L = (long)i * G + c; if (L >= nwg) return false;
        int wgid = (int)L; { const int q = nwg / NXCD, r = nwg % NXCD, xcd = wgid % NXCD, off = wgid / NXCD; wgid = (xcd < r ? xcd * (q + 1) : r * (q + 1) + (xcd - r) * q) + off; }
        const int nig = WGM * nN, gid = wgid / nig, fm = gid * WGM, gsz = (nM - fm) < WGM ? (nM - fm) : WGM;
        u.pm = fm + ((wgid % nig) % gsz); u.pn = (wgid % nig) / gsz; return true;
    }
    __device__ __forceinline__ void a_ready(const Unit&) const {}
    __device__ __forceinline__ void done(const Unit&) const {}
};
template <class Epi, class Sched, bool ALIGN_EPI = false, bool SP2 = false>
__device__ __forceinline__ void gemm_phase(PG8_LAS unsigned char* lds, const Gemm g, const Sched& S, const Epi& E) {
    const int tid = threadIdx.x, wid = __builtin_amdgcn_readfirstlane(tid >> 6), lane = tid & 63, wr = wid >> 2, wc = wid & 3, fr = lane & 15, fq = lane >> 4;
    const int K = g.K, nt = K / BK;
    unsigned voffA[2], voffB[2];
#pragma unroll
    for (int i = 0; i < 2; ++i) { int R, C; stage_rc(tid * 16 + i * 8192, R, C); const int Rb = Epi::PERM ? ((R & ~31) + perm32(R & 31)) : R;
        voffA[i] = (unsigned)(R * K + C) * 2u; voffB[i] = (unsigned)(Rb * K + C) * 2u; }
    const size_t kstep = (size_t)(BK * 2);
    const size_t hstep = (size_t)HALF * K * 2;
    const size_t tstep = 2 * hstep;
    const unsigned ldsw = (unsigned)wid * 1024u;
    const int aoff = lds_byte(wr * 64 + fr, fq * 8), boff = lds_byte(wc * 32 + fr, fq * 8);
#define PG8_SA(b, h) (((b) * 2 + (h)) * HTB)
#define PG8_SB(b, h) ((4 + (b) * 2 + (h)) * HTB)
#define PG8_STAGE(bufoff, gbase, voff) do { _Pragma("unroll") for (int _i = 0; _i < 2; ++_i) \
        __builtin_amdgcn_global_load_lds((const unsigned*)((const char*)(gbase) + (voff)[_i]), (PG8_LAS unsigned*)(lds + (bufoff) + ldsw + _i * 8192), 16, 0, 0); } while (0)
#define PG8_LDA(dst, b, h) do { _Pragma("unroll") for (int m = 0; m < 4; ++m) _Pragma("unroll") for (int k = 0; k < 2; ++k) dst[m][k] = *(const PG8_LAS bf16x8*)(lds + PG8_SA(b, h) + aoff + m * 2048 + k * 1024); } while (0)
#define PG8_LDB(dst, b, h) do { _Pragma("unroll") for (int n = 0; n < 2; ++n) _Pragma("unroll") for (int k = 0; k < 2; ++k) dst[n][k] = *(const PG8_LAS bf16x8*)(lds + PG8_SB(b, h) + boff + n * 2048 + k * 1024); } while (0)
#define PG8_MMA(ai, bj, At, Bt) do { __builtin_amdgcn_s_setprio(1); _Pragma("unroll") for (int m = 0; m < 4; ++m) _Pragma("unroll") for (int n = 0; n < 2; ++n) _Pragma("unroll") for (int k = 0; k < 2; ++k) \
        acc[ai][bj][m][n] = __builtin_amdgcn_mfma_f32_16x16x32_bf16(Bt[n][k], At[m][k], acc[ai][bj][m][n], 0, 0, 0); __builtin_amdgcn_s_setprio(0); } while (0)
#define PG8_WAIT_V(n) asm volatile("s_waitcnt vmcnt(" #n ")" ::: "memory")
#define PG8_WAIT_L(n) asm volatile("s_waitcnt lgkmcnt(" #n ")" ::: "memory")
#define PG8_BAR __builtin_amdgcn_s_barrier()
#define PG8_SCHED __builtin_amdgcn_sched_barrier(0)
    Unit cur, nxt; int ui = 0;
    if (!S.next(0, cur)) return;
    f32x4 acc[2][2][4][2];
#pragma unroll
    for (int a = 0; a < 2; ++a)
#pragma unroll
        for (int b = 0; b < 2; ++b)
#pragma unroll
            for (int m = 0; m < 4; ++m)
#pragma unroll
                for (int n = 0; n < 2; ++n) acc[a][b][m][n] = (f32x4){0.f, 0.f, 0.f, 0.f};
    bf16x8 At[4][2], B0[2][2], B1[2][2];
    const char* cA = (const char*)g.A + (size_t)cur.pm * tstep; const char* cB = (const char*)g.Bt + (size_t)cur.pn * tstep;
    S.a_ready(cur);
    if constexpr (SP2) {
        PG8_STAGE(PG8_SB(0, 0), cB, voffB); PG8_STAGE(PG8_SB(0, 1), cB + hstep, voffB); PG8_STAGE(PG8_SA(0, 0), cA, voffA); PG8_STAGE(PG8_SA(0, 1), cA + hstep, voffA);
        if (wr == 1) PG8_BAR;
        PG8_WAIT_V(2); PG8_BAR;
        PG8_STAGE(PG8_SB(1, 0), cB + kstep, voffB); PG8_STAGE(PG8_SA(1, 0), cA + kstep, voffA); PG8_STAGE(PG8_SB(1, 1), cB + hstep + kstep, voffB);
        PG8_WAIT_V(6); PG8_BAR;
    } else {
        PG8_STAGE(PG8_SB(0, 0), cB, voffB); PG8_STAGE(PG8_SA(0, 0), cA, voffA); PG8_STAGE(PG8_SB(0, 1), cB + hstep, voffB); PG8_STAGE(PG8_SA(0, 1), cA + hstep, voffA);
        if (wr == 1) PG8_BAR;
        PG8_WAIT_V(4); PG8_BAR;
        PG8_STAGE(PG8_SB(1, 0), cB + kstep, voffB); PG8_STAGE(PG8_SA(1, 0), cA + kstep, voffA); PG8_STAGE(PG8_SB(1, 1), cB + hstep + kstep, voffB);
        PG8_WAIT_V(6); PG8_BAR;
    }
    for (;;) {
        const bool has_next = S.next(ui + 1, nxt);
        const char* nA = has_next ? (const char*)g.A + (size_t)nxt.pm * tstep : cA; const char* nB = has_next ? (const char*)g.Bt + (size_t)nxt.pn * tstep : cB;
        for (int t = 0; t < nt; t += 2) {
            const bool last = (t == nt - 2);
            const char* a1 = cA + (size_t)(t + 1) * kstep;
            const char* a2 = last ? nA : cA + (size_t)(t + 2) * kstep; const char* b2 = last ? nB : cB + (size_t)(t + 2) * kstep;
            const char* a3 = a2 + kstep; const char* b3 = b2 + kstep;
            if (last && has_next) S.a_ready(nxt);
            if constexpr (SP2) {
            PG8_LDB(B0, 0, 0); PG8_LDB(B1, 0, 1); PG8_SCHED; PG8_LDA(At, 0, 0); PG8_STAGE(PG8_SA(1, 1), a1 + hstep, voffA);
            PG8_WAIT_V(8); PG8_WAIT_L(0); PG8_BAR; PG8_MMA(0, 0, At, B0); PG8_MMA(0, 1, At, B1); PG8_BAR; PG8_SCHED;
            PG8_LDA(At, 0, 1); PG8_STAGE(PG8_SB(0, 0), b2, voffB); PG8_STAGE(PG8_SB(0, 1), b2 + hstep, voffB); PG8_STAGE(PG8_SA(0, 0), a2, voffA);
            PG8_WAIT_V(8); PG8_WAIT_L(0); PG8_BAR; PG8_MMA(1, 0, At, B0); PG8_MMA(1, 1, At, B1); PG8_BAR; PG8_SCHED;
            PG8_LDB(B0, 1, 0); PG8_LDB(B1, 1, 1); PG8_SCHED; PG8_LDA(At, 1, 0); PG8_STAGE(PG8_SA(0, 1), a2 + hstep, voffA);
            PG8_WAIT_V(8); PG8_WAIT_L(0); PG8_BAR; PG8_MMA(0, 0, At, B0); PG8_MMA(0, 1, At, B1); PG8_BAR; PG8_SCHED;
            PG8_LDA(At, 1, 1); PG8_STAGE(PG8_SB(1, 0), b3, voffB); PG8_STAGE(PG8_SB(1, 1), b3 + hstep, voffB); PG8_STAGE(PG8_SA(1, 0), a3, voffA);
            PG8_WAIT_V(8); PG8_WAIT_L(0); PG8_BAR; PG8_MMA(1, 0, At, B0); PG8_MMA(1, 1, At, B1); PG8_BAR; PG8_SCHED;
            } else {
            PG8_LDB(B0, 0, 0); PG8_SCHED; PG8_LDA(At, 0, 0); PG8_STAGE(PG8_SA(1, 1), a1 + hstep, voffA);
            PG8_WAIT_L(8); PG8_BAR; PG8_WAIT_L(0); PG8_MMA(0, 0, At, B0); PG8_BAR; PG8_SCHED;
            PG8_LDB(B1, 0, 1); PG8_STAGE(PG8_SB(0, 0), b2, voffB);
            PG8_BAR; PG8_WAIT_L(0); PG8_MMA(0, 1, At, B1); PG8_BAR;
            PG8_LDA(At, 0, 1); PG8_STAGE(PG8_SA(0, 0), a2, voffA);
            PG8_BAR; PG8_WAIT_L(0); PG8_MMA(1, 0, At, B0); PG8_BAR; PG8_SCHED;
            PG8_STAGE(PG8_SB(0, 1), b2 + hstep, voffB);
            PG8_WAIT_V(6); PG8_BAR; PG8_MMA(1, 1, At, B1); PG8_BAR;
            PG8_LDB(B0, 1, 0); PG8_SCHED; PG8_LDA(At, 1, 0); PG8_STAGE(PG8_SA(0, 1), a2 + hstep, voffA);
            PG8_WAIT_L(8); PG8_BAR; PG8_WAIT_L(0); PG8_MMA(0, 0, At, B0); PG8_BAR; PG8_SCHED;
            PG8_LDB(B1, 1, 1); PG8_STAGE(PG8_SB(1, 0), b3, voffB);
            PG8_BAR; PG8_WAIT_L(0); PG8_MMA(0, 1, At, B1); PG8_BAR;
            PG8_LDA(At, 1, 1); PG8_STAGE(PG8_SA(1, 0), a3, voffA);
            PG8_BAR; PG8_WAIT_L(0); PG8_MMA(1, 0, At, B0); PG8_BAR; PG8_SCHED;
            PG8_STAGE(PG8_SB(1, 1), b3 + hstep, voffB);
            PG8_WAIT_V(6); PG8_BAR; PG8_MMA(1, 1, At, B1); PG8_BAR;
            }
        }
        if constexpr (ALIGN_EPI) { if (wr == 0) PG8_BAR; }
        if constexpr (!Epi::AFTER_DRAIN) { E(acc, cur, wr, wc, fr, fq); S.done(cur); }
        if (!has_next) break;
#pragma unroll
        for (int a = 0; a < 2; ++a)
#pragma unroll
            for (int b = 0; b < 2; ++b)
#pragma unroll
                for (int m = 0; m < 4; ++m)
#pragma unroll
                    for (int n = 0; n < 2; ++n) acc[a][b][m][n] = (f32x4){0.f, 0.f, 0.f, 0.f};
        cur = nxt; cA = nA; cB = nB; ++ui;
        if constexpr (ALIGN_EPI) { if (wr == 1) PG8_BAR; }
    }
    PG8_WAIT_V(0);
    if constexpr (!ALIGN_EPI) { if (wr == 0) PG8_BAR; }
    PG8_BAR;
    if constexpr (Epi::AFTER_DRAIN) { E.fused(acc, cur, wr, wc, fr, fq, lds, wid, lane); S.done(cur); }
#undef PG8_SA
#undef PG8_SB
#undef PG8_STAGE
#undef PG8_LDA
#undef PG8_LDB
#undef PG8_MMA
#undef PG8_WAIT_V
#undef PG8_WAIT_L
#undef PG8_BAR
#undef PG8_SCHED
}
}
#define GAS __attribute__((address_space(1)))
#define LAS __attribute__((address_space(3)))
typedef unsigned short bf16_t;
typedef short bf16x8 __attribute__((ext_vector_type(8)));
typedef short s16x4 __attribute__((ext_vector_type(4)));
typedef float f32x4 __attribute__((ext_vector_type(4)));
typedef unsigned u32x4 __attribute__((ext_vector_type(4)));
typedef unsigned u32x2 __attribute__((ext_vector_type(2)));
typedef _Float16 h16;
typedef _Float16 h16x4 __attribute__((ext_vector_type(4)));

constexpr int NW = 8, NT = 512;
constexpr int DM = 2048, TSEQ = 4096, MP = 8192, MS = 8, MTOT = 8200, MPAD = 8448;
constexpr int SHW = 3264, NPAD = 8448, DR = 1024;
constexpr size_t MiB = 1u << 20;
constexpr size_t WS_XN = 0, WS_WIN = 33 * MiB, WS_E = 0, WS_WOUT = 97 * MiB, WS_WUP = 105 * MiB, WS_AUP = 105 * MiB + 512 * 1024;
constexpr size_t WS_ZS = 106 * MiB, WS_YR = 106 * MiB, WS_MIX = 159 * MiB, WS_QN = 192 * MiB, WS_KN = WS_QN + 17301504, WS_VA = WS_KN + 17301504, WS_PART = 242 * MiB, WS_BAR = 243 * MiB, WS_END = 244 * MiB;
constexpr int O_Y = 0, O_YS = 16777216, O_WKVP = 16793600, O_SHP = 16924672, O_KP = 16931200, O_VP = 21125504, O_WKVS = 25319808, O_SHS = 25844096, O_KS = 25870208, O_VS = 25878400;
constexpr int LDS_BYTES = 147456;
constexpr int ESTRIDE = 768;

__device__ __forceinline__ unsigned f2bf(float f) { unsigned u = __builtin_bit_cast(unsigned, f); return (u + 0x7fffu + ((u >> 16) & 1u)) >> 16; }
typedef __bf16 bf16x2_hw __attribute__((ext_vector_type(2)));
typedef float f32x2_hw __attribute__((ext_vector_type(2)));
__device__ __forceinline__ unsigned pk2(float lo, float hi) { const f32x2_hw v = {lo, hi}; const bf16x2_hw b = __builtin_convertvector(v, bf16x2_hw); return __builtin_bit_cast(unsigned, b); }
__device__ __forceinline__ float bf2f(unsigned short b) { return __builtin_bit_cast(float, (unsigned)b << 16); }
__device__ __forceinline__ float bflo(unsigned w) { return __builtin_bit_cast(float, w << 16); }
__device__ __forceinline__ float bfhi(unsigned w) { return __builtin_bit_cast(float, w & 0xffff0000u); }
__device__ __forceinline__ float wave_sum(float v) {
#pragma unroll
    for (int o = 1; o < 64; o <<= 1) v += __shfl_xor(v, o);
    return v;
}
__device__ __forceinline__ float wave_max(float v) {
#pragma unroll
    for (int o = 1; o < 64; o <<= 1) v = fmaxf(v, __shfl_xor(v, o));
    return v;
}
__device__ __forceinline__ float silu_f(float x) { return x / (1.f + __expf(-x)); }
__device__ __forceinline__ float sigmoid_f(float x) { return 1.f / (1.f + __expf(-x)); }
#define LDS_WAIT() asm volatile("s_waitcnt lgkmcnt(0)" ::: "memory")

struct EpiIn {
    static constexpr bool PERM = true, AFTER_DRAIN = false;
    bf16_t *zs, *mixg, *qn, *kn, *va; float* out; const float *qnw, *knw;
    __device__ __forceinline__ void shift_out(int row, int col, f32x4 v0, f32x4 v1) const {
        float* dst = nullptr;
        if (row == TSEQ - 1) dst = out + O_SHP + col;
        else if (row == 2 * TSEQ - 1) dst = out + O_SHP + SHW + col;
        else if (row >= MP && row < MTOT) dst = out + O_SHS + (row - MP) * SHW + col;
        if (dst) { *(f32x4*)dst = v0; *(f32x4*)(dst + 4) = v1; }
    }
    __device__ __forceinline__ void operator()(const f32x4 (&acc)[2][2][4][2], const pg8::Unit& u, int wr, int wc, int fr, int fq) const {
        const int pn = u.pn, sec = pn >> 2;
        const int rowb = u.pm * 256 + wr * 64 + fr;
        if (pn == 32) {
#pragma unroll
            for (int ai = 0; ai < 2; ++ai)
#pragma unroll
                for (int m = 0; m < 4; ++m) { const int row = rowb + ai * 128 + m * 16;
#pragma unroll
                    for (int bj = 0; bj < 2; ++bj) { const int p0 = 128 * bj + 32 * wc + 8 * fq;
                        if (p0 < 192) { const f32x4 v0 = acc[ai][bj][m][0], v1 = acc[ai][bj][m][1];
                            u32x4 w; w.x = pk2(v0[0], v0[1]); w.y = pk2(v0[2], v0[3]); w.z = pk2(v1[0], v1[1]); w.w = pk2(v1[2], v1[3]);
                            *(u32x4*)(zs + (size_t)row * SHW + 3072 + p0) = w;
                            shift_out(row, 3072 + p0, v0, v1); } } }
            return;
        }
        const int lcb = (pn & 3) * 256 + wc * 64 + fq * 8;
        if (sec <= 2) {
#pragma unroll
            for (int ai = 0; ai < 2; ++ai)
#pragma unroll
                for (int m = 0; m < 4; ++m) { const int row = rowb + ai * 128 + m * 16;
#pragma unroll
                    for (int bj = 0; bj < 2; ++bj) { const int col = sec * 1024 + lcb + bj * 32; const f32x4 v0 = acc[ai][bj][m][0], v1 = acc[ai][bj][m][1];
                        u32x4 w; w.x = pk2(v0[0], v0[1]); w.y = pk2(v0[2], v0[3]); w.z = pk2(v1[0], v1[1]); w.w = pk2(v1[2], v1[3]);
                        *(u32x4*)(zs + (size_t)row * SHW + col) = w;
                        shift_out(row, col, v0, v1); } }
        } else if (sec == 3 || sec == 7) {
            const int cb = (sec == 7 ? 1024 : 0) + lcb;
#pragma unroll
            for (int ai = 0; ai < 2; ++ai)
#pragma unroll
                for (int m = 0; m < 4; ++m) { const int row = rowb + ai * 128 + m * 16;
#pragma unroll
                    for (int bj = 0; bj < 2; ++bj) { const f32x4 v0 = acc[ai][bj][m][0], v1 = acc[ai][bj][m][1];
                        u32x4 w; w.x = pk2(silu_f(v0[0]), silu_f(v0[1])); w.y = pk2(silu_f(v0[2]), silu_f(v0[3])); w.z = pk2(silu_f(v1[0]), silu_f(v1[1])); w.w = pk2(silu_f(v1[2]), silu_f(v1[3]));
                        *(u32x4*)(mixg + (size_t)row * 2048 + cb + bj * 32) = w; } }
        } else if (sec == 6) {
#pragma unroll
            for (int ai = 0; ai < 2; ++ai)
#pragma unroll
                for (int m = 0; m < 4; ++m) { const int row = rowb + ai * 128 + m * 16;
                    float* dst = nullptr; const int t = row & (TSEQ - 1);
                    if (row < MP) { if (t >= 2048) dst = out + O_VP + ((size_t)((row >> 12) * 2048 + (t - 2048))) * 1024; }
                    else if (row < MTOT) dst = out + O_VS + (size_t)(row - MP) * 1024;
#pragma unroll
                    for (int bj = 0; bj < 2; ++bj) { const int col = lcb + bj * 32; const f32x4 v0 = acc[ai][bj][m][0], v1 = acc[ai][bj][m][1];
                        u32x4 w; w.x = pk2(v0[0], v0[1]); w.y = pk2(v0[2], v0[3]); w.z = pk2(v1[0], v1[1]); w.w = pk2(v1[2], v1[3]);
                        *(u32x4*)(va + (size_t)row * 1024 + col) = w;
                        if (dst) { *(f32x4*)(dst + col) = v0; *(f32x4*)(dst + col + 4) = v1; } } }
        } else {
            const bool isq = (sec == 4);
            const float* nwp = isq ? qnw : knw; const float sc = isq ? 0.125f : 1.0f;
            f32x4 nw[2][2];
#pragma unroll
            for (int bj = 0; bj < 2; ++bj) { nw[bj][0] = *(const f32x4*)(nwp + bj * 32 + fq * 8); nw[bj][1] = *(const f32x4*)(nwp + bj * 32 + fq * 8 + 4); }
            bf16_t* ob = isq ? qn : kn;
#pragma unroll
            for (int ai = 0; ai < 2; ++ai)
#pragma unroll
                for (int m = 0; m < 4; ++m) { const int row = rowb + ai * 128 + m * 16;
                    float ss = 0.f;
#pragma unroll
                    for (int bj = 0; bj < 2; ++bj)
#pragma unroll
                        for (int n = 0; n < 2; ++n) { const f32x4 x = acc[ai][bj][m][n]; ss += (x[0] * x[0] + x[1] * x[1]) + (x[2] * x[2] + x[3] * x[3]); }
                    ss += __shfl_xor(ss, 16); ss += __shfl_xor(ss, 32);
                    const float rs = rsqrtf(ss * (1.f / 64.f) + 1e-6f) * sc;
                    float* dst = nullptr; const int t = row & (TSEQ - 1);
                    if (!isq) { if (row < MP) { if (t >= 2048) dst = out + O_KP + ((size_t)((row >> 12) * 2048 + (t - 2048))) * 1024; }
                                else if (row < MTOT) dst = out + O_KS + (size_t)(row - MP) * 1024; }
#pragma unroll
                    for (int bj = 0; bj < 2; ++bj) { const int col = lcb + bj * 32; const f32x4 v0 = acc[ai][bj][m][0] * rs * nw[bj][0], v1 = acc[ai][bj][m][1] * rs * nw[bj][1];
                        u32x4 w; w.x = pk2(v0[0], v0[1]); w.y = pk2(v0[2], v0[3]); w.z = pk2(v1[0], v1[1]); w.w = pk2(v1[2], v1[3]);
                        *(u32x4*)(ob + (size_t)row * 1024 + col) = w;
                        if (dst) { *(f32x4*)(dst + col) = v0; *(f32x4*)(dst + col + 4) = v1; } } }
        }
    }
};
struct EpiOut {
    static constexpr bool PERM = true, AFTER_DRAIN = false;
    const float *xp, *xs; float* out;
    __device__ __forceinline__ void operator()(const f32x4 (&acc)[2][2][4][2], const pg8::Unit& u, int wr, int wc, int fr, int fq) const {
        const int rowb = u.pm * 256 + wr * 64 + fr, colb = u.pn * 256 + wc * 32 + fq * 8;
#pragma unroll
        for (int ai = 0; ai < 2; ++ai)
#pragma unroll
            for (int m = 0; m < 4; ++m) { const int row = rowb + ai * 128 + m * 16;
                const float* xr; float* orow;
                if (row < MP) { xr = xp + (size_t)row * DM; orow = out + O_Y + (size_t)row * DM; }
                else if (row < MTOT) { xr = xs + (size_t)(row - MP) * DM; orow = out + O_YS + (size_t)(row - MP) * DM; }
                else continue;
#pragma unroll
                for (int bj = 0; bj < 2; ++bj) { const int col = colb + bj * 128;
                    *(f32x4*)(orow + col) = acc[ai][bj][m][0] + *(const f32x4*)(xr + col);
                    *(f32x4*)(orow + col + 4) = acc[ai][bj][m][1] + *(const f32x4*)(xr + col + 4); } }
    }
};

__device__ __forceinline__ void p0_transpose_item(const float* W, int Nsrc, int src_n0, int k0, bf16_t* WT, int dst_row0, int Kdst, LAS float* scr, int lane) {
    if (src_n0 < 0) {
        const int c = lane & 7;
#pragma unroll
        for (int j = 0; j < 4; ++j) { const int n = (lane >> 3) + 8 * j; *(u32x4*)(WT + (size_t)(dst_row0 + n) * Kdst + k0 + 8 * c) = (u32x4){0u, 0u, 0u, 0u}; }
        return;
    }
    {
        f32x4 t[8];
#pragma unroll
        for (int i = 0; i < 8; ++i) { const int kk = 8 * i + (lane >> 3); t[i] = *(const f32x4*)(W + (size_t)(k0 + kk) * Nsrc + src_n0 + 4 * (lane & 7)); }
#pragma unroll
        for (int i = 0; i < 8; ++i) { const int kk = 8 * i + (lane >> 3); LAS float* d = scr + kk * 33 + 4 * (lane & 7); d[0] = t[i].x; d[1] = t[i].y; d[2] = t[i].z; d[3] = t[i].w; }
    }
    LDS_WAIT(); asm volatile("" ::: "memory");
    const int c = lane & 7;
#pragma unroll
    for (int j = 0; j < 4; ++j) { const int n = (lane >> 3) + 8 * j; const LAS float* s = scr + (8 * c) * 33 + n;
        u32x4 o; o.x = pk2(s[0 * 33], s[1 * 33]); o.y = pk2(s[2 * 33], s[3 * 33]); o.z = pk2(s[4 * 33], s[5 * 33]); o.w = pk2(s[6 * 33], s[7 * 33]);
        *(u32x4*)(WT + (size_t)(dst_row0 + n) * Kdst + k0 + 8 * c) = o; }
    LDS_WAIT(); asm volatile("" ::: "memory");
}
__device__ __forceinline__ int win_src_col(int n0) {
    const int T = n0 >> 8, p = n0 & 255;
    if (T < 32) { const int s = T >> 2, ts = T & 3, bj = p >> 7, wc = (p & 127) >> 5; const int lc = ts * 256 + wc * 64 + bj * 32;
        return (s < 3 ? s * 1024 : SHW + (s - 3) * 1024) + lc; }
    return p < 192 ? 3072 + p : -1;
}
__device__ __forceinline__ void p0_prologue(const float* xp, const float* xs, const float* nwp, const float* w_in, const float* w_up, const float* a_up, const float* w_out, unsigned char* ws, LAS unsigned char* lds, int G, int bx, int wave, int lane, int tid) {
    LAS float* scr = (LAS float*)(lds + wave * 16384);
    const int gw = bx * NW + wave, NGW = G * NW;
    bf16_t* winT = (bf16_t*)(ws + WS_WIN); bf16_t* woutT = (bf16_t*)(ws + WS_WOUT);
    constexpr int I_IN = 32 * (NPAD / 32), I_OUT = 32 * (DM / 32);
    for (int it = gw; it < I_IN + I_OUT; it += NGW) {
        if (it < I_IN) { const int kb = it / (NPAD / 32), nb = it % (NPAD / 32); p0_transpose_item(w_in, 8384, win_src_col(nb * 32), kb * 64, winT, nb * 32, DM, scr, lane); }
        else { const int r = it - I_IN; const int kb = r / (DM / 32), nb = r % (DM / 32); p0_transpose_item(w_out, DM, nb * 32, kb * 64, woutT, nb * 32, DM, scr, lane); }
    }
    { bf16_t* wupT = (bf16_t*)(ws + WS_WUP); bf16_t* aupT = (bf16_t*)(ws + WS_AUP);
      for (int i = bx * NT + tid; i < 2 * 1024 * 12; i += G * NT) { const int which = i / 12288, r = i % 12288, n = r / 12, c = r % 12;
          const float* W = which ? a_up : w_up; bf16_t* D = which ? aupT : wupT;
          u32x4 o; o.x = pk2(W[(8 * c + 0) * 1024 + n], W[(8 * c + 1) * 1024 + n]); o.y = pk2(W[(8 * c + 2) * 1024 + n], W[(8 * c + 3) * 1024 + n]);
          o.z = pk2(W[(8 * c + 4) * 1024 + n], W[(8 * c + 5) * 1024 + n]); o.w = pk2(W[(8 * c + 6) * 1024 + n], W[(8 * c + 7) * 1024 + n]);
          *(u32x4*)(D + n * 96 + 8 * c) = o; } }
    bf16_t* xn = (bf16_t*)(ws + WS_XN);
    for (int m = gw; m < MPAD; m += NGW) {
        u32x2* o8 = (u32x2*)(xn + (size_t)m * DM) + lane;
        if (m >= MTOT) {
#pragma unroll
            for (int j = 0; j < 8; ++j) o8[64 * j] = (u32x2){0u, 0u};
            continue; }
        const float* xrow = m < MP ? xp + (size_t)m * DM : xs + (size_t)(m - MP) * DM;
        const f32x4* xr = (const f32x4*)xrow + lane;
        f32x4 v[8]; float s = 0.f;
#pragma unroll
        for (int j = 0; j < 8; ++j) { v[j] = xr[64 * j]; s += (v[j].x * v[j].x + v[j].y * v[j].y) + (v[j].z * v[j].z + v[j].w * v[j].w); }
        const float rstd = rsqrtf(wave_sum(s) * (1.f / DM) + 1e-6f);
#pragma unroll
        for (int j = 0; j < 8; ++j) { const f32x4 g = ((const f32x4*)nwp)[lane + 64 * j]; const f32x4 y = v[j] * rstd * g;
            o8[64 * j] = (u32x2){pk2(y.x, y.y), pk2(y.z, y.w)}; }
    }
}
__device__ __forceinline__ size_t e_rec(int m, int h) { return m < MP ? ((size_t)((m >> 12) * 16 + h) * TSEQ + (m & (TSEQ - 1))) : ((size_t)32 * TSEQ + (size_t)(m - MP) * 16 + h); }
struct F8 { f32x4 a, b; };
__device__ __forceinline__ F8 ld_bf8(const bf16_t* p) { const u32x4 w = *(const u32x4*)p; F8 r; r.a = (f32x4){bflo(w.x), bfhi(w.x), bflo(w.y), bfhi(w.y)}; r.b = (f32x4){bflo(w.z), bfhi(w.z), bflo(w.w), bfhi(w.w)}; return r; }
__device__ __forceinline__ F8 ld_prev8(const bf16_t* zs, const float* sst, int m, int col) {
    F8 r;
    if (m >= MP) { const float* p = sst + (m - MP) * SHW + col; r.a = *(const f32x4*)p; r.b = *(const f32x4*)(p + 4); return r; }
    if ((m & (TSEQ - 1)) == 0) { r.a = (f32x4){0.f, 0.f, 0.f, 0.f}; r.b = r.a; return r; }
    return ld_bf8(zs + (size_t)(m - 1) * SHW + col);
}
__device__ __forceinline__ float ld_prev1(const bf16_t* zs, const float* sst, int m, int col) {
    if (m >= MP) return sst[(m - MP) * SHW + col];
    if ((m & (TSEQ - 1)) == 0) return 0.f;
    return bf2f(zs[(size_t)(m - 1) * SHW + col]);
}
__device__ __forceinline__ float tanh_f(float x) { return 1.f - 2.f / (1.f + __expf(2.f * x)); }
__device__ __forceinline__ bf16x8 pack_bf8(f32x4 a, f32x4 b) { u32x4 w; w.x = pk2(a[0], a[1]); w.y = pk2(a[2], a[3]); w.z = pk2(b[0], b[1]); w.w = pk2(b[2], b[3]); return __builtin_bit_cast(bf16x8, w); }

struct F4 { float v[4]; };
__device__ __forceinline__ f32x4 cv_bf4(u32x2 w) { return (f32x4){bflo(w.x), bfhi(w.x), bflo(w.y), bfhi(w.y)}; }
__device__ __forceinline__ f32x4 ld_bf4(const bf16_t* p) { const u32x2 w = *(const u32x2*)p; return (f32x4){bflo(w.x), bfhi(w.x), bflo(w.y), bfhi(w.y)}; }
__device__ __forceinline__ f32x4 ld_prev4(const bf16_t* zs, const float* sst, int m, int col) {
    if (m >= MP) return *(const f32x4*)(sst + (m - MP) * SHW + col);
    if ((m & (TSEQ - 1)) == 0) return (f32x4){0.f, 0.f, 0.f, 0.f};
    return ld_bf4(zs + (size_t)(m - 1) * SHW + col);
}
typedef _Float16 h16x4s __attribute__((ext_vector_type(4)));
__device__ __forceinline__ void st_h4l(LAS unsigned char* p, f32x4 v) { h16x4s h; h[0] = (h16)v[0]; h[1] = (h16)v[1]; h[2] = (h16)v[2]; h[3] = (h16)v[3]; *(LAS h16x4s*)p = h; }
__device__ __forceinline__ void st_h4(unsigned char* p, f32x4 v) { h16x4s h; h[0] = (h16)v[0]; h[1] = (h16)v[1]; h[2] = (h16)v[2]; h[3] = (h16)v[3]; *(h16x4s*)p = h; }
__device__ __forceinline__ int m_of(int tg, int lane) { return 16 * tg + (lane & 15); }
template <bool SAMP> __device__ __forceinline__ F8 prev8(const bf16_t* zs, const float* sst, int m, int col, bool first) {
    if (SAMP) { const float* p = sst + (m - MP) * SHW + col; F8 r; r.a = *(const f32x4*)p; r.b = *(const f32x4*)(p + 4); return r; }
    F8 r = ld_bf8(zs + (size_t)(m - (first ? 0 : 1)) * SHW + col); const float z = first ? 0.f : 1.f; r.a = r.a * z; r.b = r.b * z; return r;
}
template <bool SAMP> __device__ __forceinline__ f32x4 prev4(const bf16_t* zs, const float* sst, int m, int col, bool first) {
    if (SAMP) return *(const f32x4*)(sst + (m - MP) * SHW + col);
    const f32x4 r = ld_bf4(zs + (size_t)(m - (first ? 0 : 1)) * SHW + col); return r * (first ? 0.f : 1.f);
}
template <bool SAMP> __device__ __forceinline__ void prep_unit_t(int tg, const bf16_t* __restrict__ zs, unsigned char* __restrict__ Eb, const bf16_t* wupT, const bf16_t* aupT, const float* sst, const float* mu,
                                          const float* w0, const float* a0, const float* k_k, const float* k_a, int wave, int lane, LAS unsigned char* stg, bool do_store = true) {
    const int q = lane & 15, g = lane >> 4;
    constexpr bool samp = SAMP;
    const bool first = !SAMP && ((m_of(tg, lane) & (TSEQ - 1)) == 0);
    const int m = samp ? MP + (q < 8 ? q : 7) : 16 * tg + q;
    const bool wr_ok = !(samp && q >= 8) && do_store;
    bf16x8 Bw[3], Ba[3];
#pragma unroll
    for (int ks = 0; ks < 3; ++ks) {
        { const int col = 3072 + 32 * ks + 8 * g; const F8 c = ld_bf8(zs + (size_t)m * SHW + col), p = prev8<SAMP>(zs, sst, m, col, first);
          const f32x4 m0 = *(const f32x4*)(mu + col), m1 = *(const f32x4*)(mu + col + 4);
          f32x4 xa = c.a + m0 * (p.a - c.a), xb = c.b + m1 * (p.b - c.b);
#pragma unroll
          for (int i = 0; i < 4; ++i) { xa[i] = tanh_f(xa[i]); xb[i] = tanh_f(xb[i]); }
          Bw[ks] = pack_bf8(xa, xb); }
        { const int col = 3168 + 32 * ks + 8 * g; const F8 c = ld_bf8(zs + (size_t)m * SHW + col), p = prev8<SAMP>(zs, sst, m, col, first);
          const f32x4 m0 = *(const f32x4*)(mu + col), m1 = *(const f32x4*)(mu + col + 4);
          const f32x4 xa = c.a + m0 * (p.a - c.a), xb = c.b + m1 * (p.b - c.b);
          Ba[ks] = pack_bf8(xa, xb); }
    }
#pragma unroll 1
    for (int hh = 0; hh < (SAMP ? 1 : 2); ++hh) {
        const int h = SAMP ? wave : 2 * wave + hh;
        unsigned char* erec = Eb + e_rec(m, h) * ESTRIDE;
        f32x4 kkr[4], av[4]; float ss = 0.f;
        u32x2 zrc[4], zkc[4], zvc[4], zrp[4], zkp[4], zvp[4];
        const size_t prow = (size_t)(SAMP ? m : m - (first ? 0 : 1)) * SHW;
#pragma unroll
        for (int j = 0; j < 4; ++j) { const int ch = h * 64 + 16 * j + 4 * g;
            zrc[j] = *(const u32x2*)(zs + (size_t)m * SHW + ch); zkc[j] = *(const u32x2*)(zs + (size_t)m * SHW + 1024 + ch); zvc[j] = *(const u32x2*)(zs + (size_t)m * SHW + 2048 + ch);
            zrp[j] = *(const u32x2*)(zs + prow + ch); zkp[j] = *(const u32x2*)(zs + prow + 1024 + ch); zvp[j] = *(const u32x2*)(zs + prow + 2048 + ch); }
#pragma unroll
        for (int j = 0; j < 4; ++j) {
            const int chA = h * 64 + 16 * j + q;
            const int ch = h * 64 + 16 * j + 4 * g;
            f32x4 cw = (f32x4){0.f, 0.f, 0.f, 0.f}, ca = cw;
#pragma unroll
            for (int ks = 0; ks < 3; ++ks) {
                const bf16x8 aw = *(const bf16x8*)(wupT + chA * 96 + 32 * ks + 8 * g), aa = *(const bf16x8*)(aupT + chA * 96 + 32 * ks + 8 * g);
                cw = __builtin_amdgcn_mfma_f32_16x16x32_bf16(aw, Bw[ks], cw, 0, 0, 0);
                ca = __builtin_amdgcn_mfma_f32_16x16x32_bf16(aa, Ba[ks], ca, 0, 0, 0);
            }
            const f32x4 w0c = *(const f32x4*)(w0 + ch), a0c = *(const f32x4*)(a0 + ch), kkc = *(const f32x4*)(k_k + ch), kac = *(const f32x4*)(k_a + ch);
            const f32x4 mur = *(const f32x4*)(mu + ch), muk = *(const f32x4*)(mu + 1024 + ch), muv = *(const f32x4*)(mu + 2048 + ch);
            const f32x4 rc = cv_bf4(zrc[j]), kc = cv_bf4(zkc[j]), vc = cv_bf4(zvc[j]);
            f32x4 rp, kp, vp;
            if (SAMP) { rp = *(const f32x4*)(sst + (m - MP) * SHW + ch); kp = *(const f32x4*)(sst + (m - MP) * SHW + 1024 + ch); vp = *(const f32x4*)(sst + (m - MP) * SHW + 2048 + ch); }
            else { const float z = first ? 0.f : 1.f; rp = cv_bf4(zrp[j]) * z; kp = cv_bf4(zkp[j]) * z; vp = cv_bf4(zvp[j]) * z; }
            const f32x4 rv = rc + mur * (rp - rc), vv = vc + muv * (vp - vc), km = kc + muk * (kp - kc);
            f32x4 a, u;
#pragma unroll
            for (int c = 0; c < 4; ++c) { a[c] = sigmoid_f(a0c[c] + ca[c]); u[c] = expm1f(-0.60653065971f * sigmoid_f(w0c[c] + cw[c])); }
            const f32x4 kr = km * kkc; kkr[j] = kr; av[j] = a; ss += (kr[0] * kr[0] + kr[1] * kr[1]) + (kr[2] * kr[2] + kr[3] * kr[3]);
            if (SAMP) { if (wr_ok) { unsigned char* e = erec + (16 * j + 4 * g) * 2;
                st_h4(e, u); st_h4(e + 128, km * (1.f + (a - 1.f) * kac)); st_h4(e + 512, rv); st_h4(e + 640, vv); } }
            else { LAS unsigned char* e = stg + q * 784 + (16 * j + 4 * g) * 2;
                st_h4l(e, u); st_h4l(e + 128, km * (1.f + (a - 1.f) * kac)); st_h4l(e + 512, rv); st_h4l(e + 640, vv); }
        }
        ss += __shfl_xor(ss, 16); ss += __shfl_xor(ss, 32);
        const float inv = 1.f / fmaxf(sqrtf(ss), 1e-12f);
        if (SAMP) { if (wr_ok) {
#pragma unroll
            for (int j = 0; j < 4; ++j) { unsigned char* e = erec + (16 * j + 4 * g) * 2; const f32x4 kk = kkr[j] * inv;
                st_h4(e + 256, -kk); st_h4(e + 384, kk * av[j]); } } }
        else {
#pragma unroll
            for (int j = 0; j < 4; ++j) { LAS unsigned char* e = stg + q * 784 + (16 * j + 4 * g) * 2; const f32x4 kk = kkr[j] * inv;
                st_h4l(e + 256, -kk); st_h4l(e + 384, kk * av[j]); }
            LDS_WAIT(); asm volatile("" ::: "memory");
            unsigned char* gb = Eb + e_rec(16 * tg, h) * ESTRIDE;
            if (do_store) {
#pragma unroll
                for (int it = 0; it < 12; ++it) { const int x = it * 64 + lane; const u32x4 w = *(const LAS u32x4*)(stg + (x / 48) * 784 + (x % 48) * 16); *(u32x4*)(gb + (size_t)x * 16) = w; }
            }
            LDS_WAIT(); asm volatile("" ::: "memory");
        }
    }
}

__device__ __forceinline__ void prep_unit(int tg, const bf16_t* zs, unsigned char* Eb, const bf16_t* wupT, const bf16_t* aupT, const float* sst, const float* mu,
                                          const float* w0, const float* a0, const float* k_k, const float* k_a, int wave, int lane, LAS unsigned char* lds, bool do_store = true) {
    LAS unsigned char* stg = lds + wave * (16 * 784);
    if (tg >= 512) prep_unit_t<true>(tg, zs, Eb, wupT, aupT, sst, mu, w0, a0, k_k, k_a, wave  , lane, stg, do_store);
    else prep_unit_t<false>(tg, zs, Eb, wupT, aupT, sst, mu, w0, a0, k_k, k_a, wave, lane, stg, do_store);
}

__device__ __forceinline__ s16x4 tr_read(LAS unsigned char* p) { return __builtin_bit_cast(s16x4, __builtin_amdgcn_ds_read_tr16_b64_v4i16((LAS s16x4*)p)); }
constexpr int ACC_PITCH = 68;
__device__ __forceinline__ void attn_pair_shared(int p, int wave, int mb, int tb, int h, float slope, const bf16_t* qn, const bf16_t* kn, const bf16_t* va,
                                                 LAS float* accL, LAS float* mL, LAS float* lL, LAS unsigned char* vst, int lane) {
    const int q = lane & 15, g = lane >> 4;
    const int d = p == 0 ? 1 : 4;
    const float sd = slope * (float)d;
    const int base = p == 0 ? 32 * wave : (wave & 3) + 128 * (wave >> 2);
    const int tok0 = tb + base;
    bf16x8 qa[2], qb[2]; float m_run[2], l_run[2]; f32x4 O[2][4];
#pragma unroll
    for (int j = 0; j < 2; ++j) {
        const bf16_t* qp = qn + (size_t)(mb + tok0 + (16 * j + q) * d) * 1024 + h * 64 + 8 * g;
        qa[j] = *(const bf16x8*)qp; qb[j] = *(const bf16x8*)(qp + 32);
        m_run[j] = -INFINITY; l_run[j] = 0.f;
#pragma unroll
        for (int i = 0; i < 4; ++i) O[j][i] = (f32x4){0.f, 0.f, 0.f, 0.f};
    }
#define AP_LOADKV(KS, KA, KB, V0, V1) do { int _kt = tok0 + (16 * (KS) + q - 128) * d; _kt = _kt < 0 ? 0 : _kt; const bf16_t* _kp = kn + (size_t)(mb + _kt) * 1024 + h * 64 + 8 * g; \
        KA = *(const bf16x8*)_kp; KB = *(const bf16x8*)(_kp + 32); int _vt = tok0 + (16 * (KS) + (lane >> 2) - 128) * d; _vt = _vt < 0 ? 0 : _vt; \
        const bf16_t* _vp = va + (size_t)(mb + _vt) * 1024 + h * 64 + 16 * (lane & 3); V0 = *(const u32x4*)_vp; V1 = *(const u32x4*)(_vp + 8); } while (0)
    bf16x8 nka, nkb; u32x4 nv0, nv1;
    AP_LOADKV(0, nka, nkb, nv0, nv1);
#pragma unroll 1
    for (int ks = 0; ks < 10; ++ks) {
        const bf16x8 ka = nka, kb = nkb; const u32x4 v0 = nv0, v1 = nv1;
        { const int kn1 = ks < 9 ? ks + 1 : 9; AP_LOADKV(kn1, nka, nkb, nv0, nv1); }
        asm volatile("" ::: "memory");
        *(LAS u32x4*)(vst + (lane >> 2) * 144 + (lane & 3) * 32) = v0; *(LAS u32x4*)(vst + (lane >> 2) * 144 + (lane & 3) * 32 + 16) = v1;
        s16x4 pb[2];
#pragma unroll
        for (int j = 0; j < 2; ++j) {
            f32x4 S = (f32x4){0.f, 0.f, 0.f, 0.f};
            S = __builtin_amdgcn_mfma_f32_16x16x32_bf16(ka, qa[j], S, 0, 0, 0);
            S = __builtin_amdgcn_mfma_f32_16x16x32_bf16(kb, qb[j], S, 0, 0, 0);
            float s[4]; float mx = -INFINITY;
#pragma unroll
            for (int c = 0; c < 4; ++c) { const int ki = 16 * ks + 4 * g + c; const int off = 16 * j + q + 128 - ki; const int ktok = tok0 + (ki - 128) * d;
                const bool valid = (off >= 0) && (off <= 128) && (ktok >= 0);
                s[c] = valid ? S[c] - sd * (float)off : -INFINITY; mx = fmaxf(mx, s[c]); }
            mx = fmaxf(mx, __shfl_xor(mx, 16)); mx = fmaxf(mx, __shfl_xor(mx, 32));
            const float m_new = fmaxf(m_run[j], mx);
            float sc = 1.f, pe[4] = {0.f, 0.f, 0.f, 0.f};
            if (m_new > -INFINITY) { sc = __expf(m_run[j] - m_new);
#pragma unroll
                for (int c = 0; c < 4; ++c) pe[c] = __expf(s[c] - m_new); }
            l_run[j] = l_run[j] * sc + ((pe[0] + pe[1]) + (pe[2] + pe[3])); m_run[j] = m_new;
#pragma unroll
            for (int i = 0; i < 4; ++i) O[j][i] = O[j][i] * sc;
            u32x2 pw; pw.x = pk2(pe[0], pe[1]); pw.y = pk2(pe[2], pe[3]);
            pb[j] = __builtin_bit_cast(s16x4, pw);
        }
        LDS_WAIT(); asm volatile("" ::: "memory");
#pragma unroll
        for (int blk = 0; blk < 4; ++blk) {
            const s16x4 vtr = tr_read(vst + (4 * g + ((lane & 15) >> 2)) * 144 + (16 * blk + 4 * (lane & 3)) * 2);
            O[0][blk] = __builtin_amdgcn_mfma_f32_16x16x16bf16_1k(vtr, pb[0], O[0][blk], 0, 0, 0);
            O[1][blk] = __builtin_amdgcn_mfma_f32_16x16x16bf16_1k(vtr, pb[1], O[1][blk], 0, 0, 0);
        }
        LDS_WAIT(); asm volatile("" ::: "memory");
    }
#undef AP_LOADKV
#pragma unroll
    for (int j = 0; j < 2; ++j) {
        float lr = l_run[j]; lr += __shfl_xor(lr, 16); lr += __shfl_xor(lr, 32);
        const int ti = base + (16 * j + q) * d;
        LAS float* ar = accL + ti * ACC_PITCH + 4 * g;
        if (p == 0) {
#pragma unroll
            for (int blk = 0; blk < 4; ++blk) *(LAS f32x4*)(ar + 16 * blk) = O[j][blk];
            if (g == 0) { mL[ti] = m_run[j]; lL[ti] = lr; }
        } else {
            const float mo = mL[ti], lo = lL[ti];
            const float mn = fmaxf(mo, m_run[j]), ao = __expf(mo - mn), an = __expf(m_run[j] - mn);
#pragma unroll
            for (int blk = 0; blk < 4; ++blk) { const f32x4 old = *(LAS f32x4*)(ar + 16 * blk); *(LAS f32x4*)(ar + 16 * blk) = old * ao + O[j][blk] * an; }
            LDS_WAIT(); asm volatile("" ::: "memory");
            if (g == 0) { mL[ti] = mn; lL[ti] = lo * ao + lr * an; }
        }
    }
}
__device__ __forceinline__ void attn_unit(int unit, const bf16_t* qn, const bf16_t* kn, const bf16_t* va, const bf16_t* mixg, bf16_t* mixo, LAS unsigned char* lds, int wave, int lane, int tid) {
    const int b = unit >> 8, h = (unit >> 4) & 15, sp = unit & 15;
    const int mb = b * TSEQ, tb = sp * 256;
    LAS float* accL = (LAS float*)lds; LAS float* mL = (LAS float*)(lds + 256 * ACC_PITCH * 4); LAS float* lL = mL + 256;
    LAS unsigned char* vst = lds + 256 * ACC_PITCH * 4 + 2048 + wave * 2304;
    const int q = lane & 15, g = lane >> 4;
    const float slope = exp2f(-0.5f * (float)(h + 1));
#pragma unroll 1
    for (int p = 0; p < 3; ++p) {
        const int d = p == 0 ? 1 : (p == 1 ? 4 : 16);
        const float sd = slope * (float)d;
        if (p < 2) { attn_pair_shared(p, wave, mb, tb, h, slope, qn, kn, va, accL, mL, lL, vst, lane); __syncthreads(); continue; }
#pragma unroll 1
        for (int tt = 0; tt < 2; ++tt) {
            const int tile = 2 * wave + tt;
            const int base = p == 0 ? 16 * tile : (p == 1 ? 64 * (tile >> 2) + (tile & 3) : tile);
            const int tok0 = tb + base;
            const bf16_t* qp = qn + (size_t)(mb + tok0 + q * d) * 1024 + h * 64 + 8 * g;
            const bf16x8 qa = *(const bf16x8*)qp, qb = *(const bf16x8*)(qp + 32);
            float m_run = -INFINITY, l_run = 0.f;
            f32x4 O[4];
#pragma unroll
            for (int i = 0; i < 4; ++i) O[i] = (f32x4){0.f, 0.f, 0.f, 0.f};
#define AT_LOADKV(KS, KA, KB, V0, V1) do { int _kt = tok0 + (16 * (KS) + q - 128) * d; _kt = _kt < 0 ? 0 : _kt; const bf16_t* _kp = kn + (size_t)(mb + _kt) * 1024 + h * 64 + 8 * g; \
                KA = *(const bf16x8*)_kp; KB = *(const bf16x8*)(_kp + 32); int _vt = tok0 + (16 * (KS) + (lane >> 2) - 128) * d; _vt = _vt < 0 ? 0 : _vt; \
                const bf16_t* _vp = va + (size_t)(mb + _vt) * 1024 + h * 64 + 16 * (lane & 3); V0 = *(const u32x4*)_vp; V1 = *(const u32x4*)(_vp + 8); } while (0)
            bf16x8 nka, nkb; u32x4 nv0, nv1;
            AT_LOADKV(0, nka, nkb, nv0, nv1);
#pragma unroll 1
            for (int ks = 0; ks < 9; ++ks) {
                const bf16x8 ka = nka, kb = nkb; const u32x4 v0 = nv0, v1 = nv1;
                { const int kn1 = ks < 8 ? ks + 1 : 8; AT_LOADKV(kn1, nka, nkb, nv0, nv1); }
                asm volatile("" ::: "memory");
                *(LAS u32x4*)(vst + (lane >> 2) * 144 + (lane & 3) * 32) = v0; *(LAS u32x4*)(vst + (lane >> 2) * 144 + (lane & 3) * 32 + 16) = v1;
                f32x4 S = (f32x4){0.f, 0.f, 0.f, 0.f};
                S = __builtin_amdgcn_mfma_f32_16x16x32_bf16(ka, qa, S, 0, 0, 0);
                S = __builtin_amdgcn_mfma_f32_16x16x32_bf16(kb, qb, S, 0, 0, 0);
                float s[4]; float mx = -INFINITY;
                if (ks >= 1 && ks <= 7 && tok0 >= 128 * d) {
#pragma unroll
                    for (int c = 0; c < 4; ++c) { const int off = q + 128 - (16 * ks + 4 * g + c); s[c] = S[c] - sd * (float)off; mx = fmaxf(mx, s[c]); }
                } else {
#pragma unroll
                for (int c = 0; c < 4; ++c) { const int ki = 16 * ks + 4 * g + c; const int off = q + 128 - ki; const int ktok = tok0 + (ki - 128) * d;
                    const bool valid = (off >= 0) && (off <= 128) && (ktok >= 0);
                    s[c] = valid ? S[c] - sd * (float)off : -INFINITY; mx = fmaxf(mx, s[c]); }
                }
                mx = fmaxf(mx, __shfl_xor(mx, 16)); mx = fmaxf(mx, __shfl_xor(mx, 32));
                const float m_new = fmaxf(m_run, mx);
                float sc = 1.f, pe[4] = {0.f, 0.f, 0.f, 0.f};
                if (m_new > -INFINITY) { sc = __expf(m_run - m_new);
#pragma unroll
                    for (int c = 0; c < 4; ++c) pe[c] = __expf(s[c] - m_new); }
                l_run = l_run * sc + ((pe[0] + pe[1]) + (pe[2] + pe[3])); m_run = m_new;
#pragma unroll
                for (int i = 0; i < 4; ++i) O[i] = O[i] * sc;
                u32x2 pw; pw.x = pk2(pe[0], pe[1]); pw.y = pk2(pe[2], pe[3]);
                const s16x4 pb = __builtin_bit_cast(s16x4, pw);
                LDS_WAIT(); asm volatile("" ::: "memory");
#pragma unroll
                for (int blk = 0; blk < 4; ++blk) {
                    const s16x4 vtr = tr_read(vst + (4 * g + ((lane & 15) >> 2)) * 144 + (16 * blk + 4 * (lane & 3)) * 2);
                    O[blk] = __builtin_amdgcn_mfma_f32_16x16x16bf16_1k(vtr, pb, O[blk], 0, 0, 0);
                }
                LDS_WAIT(); asm volatile("" ::: "memory");
            }
            l_run += __shfl_xor(l_run, 16); l_run += __shfl_xor(l_run, 32);
            const int ti = base + q * d;
            LAS float* ar = accL + ti * ACC_PITCH + 4 * g;
            if (p == 0) {
#pragma unroll
                for (int blk = 0; blk < 4; ++blk) *(LAS f32x4*)(ar + 16 * blk) = O[blk];
                if (g == 0) { mL[ti] = m_run; lL[ti] = l_run; }
            } else {
                const float mo = mL[ti], lo = lL[ti];
                const float mn = fmaxf(mo, m_run), ao = __expf(mo - mn), an = __expf(m_run - mn);
#pragma unroll
                for (int blk = 0; blk < 4; ++blk) { const f32x4 old = *(LAS f32x4*)(ar + 16 * blk); *(LAS f32x4*)(ar + 16 * blk) = old * ao + O[blk] * an; }
                LDS_WAIT(); asm volatile("" ::: "memory");
                if (g == 0) { mL[ti] = mn; lL[ti] = lo * ao + l_run * an; }
            }
        }
        __syncthreads();
    }
    {
        const int ti = tid >> 1, hf = tid & 1;
        const float inv = 1.f / lL[ti];
        const size_t go = (size_t)(mb + tb + ti) * 2048 + 1024 + h * 64 + 32 * hf; const bf16_t* gp = mixg + go; bf16_t* op = mixo + go;
        const LAS float* ar = accL + ti * ACC_PITCH + 32 * hf;
#pragma unroll
        for (int c8 = 0; c8 < 4; ++c8) { const F8 gt = ld_bf8(gp + 8 * c8); const f32x4 o0 = *(const LAS f32x4*)(ar + 8 * c8) * inv * gt.a, o1 = *(const LAS f32x4*)(ar + 8 * c8 + 4) * inv * gt.b;
            u32x4 w; w.x = pk2(o0[0], o0[1]); w.y = pk2(o0[2], o0[3]); w.z = pk2(o1[0], o1[1]); w.w = pk2(o1[2], o1[3]);
            *(u32x4*)(op + 8 * c8) = w; }
    }
    __syncthreads();
}

constexpr int SA_KC = 26, SA_NKC = 5, SA_NPART = 15, SA_TASKS = 128 * SA_NPART, SA_PSTRIDE = 66;
__device__ __forceinline__ void attn_sample_part(int task, const bf16_t* qn, const bf16_t* kn, const bf16_t* va, const float* ck, const float* cv, float* part, int lane) {
    const int sbh = task / SA_NPART, pk = task % SA_NPART, p = pk / SA_NKC, kc = pk % SA_NKC;
    const int sb = sbh >> 4, h = sbh & 15, m = MP + sb; const int d = p == 0 ? 1 : (p == 1 ? 4 : 16);
    const float ql = bf2f(qn[(size_t)m * 1024 + h * 64 + lane]);
    const float slope = exp2f(-0.5f * (float)(h + 1));
    float kv[SA_KC];
#pragma unroll
    for (int jj = 0; jj < SA_KC; ++jj) { const int j = SA_KC * kc + jj; const int jc = j > 128 ? 128 : j;
        kv[jj] = (jc == 0) ? bf2f(kn[(size_t)m * 1024 + h * 64 + lane]) : ck[(((size_t)sb * 2048 + (2048 - jc * d)) * 16 + h) * 64 + lane]; }
    float sc[SA_KC]; float mx = -INFINITY;
#pragma unroll
    for (int jj = 0; jj < SA_KC; ++jj) { const int j = SA_KC * kc + jj; const float dot = wave_sum(ql * kv[jj]);
        sc[jj] = (j <= 128) ? dot - slope * (float)(j * d) : -INFINITY; mx = fmaxf(mx, sc[jj]); }
#pragma unroll
    for (int jj = 0; jj < SA_KC; ++jj) { const int j = SA_KC * kc + jj; const int jc = j > 128 ? 128 : j;
        kv[jj] = (jc == 0) ? bf2f(va[(size_t)m * 1024 + h * 64 + lane]) : cv[(((size_t)sb * 2048 + (2048 - jc * d)) * 16 + h) * 64 + lane]; }
    float o = 0.f, l = 0.f;
#pragma unroll
    for (int jj = 0; jj < SA_KC; ++jj) { const float pe = __expf(sc[jj] - mx); l += pe; o = fmaf(pe, kv[jj], o); }
    float* pp = part + (size_t)task * SA_PSTRIDE;
    pp[lane] = o; if (lane == 0) { pp[64] = mx; pp[65] = l; }
}
__device__ __forceinline__ void attn_sample_combine(int sbh, const float* part, bf16_t* mixg, int lane) {
    const float* pp = part + (size_t)sbh * SA_NPART * SA_PSTRIDE;
    float M = -INFINITY;
#pragma unroll
    for (int i = 0; i < SA_NPART; ++i) M = fmaxf(M, pp[i * SA_PSTRIDE + 64]);
    float o = 0.f, l = 0.f;
#pragma unroll
    for (int i = 0; i < SA_NPART; ++i) { const float w = __expf(pp[i * SA_PSTRIDE + 64] - M); o = fmaf(w, pp[i * SA_PSTRIDE + lane], o); l = fmaf(w, pp[i * SA_PSTRIDE + 65], l); }
    const size_t go = (size_t)(MP + (sbh >> 4)) * 2048 + 1024 + (sbh & 15) * 64 + lane;
    mixg[go] = (bf16_t)f2bf(o / l * bf2f(mixg[go]));
}

template <int CTRL> __device__ __forceinline__ float dpp_mov(float v) { return __builtin_bit_cast(float, __builtin_amdgcn_update_dpp(0, __builtin_bit_cast(int, v), CTRL, 0xF, 0xF, true)); }
__device__ __forceinline__ float red16(float v) { v += dpp_mov<0xB1>(v); v += dpp_mov<0x4E>(v); v += dpp_mov<0x141>(v); v += dpp_mov<0x140>(v); return v; }
struct StepIn { h16x4 w, k, a, b, r; h16 v; };
__device__ __forceinline__ float do_step(float (&S)[4], const StepIn& in) {
    float sa = 0.f;
#pragma unroll
    for (int c = 0; c < 4; ++c) sa = fmaf(S[c], (float)in.a[c], sa);
    sa = red16(sa);
    const float v = (float)in.v; float y = 0.f;
#pragma unroll
    for (int c = 0; c < 4; ++c) { float t = fmaf(v, (float)in.k[c], S[c]); asm("" : "+v"(t)); t = fmaf(sa, (float)in.b[c], t); asm("" : "+v"(t));
        S[c] = fmaf((float)in.w[c], S[c], t); asm("" : "+v"(S[c])); y = fmaf(S[c], (float)in.r[c], y); }
    return red16(y);
}
#define FMIX_DECL(NAME, MODS, ZERO) \
__device__ __forceinline__ float NAME(float a, unsigned h, float c) { float d; asm("v_fma_mix_f32 %0, %1, %2, " ZERO " " MODS : "=v"(d) : "v"(a), "v"(h), "v"(c)); return d; }
FMIX_DECL(mix_lo, "op_sel_hi:[0,1,0]", "%3")
FMIX_DECL(mix_hi, "op_sel:[0,1,0] op_sel_hi:[0,1,0]", "%3")
__device__ __forceinline__ float mix0_lo(float a, unsigned h) { float d; asm("v_fma_mix_f32 %0, %1, %2, 0 op_sel_hi:[0,1,0]" : "=v"(d) : "v"(a), "v"(h)); return d; }
__device__ __forceinline__ float mix0_hi(float a, unsigned h) { float d; asm("v_fma_mix_f32 %0, %1, %2, 0 op_sel:[0,1,0] op_sel_hi:[0,1,0]" : "=v"(d) : "v"(a), "v"(h)); return d; }
__device__ __forceinline__ float mixh_lo(unsigned vh, unsigned h, float c) { float d; asm("v_fma_mix_f32 %0, %1, %2, %3 op_sel_hi:[1,1,0]" : "=v"(d) : "v"(vh), "v"(h), "v"(c)); return d; }
__device__ __forceinline__ float mixh_hi(unsigned vh, unsigned h, float c) { float d; asm("v_fma_mix_f32 %0, %1, %2, %3 op_sel:[0,1,0] op_sel_hi:[1,1,0]" : "=v"(d) : "v"(vh), "v"(h), "v"(c)); return d; }
struct StepRaw { u32x2 w, k, a, b, r; unsigned v; };
__device__ __forceinline__ float do_step2(float (&S)[4], const StepRaw& in, float& yprev) {
    float pre[4];
    pre[0] = mix_lo(S[0], in.w.x, mixh_lo(in.v, in.k.x, S[0])); pre[1] = mix_hi(S[1], in.w.x, mixh_hi(in.v, in.k.x, S[1]));
    pre[2] = mix_lo(S[2], in.w.y, mixh_lo(in.v, in.k.y, S[2])); pre[3] = mix_hi(S[3], in.w.y, mixh_hi(in.v, in.k.y, S[3]));
    const float s01 = mix_hi(S[1], in.a.x, mix0_lo(S[0], in.a.x)), s23 = mix_hi(S[3], in.a.y, mix0_lo(S[2], in.a.y));
    float sa = s01 + s23, yp = yprev;
    sa += dpp_mov<0xB1>(sa); yp += dpp_mov<0xB1>(yp);
    sa += dpp_mov<0x4E>(sa); yp += dpp_mov<0x4E>(yp);
    sa += dpp_mov<0x141>(sa); yp += dpp_mov<0x141>(yp);
    sa += dpp_mov<0x140>(sa); yp += dpp_mov<0x140>(yp);
    yprev = yp;
    S[0] = mix_lo(sa, in.b.x, pre[0]); S[1] = mix_hi(sa, in.b.x, pre[1]); S[2] = mix_lo(sa, in.b.y, pre[2]); S[3] = mix_hi(sa, in.b.y, pre[3]);
    const float y01 = mix_hi(S[1], in.r.x, mix0_lo(S[0], in.r.x)), y23 = mix_hi(S[3], in.r.y, mix0_lo(S[2], in.r.y));
    return y01 + y23;
}
__device__ __forceinline__ void scan_one(const unsigned char* rec, int rq, const float* S0, float* Sout, float* yp, int lane) {
    const int rr = lane >> 4, jq = lane & 15, i = 4 * rq + rr;
    float S[4]; { const f32x4 s = *(const f32x4*)(S0 + i * 64 + 4 * jq); S[0] = s.x; S[1] = s.y; S[2] = s.z; S[3] = s.w; }
    StepIn in; in.w = *(const h16x4*)(rec + jq * 8); in.k = *(const h16x4*)(rec + 128 + jq * 8); in.a = *(const h16x4*)(rec + 256 + jq * 8); in.b = *(const h16x4*)(rec + 384 + jq * 8);
    in.r = *(const h16x4*)(rec + 512 + jq * 8); in.v = *(const h16*)(rec + 640 + i * 2);
    const float y = do_step(S, in); if (jq == 0) yp[i] = y;
    *(f32x4*)(Sout + i * 64 + 4 * jq) = (f32x4){S[0], S[1], S[2], S[3]};
}
constexpr int SC_CH = 64, SC_CHB = SC_CH * ESTRIDE, SC_NCH = TSEQ / SC_CH;
__device__ __forceinline__ void scan_pair(int pair, const unsigned char* Eb, float* out, float* yraw, LAS unsigned char* lds, int wave, int lane) {
    const int bh = pair >> 3, rq = ((pair & 7) << 1) + (wave & 1);
    const unsigned char* base = Eb + (size_t)bh * TSEQ * ESTRIDE;
    const int rr = lane >> 4, jq = lane & 15, i = 4 * rq + rr;
    float S[4] = {0.f, 0.f, 0.f, 0.f};
    float* yp = yraw + (size_t)((bh >> 4) * TSEQ) * 1024 + (bh & 15) * 64 + i;
    float ypart = 0.f, ycap = 0.f; float* dummy = yraw + (size_t)(MPAD - 1) * 1024 + (bh & 15) * 64 + i;
#define SC_ISSUE(kc) do { const int _kc = (kc) < SC_NCH ? (kc) : SC_NCH - 1; const unsigned char* _g = base + (size_t)_kc * SC_CHB; LAS unsigned char* _l = lds + ((kc) & 1) * SC_CHB; \
        _Pragma("unroll") for (int _p = 0; _p < 8; ++_p) { const int _x = (8 * (wave - 2) + _p) * 64; \
            __builtin_amdgcn_global_load_lds((const unsigned*)(_g + (size_t)(_x + lane) * 16), (LAS unsigned*)(_l + _x * 16), 16, 0, 0); } } while (0)
    if (wave >= 2) { SC_ISSUE(0); asm volatile("s_waitcnt vmcnt(0)" ::: "memory"); }
    __builtin_amdgcn_s_barrier(); asm volatile("" ::: "memory");
#pragma unroll 1
    for (int k = 0; k < SC_NCH; ++k) {
        if (wave >= 2) { SC_ISSUE(k + 1); asm volatile("s_waitcnt vmcnt(0)" ::: "memory"); }
        else {
            const LAS unsigned char* bp = lds + (k & 1) * SC_CHB;
#define SC_LD1(DST, SIDX) do { const LAS unsigned char* p = bp + (SIDX) * ESTRIDE; \
                DST.w = *(const LAS u32x2*)(p + jq * 8); DST.k = *(const LAS u32x2*)(p + 128 + jq * 8); DST.a = *(const LAS u32x2*)(p + 256 + jq * 8); DST.b = *(const LAS u32x2*)(p + 384 + jq * 8); \
                DST.r = *(const LAS u32x2*)(p + 512 + jq * 8); DST.v = *(const LAS unsigned short*)(p + 640 + i * 2); } while (0)
            StepRaw nx; SC_LD1(nx, 0);
#pragma unroll 8
            for (int s = 0; s < SC_CH; ++s) {
                const StepRaw in = nx;
                asm volatile("" ::: "memory");
                { const int sn = s + 1 < SC_CH ? s + 1 : SC_CH - 1; SC_LD1(nx, sn); }
                asm volatile("" ::: "memory");
                float yr = ypart; ypart = do_step2(S, in, yr);
                { const int tp = k * SC_CH + s - 1;
                  ycap = ((jq & 3) == (tp & 3)) ? yr : ycap;
                  if (((s - 1) & 3) == 3) { float* dst = tp < 0 ? dummy : yp + (size_t)(tp - 3 + (jq & 3)) * 1024; *dst = ycap; } }
            }
#undef SC_LD1
        }
        asm volatile("" ::: "memory"); __builtin_amdgcn_s_barrier(); asm volatile("" ::: "memory");
    }
    if (wave >= 2) asm volatile("s_waitcnt vmcnt(0)" ::: "memory");
    if (wave < 2) { const float yl = red16(ypart); ycap = ((jq & 3) == 3) ? yl : ycap; yp[(size_t)(TSEQ - 4 + (jq & 3)) * 1024] = ycap; *(f32x4*)(out + O_WKVP + (size_t)bh * 4096 + i * 64 + 4 * jq) = (f32x4){S[0], S[1], S[2], S[3]}; }
    __builtin_amdgcn_s_barrier(); asm volatile("" ::: "memory");
#undef SC_ISSUE
}

template <int CTRL> __device__ __forceinline__ float dpp_mov(float v);
__device__ __forceinline__ float quad_sum(float v) { v += dpp_mov<0xB1>(v); v += dpp_mov<0x4E>(v); return v; }
__device__ __forceinline__ void fin_token(int m, const float* yraw, const unsigned char* Eb, bf16_t* mixg, const float* gn_w, const float* gn_b, const float* r_k, int lane) {
    const int h = lane >> 2, qt = lane & 3, ch0 = lane * 16;
    f32x4 y[4];
#pragma unroll
    for (int i = 0; i < 4; ++i) y[i] = *(const f32x4*)(yraw + (size_t)m * 1024 + ch0 + 4 * i);
    const unsigned char* e = Eb + e_rec(m, h) * ESTRIDE + qt * 32;
    const u32x4 rr0 = *(const u32x4*)(e + 512), rr1 = *(const u32x4*)(e + 528), kk0 = *(const u32x4*)(e + 128), kk1 = *(const u32x4*)(e + 144), vv0 = *(const u32x4*)(e + 640), vv1 = *(const u32x4*)(e + 656);
    bf16_t* gp = mixg + (size_t)m * 2048 + ch0;
    const F8 g0 = ld_bf8(gp), g1 = ld_bf8(gp + 8);
    float s = 0.f;
#pragma unroll
    for (int i = 0; i < 4; ++i) s += (y[i].x + y[i].y) + (y[i].z + y[i].w);
    const float mean = quad_sum(s) * (1.f / 64.f);
    float q = 0.f;
#pragma unroll
    for (int i = 0; i < 4; ++i) { y[i] = y[i] - mean; q += (y[i].x * y[i].x + y[i].y * y[i].y) + (y[i].z * y[i].z + y[i].w * y[i].w); }
    const float rstd = rsqrtf(quad_sum(q) * (1.f / 64.f) + 64e-5f);
    typedef _Float16 h16x8 __attribute__((ext_vector_type(8)));
    const h16x8 r0 = __builtin_bit_cast(h16x8, rr0), r1 = __builtin_bit_cast(h16x8, rr1), k0 = __builtin_bit_cast(h16x8, kk0), k1 = __builtin_bit_cast(h16x8, kk1), v0 = __builtin_bit_cast(h16x8, vv0), v1 = __builtin_bit_cast(h16x8, vv1);
    float bs = 0.f;
#pragma unroll
    for (int i = 0; i < 8; ++i) { bs = fmaf((float)r0[i] * (float)k0[i], r_k[ch0 + i], bs); bs = fmaf((float)r1[i] * (float)k1[i], r_k[ch0 + 8 + i], bs); }
    bs = quad_sum(bs);
    float o[16];
#pragma unroll
    for (int i = 0; i < 16; ++i) { const float yn = y[i >> 2][i & 3] * rstd * gn_w[ch0 + i] + gn_b[ch0 + i];
        const float vv = i < 8 ? (float)v0[i & 7] : (float)v1[i & 7]; const float gt = i < 4 ? g0.a[i & 3] : (i < 8 ? g0.b[i & 3] : (i < 12 ? g1.a[i & 3] : g1.b[i & 3]));
        o[i] = (yn + bs * vv) * gt; }
    u32x4 w0, w1; w0.x = pk2(o[0], o[1]); w0.y = pk2(o[2], o[3]); w0.z = pk2(o[4], o[5]); w0.w = pk2(o[6], o[7]); w1.x = pk2(o[8], o[9]); w1.y = pk2(o[10], o[11]); w1.z = pk2(o[12], o[13]); w1.w = pk2(o[14], o[15]);
    *(u32x4*)gp = w0; *(u32x4*)(gp + 8) = w1;
}
__device__ __forceinline__ void outproj_sample_col(int d, const bf16_t* mixg, const bf16_t* woutT, const float* xs, float* out, int lane) {
    float acc[8] = {0.f, 0.f, 0.f, 0.f, 0.f, 0.f, 0.f, 0.f};
#pragma unroll
    for (int i = 0; i < 4; ++i) { const int e0 = 8 * lane + 512 * i; const F8 w = ld_bf8(woutT + (size_t)d * DM + e0);
#pragma unroll
        for (int r = 0; r < 8; ++r) { const F8 x = ld_bf8(mixg + (size_t)(MP + r) * DM + e0);
            acc[r] += (w.a[0] * x.a[0] + w.a[1] * x.a[1]) + (w.a[2] * x.a[2] + w.a[3] * x.a[3]) + (w.b[0] * x.b[0] + w.b[1] * x.b[1]) + (w.b[2] * x.b[2] + w.b[3] * x.b[3]); } }
#pragma unroll
    for (int r = 0; r < 8; ++r) { const float t = wave_sum(acc[r]); if (lane == r) out[O_YS + r * DM + d] = t + xs[r * DM + d]; }
}

#define XB_TMO      128
#define XB_XCNT(j)  (256  + 64 * (j))
#define XB_XSUB(j)  (1280 + 64 * (j))
#define XB_XGEN(j)  (2304 + 64 * (j))
#define XB_TOP      3328
#define XB_TOPGEN   3392
#define XCD_BAR_WORDS 3456
#define XB_SPIN_CAP (1u << 18)

__device__ __forceinline__ unsigned xb_ld(unsigned* p)              { return __hip_atomic_load(p, __ATOMIC_RELAXED, __HIP_MEMORY_SCOPE_AGENT); }
__device__ __forceinline__ unsigned xb_add(unsigned* p, unsigned v) { return __hip_atomic_fetch_add(p, v, __ATOMIC_RELAXED, __HIP_MEMORY_SCOPE_AGENT); }
__device__ __forceinline__ unsigned xb_xcc_id() { return (unsigned)__builtin_amdgcn_s_getreg((3 << 11) | 20) & 0xFu; }
#define XB_SPIN(cond, bar) do { unsigned _sp = 0; while (cond) { __builtin_amdgcn_s_sleep(1); \
    if ((++_sp & 255u) == 0u) { if (xb_ld(&(bar)[XB_TMO])) break; if (_sp > XB_SPIN_CAP) { atomicAdd(&(bar)[XB_TMO], 1u); break; } } } } while (0)

struct XcdBarrier {
    unsigned* bar; unsigned x;
    volatile LAS unsigned* st;
};

__device__ __forceinline__ XcdBarrier xcd_barrier_post(unsigned* bar, volatile LAS unsigned* st) {
    XcdBarrier b; b.bar = bar; b.x = xb_xcc_id(); b.st = st;
    if (threadIdx.x == 0) (void)xb_add(&bar[XB_XCNT(b.x)], 1u);
    return b;
}
__device__ __forceinline__ void xcd_barrier_complete(unsigned* bar, unsigned x, unsigned& nloc, unsigned& nx) {
    const unsigned G = gridDim.x * gridDim.y * gridDim.z;
    unsigned sum, cnt, mine, sp = 0u;
    for (;;) {
        sum = 0u; cnt = 0u; mine = 0u;
#pragma unroll
        for (unsigned j = 0; j < 16; ++j) { const unsigned c = xb_ld(&bar[XB_XCNT(j)]); sum += c; cnt += (c > 0u) ? 1u : 0u; mine = (j == x) ? c : mine; }
        if (sum == G) break;
        __builtin_amdgcn_s_sleep(1);
        if ((++sp & 255u) == 0u) { if (xb_ld(&bar[XB_TMO])) break; if (sp > XB_SPIN_CAP) { atomicAdd(&bar[XB_TMO], 1u); break; } }
    }
    nloc = mine > 0u ? mine : 1u; nx = cnt > 0u ? cnt : 1u;
}

__device__ __forceinline__ void xcd_barrier(const XcdBarrier& b) {
    asm volatile("s_waitcnt vmcnt(0)" ::: "memory");
    __syncthreads();
    if (threadIdx.x == 0) {
        unsigned* bar = b.bar;
        __builtin_amdgcn_s_waitcnt(0);
        unsigned nloc = b.st[0], nx = b.st[1];
        if (nloc == 0u) { xcd_barrier_complete(bar, b.x, nloc, nx); b.st[0] = nloc; b.st[1] = nx; }
        const unsigned old = xb_add(&bar[XB_XSUB(b.x)], 1u);
        const unsigned gen = old / nloc;
        if (old + 1u == (gen + 1u) * nloc) {
            __builtin_amdgcn_fence(__ATOMIC_RELEASE, "agent");
            asm volatile("s_waitcnt vmcnt(0)" ::: "memory");
            const unsigned og = xb_add(&bar[XB_TOP], 1u);
            const unsigned tg = og / nx;
            if (og + 1u == (tg + 1u) * nx) xb_add(&bar[XB_TOPGEN], 1u);
            else XB_SPIN(xb_ld(&bar[XB_TOPGEN]) == tg, bar);
            __builtin_amdgcn_fence(__ATOMIC_ACQUIRE, "agent");
            xb_add(&bar[XB_XGEN(b.x)], 1u);
            asm volatile("s_waitcnt vmcnt(0)" ::: "memory");
        } else {
            XB_SPIN(xb_ld(&bar[XB_XGEN(b.x)]) == gen, bar);
            __builtin_amdgcn_fence(__ATOMIC_ACQUIRE, "agent");
            asm volatile("s_waitcnt vmcnt(0)" ::: "memory");
        }
    }
    __syncthreads();
}


struct Args { const float* in[21]; float* out; unsigned char* ws; };
__global__ void __launch_bounds__(NT, 2) mk_fwd(Args a) {
    extern __shared__ __attribute__((aligned(16))) unsigned char lds_raw[];
    LAS unsigned char* lds = (LAS unsigned char*)lds_raw;
    cg::grid_group grid = cg::this_grid();
    const int tid = threadIdx.x, lane = tid & 63, wave = __builtin_amdgcn_readfirstlane(tid >> 6);
    const int G = gridDim.x, bx = blockIdx.x;
    unsigned char* ws = a.ws; float* out = a.out;
    bf16_t* xn = (bf16_t*)(ws + WS_XN); bf16_t* winT = (bf16_t*)(ws + WS_WIN); bf16_t* woutT = (bf16_t*)(ws + WS_WOUT);
    bf16_t* wupT = (bf16_t*)(ws + WS_WUP); bf16_t* aupT = (bf16_t*)(ws + WS_AUP);
    bf16_t* zs = (bf16_t*)(ws + WS_ZS); float* yraw = (float*)(ws + WS_YR); bf16_t* mixg = (bf16_t*)(ws + WS_MIX);
    bf16_t* qn = (bf16_t*)(ws + WS_QN); bf16_t* kn = (bf16_t*)(ws + WS_KN); bf16_t* va = (bf16_t*)(ws + WS_VA);
    unsigned char* Eb = ws + WS_E; float* part = (float*)(ws + WS_PART);
    { volatile LAS unsigned* xst = (volatile LAS unsigned*)(lds + 147328);
      if (tid == 0) { xst[0] = 0u; xst[1] = 0u; }
      __syncthreads();
      (void)xcd_barrier_post((unsigned*)(ws + WS_BAR), xst); }
#define GBAR() do { XcdBarrier _b; _b.bar = (unsigned*)(a.ws + WS_BAR); _b.x = xb_xcc_id(); _b.st = (volatile LAS unsigned*)(lds + 147328); xcd_barrier(_b); } while (0)

#ifndef PROBE_DUP
#define PROBE_DUP 0
#endif
    p0_prologue(a.in[0], a.in[1], a.in[6], a.in[7], a.in[10], a.in[12], a.in[20], ws, lds, G, bx, wave, lane, tid);
    if (a.out == nullptr) grid.sync();
    GBAR();
    { pg8::Gemm g{xn, winT, MPAD, NPAD, DM}; pg8::StaticOrder S; S.init(MPAD, NPAD, G, bx);
      EpiIn E{zs, mixg, qn, kn, va, out, a.in[18], a.in[19]};
      pg8::gemm_phase<EpiIn, pg8::StaticOrder, true, true>(lds, g, S, E); }
    GBAR();
    for (int t = bx * NW + wave; t < SA_TASKS; t += G * NW) attn_sample_part(t, qn, kn, va, a.in[4], a.in[5], part, lane);
    for (int u = bx; u < 512; u += G) prep_unit(u, zs, Eb, wupT, aupT, a.in[3], a.in[8], a.in[9], a.in[11], a.in[13], a.in[14], wave, lane, lds);
    if (G >= 16) { if (bx >= G - 16 && wave == 0) prep_unit(512, zs, Eb, wupT, aupT, a.in[3], a.in[8], a.in[9], a.in[11], a.in[13], a.in[14], bx - (G - 16), lane, lds); }
    else if (bx == G - 1) { for (int hd = wave; hd < 16; hd += NW) prep_unit(512, zs, Eb, wupT, aupT, a.in[3], a.in[8], a.in[9], a.in[11], a.in[13], a.in[14], hd, lane, lds); }
    __syncthreads();
    { const int vcu2 = (G % 8 == 0) ? (bx % 8) * (G / 8) + bx / 8 : bx;
      for (int u = vcu2; u < 512; u += G) attn_unit(u, qn, kn, va, mixg, mixg, lds, wave, lane, tid); }
    GBAR();
    {
        for (int gw = bx * NW + wave; gw < 2048; gw += G * NW) { const int sbh = gw >> 4, rq = gw & 15, sb = sbh >> 4, h = sbh & 15;
            scan_one(Eb + e_rec(MP + sb, h) * ESTRIDE, rq, a.in[2] + (size_t)sbh * 4096, out + O_WKVS + (size_t)sbh * 4096, yraw + (size_t)(MP + sb) * 1024 + h * 64, lane); }
        const int vcu = (G % 8 == 0) ? (bx % 8) * (G / 8) + bx / 8 : bx;
        for (int pair = vcu; pair < 256; pair += G) scan_pair(pair, Eb, out, yraw, lds, wave, lane);
    }
    GBAR();
    for (int t = bx * NW + wave; t < MTOT + 128; t += G * NW) { if (t < MTOT) fin_token(t, yraw, Eb, mixg, a.in[16], a.in[17], a.in[15], lane); else attn_sample_combine(t - MTOT, part, mixg, lane); }
    GBAR();
    { pg8::Gemm g{mixg, woutT, MP, DM, DM}; pg8::StaticOrder S; S.init(MP, DM, G, bx);
      EpiOut E{a.in[0], a.in[1], out};
      pg8::gemm_phase<EpiOut, pg8::StaticOrder, true, true>(lds, g, S, E); }
    for (int d = bx * NW + wave; d < DM; d += G * NW) outproj_sample_col(d, mixg, woutT, a.in[1], out, lane);
}

extern "C" void kernel_launch(void* const* d_in, const int* in_sizes, int n_in, void* d_out, int out_size, void* d_ws, size_t ws_size, hipStream_t stream) {
    static int grid = 0;
    if (grid == 0) {
        if (n_in != 21 || ws_size < WS_END) { fprintf(stderr, "kernel_launch: unexpected n_in %d / ws %zu\n", n_in, ws_size); grid = -1; return; }
        int dev = 0, cus = 0, per_cu = 0;
        (void)hipGetDevice(&dev); (void)hipDeviceGetAttribute(&cus, hipDeviceAttributeMultiprocessorCount, dev);
        (void)hipFuncSetAttribute((const void*)mk_fwd, hipFuncAttributeMaxDynamicSharedMemorySize, LDS_BYTES);
        (void)hipOccupancyMaxActiveBlocksPerMultiprocessor(&per_cu, (const void*)mk_fwd, NT, LDS_BYTES);
        if (per_cu < 1) { fprintf(stderr, "kernel_launch: occupancy query reports %d\n", per_cu); per_cu = 1; }
        grid = cus * 1;
        (void)hipGetLastError();
    }
    if (grid < 0) return;
    if (hipMemsetAsync((char*)d_ws + WS_BAR, 0, 16384, stream) != hipSuccess) { fprintf(stderr, "kernel_launch: memset of barrier words failed\n"); return; }
    Args a{};
    for (int i = 0; i < 21; ++i) a.in[i] = (const float*)d_in[i];
    a.out = (float*)d_out; a.ws = (unsigned char*)d_ws;
    void* args[] = {&a};
    hipError_t e = hipLaunchCooperativeKernel((const void*)mk_fwd, dim3(grid), dim3(NT), args, LDS_BYTES, stream);
    if (e != hipSuccess) fprintf(stderr, "cooperative launch failed: %s (grid %d)\n", hipGetErrorString(e), grid);
}
```

```cpp
#include <hip/hip_runtime.h>
#include <hip/hip_cooperative_groups.h>
#include <cstdio>
#include <cstdint>
namespace cg = cooperative_groups;
namespace pg8 {
#define PG8_LAS __attribute__((address_space(3)))
typedef unsigned short bf16_t;
typedef short bf16x8 __attribute__((ext_vector_type(8)));
typedef float f32x4 __attribute__((ext_vector_type(4)));
typedef unsigned u32x4 __attribute__((ext_vector_type(4)));
constexpr int BM = 256, BK = 64, HALF = 128, HTB = HALF * BK * 2, STAGE_BYTES = 8 * HTB, NXCD = 8, WGM = 8;
__host__ __device__ __forceinline__ int lds_byte(int r, int c) { const int st = (r >> 4) * 2 + (c >> 5), rr = r & 15, cc = c & 31, ob = rr * 64 + cc * 2; return st * 1024 + (ob ^ (((ob >> 9) & 1) << 5)); }
__host__ __device__ __forceinline__ void stage_rc(int b, int& R, int& C) { const int st = b / 1024, sb = b % 1024, swz = sb ^ (((sb >> 9) & 1) << 5); R = (st >> 1) * 16 + swz / 64; C = (st & 1) * 32 + (swz % 64) / 2; }
__host__ __device__ __forceinline__ int perm32(int rho) { const int n = rho >> 4, i = rho & 15; return 8 * (i >> 2) + 4 * n + (i & 3); }

struct Unit { int pm, pn; };
struct Gemm { const bf16_t* A; const bf16_t* Bt; int M, N, K; };

struct StaticOrder {
    int nM, nN, nwg, G, c;
    __host__ __device__ void init(int M, int N, int G_, int c_) { nM = M / BM; nN = N / BM; nwg = nM * nN; G = G_; c = c_; }
    __host__ __device__ bool next(int i, Unit& u) const {
        const long L = (long)i * G + c; if (L >= nwg) return false;
        int wgid = (int)L; { const int q = nwg / NXCD, r = nwg % NXCD, xcd = wgid % NXCD, off = wgid / NXCD; wgid = (xcd < r ? xcd * (q + 1) : r * (q + 1) + (xcd - r) * q) + off; }
        const int nig = WGM * nN, gid = wgid / nig, fm = gid * WGM, gsz = (nM - fm) < WGM ? (nM - fm) : WGM;
        u.pm = fm + ((wgid % nig) % gsz); u.pn = (wgid % nig) / gsz; return true;
    }
    __device__ __forceinline__ void a_ready(const Unit&) const {}
    __device__ __forceinline__ void done(const Unit&) const {}
};
template <class Epi, class Sched, bool ALIGN_EPI = false, bool SP2 = false>
__device__ __forceinline__ void gemm_phase(PG8_LAS unsigned char* lds, const Gemm g, const Sched& S, const Epi& E) {
    const int tid = threadIdx.x, wid = __builtin_amdgcn_readfirstlane(tid >> 6), lane = tid & 63, wr = wid >> 2, wc = wid & 3, fr = lane & 15, fq = lane >> 4;
    const int K = g.K, nt = K / BK;
    unsigned voffA[2], voffB[2];
#pragma unroll
    for (int i = 0; i < 2; ++i) { int R, C; stage_rc(tid * 16 + i * 8192, R, C); const int Rb = Epi::PERM ? ((R & ~31) + perm32(R & 31)) : R;
        voffA[i] = (unsigned)(R * K + C) * 2u; voffB[i] = (unsigned)(Rb * K + C) * 2u; }
    const size_t kstep = (size_t)(BK * 2);
    const size_t hstep = (size_t)HALF * K * 2;
    const size_t tstep = 2 * hstep;
    const unsigned ldsw = (unsigned)wid * 1024u;
    const int aoff = lds_byte(wr * 64 + fr, fq * 8), boff = lds_byte(wc * 32 + fr, fq * 8);
#define PG8_SA(b, h) (((b) * 2 + (h)) * HTB)
#define PG8_SB(b, h) ((4 + (b) * 2 + (h)) * HTB)
#define PG8_STAGE(bufoff, gbase, voff) do { _Pragma("unroll") for (int _i = 0; _i < 2; ++_i) \
        __builtin_amdgcn_global_load_lds((const unsigned*)((const char*)(gbase) + (voff)[_i]), (PG8_LAS unsigned*)(lds + (bufoff) + ldsw + _i * 8192), 16, 0, 0); } while (0)
#define PG8_LDA(dst, b, h) do { _Pragma("unroll") for (int m = 0; m < 4; ++m) _Pragma("unroll") for (int k = 0; k < 2; ++k) dst[m][k] = *(const PG8_LAS bf16x8*)(lds + PG8_SA(b, h) + aoff + m * 2048 + k * 1024); } while (0)
#define PG8_LDB(dst, b, h) do { _Pragma("unroll") for (int n = 0; n < 2; ++n) _Pragma("unroll") for (int k = 0; k < 2; ++k) dst[n][k] = *(const PG8_LAS bf16x8*)(lds + PG8_SB(b, h) + boff + n * 2048 + k * 1024); } while (0)
#define PG8_MMA(ai, bj, At, Bt) do { __builtin_amdgcn_s_setprio(1); _Pragma("unroll") for (int m = 0; m < 4; ++m) _Pragma("unroll") for (int n = 0; n < 2; ++n) _Pragma("unroll") for (int k = 0; k < 2; ++k) \
        acc[ai][bj][m][n] = __builtin_amdgcn_mfma_f32_16x16x32_bf16(Bt[n][k], At[m][k], acc[ai][bj][m][n], 0, 0, 0); __builtin_amdgcn_s_setprio(0); } while (0)
#define PG8_WAIT_V(n) asm volatile("s_waitcnt vmcnt(" #n ")" ::: "memory")
#define PG8_WAIT_L(n) asm volatile("s_waitcnt lgkmcnt(" #n ")" ::: "memory")
#define PG8_BAR __builtin_amdgcn_s_barrier()
#define PG8_SCHED __builtin_amdgcn_sched_barrier(0)
    Unit cur, nxt; int ui = 0;
    if (!S.next(0, cur)) return;
    f32x4 acc[2][2][4][2];
#pragma unroll
    for (int a = 0; a < 2; ++a)
#pragma unroll
        for (int b = 0; b < 2; ++b)
#pragma unroll
            for (int m = 0; m < 4; ++m)
#pragma unroll
                for (int n = 0; n < 2; ++n) acc[a][b][m][n] = (f32x4){0.f, 0.f, 0.f, 0.f};
    bf16x8 At[4][2], B0[2][2], B1[2][2];
    const char* cA = (const char*)g.A + (size_t)cur.pm * tstep; const char* cB = (const char*)g.Bt + (size_t)cur.pn * tstep;
    S.a_ready(cur);
    if constexpr (SP2) {
        PG8_STAGE(PG8_SB(0, 0), cB, voffB); PG8_STAGE(PG8_SB(0, 1), cB + hstep, voffB); PG8_STAGE(PG8_SA(0, 0), cA, voffA); PG8_STAGE(PG8_SA(0, 1), cA + hstep, voffA);
        if (wr == 1) PG8_BAR;
        PG8_WAIT_V(2); PG8_BAR;
        PG8_STAGE(PG8_SB(1, 0), cB + kstep, voffB); PG8_STAGE(PG8_SA(1, 0), cA + kstep, voffA); PG8_STAGE(PG8_SB(1, 1), cB + hstep + kstep, voffB);
        PG8_WAIT_V(6); PG8_BAR;
    } else {
        PG8_STAGE(PG8_SB(0, 0), cB, voffB); PG8_STAGE(PG8_SA(0, 0), cA, voffA); PG8_STAGE(PG8_SB(0, 1), cB + hstep, voffB); PG8_STAGE(PG8_SA(0, 1), cA + hstep, voffA);
        if (wr == 1) PG8_BAR;
        PG8_WAIT_V(4); PG8_BAR;
        PG8_STAGE(PG8_SB(1, 0), cB + kstep, voffB); PG8_STAGE(PG8_SA(1, 0), cA + kstep, voffA); PG8_STAGE(PG8_SB(1, 1), cB + hstep + kstep, voffB);
        PG8_WAIT_V(6); PG8_BAR;
    }
    for (;;) {
        const bool has_next = S.next(ui + 1, nxt);
        const char* nA = has_next ? (const char*)g.A + (size_t)nxt.pm * tstep : cA; const char* nB = has_next ? (const char*)g.Bt + (size_t)nxt.pn * tstep : cB;
        for (int t = 0; t < nt; t += 2) {
            const bool last = (t == nt - 2);
            const char* a1 = cA + (size_t)(t + 1) * kstep;
            const char* a2 = last ? nA : cA + (size_t)(t + 2) * kstep; const char* b2 = last ? nB : cB + (size_t)(t + 2) * kstep;
            const char* a3 = a2 + kstep; const char* b3 = b2 + kstep;
            if (last && has_next) S.a_ready(nxt);
            if constexpr (SP2) {
            PG8_LDB(B0, 0, 0); PG8_LDB(B1, 0, 1); PG8_SCHED; PG8_LDA(At, 0, 0); PG8_STAGE(PG8_SA(1, 1), a1 + hstep, voffA);
            PG8_WAIT_V(8); PG8_WAIT_L(0); PG8_BAR; PG8_MMA(0, 0, At, B0); PG8_MMA(0, 1, At, B1); PG8_BAR; PG8_SCHED;
            PG8_LDA(At, 0, 1); PG8_STAGE(PG8_SB(0, 0), b2, voffB); PG8_STAGE(PG8_SB(0, 1), b2 + hstep, voffB); PG8_STAGE(PG8_SA(0, 0), a2, voffA);
            PG8_WAIT_V(8); PG8_WAIT_L(0); PG8_BAR; PG8_MMA(1, 0, At, B0); PG8_MMA(1, 1, At, B1); PG8_BAR; PG8_SCHED;
            PG8_LDB(B0, 1, 0); PG8_LDB(B1, 1, 1); PG8_SCHED; PG8_LDA(At, 1, 0); PG8_STAGE(PG8_SA(0, 1), a2 + hstep, voffA);
            PG8_WAIT_V(8); PG8_WAIT_L(0); PG8_BAR; PG8_MMA(0, 0, At, B0); PG8_MMA(0, 1, At, B1); PG8_BAR; PG8_SCHED;
            PG8_LDA(At, 1, 1); PG8_STAGE(PG8_SB(1, 0), b3, voffB); PG8_STAGE(PG8_SB(1, 1), b3 + hstep, voffB); PG8_STAGE(PG8_SA(1, 0), a3, voffA);
            PG8_WAIT_V(8); PG8_WAIT_L(0); PG8_BAR; PG8_MMA(1, 0, At, B0); PG8_MMA(1, 1, At, B1); PG8_BAR; PG8_SCHED;
            } else {
            PG8_LDB(B0, 0, 0); PG8_SCHED; PG8_LDA(At, 0, 0); PG8_STAGE(PG8_SA(1, 1), a1 + hstep, voffA);
            PG8_WAIT_L(8); PG8_BAR; PG8_WAIT_L(0); PG8_MMA(0, 0, At, B0); PG8_BAR; PG8_SCHED;
            PG8_LDB(B1, 0, 1); PG8_STAGE(PG8_SB(0, 0), b2, voffB);
            PG8_BAR; PG8_WAIT_L(0); PG8_MMA(0, 1, At, B1); PG8_BAR;
            PG8_LDA(At, 0, 1); PG8_STAGE(PG8_SA(0, 0), a2, voffA);
            PG8_BAR; PG8_WAIT_L(0); PG8_MMA(1, 0, At, B0); PG8_BAR; PG8_SCHED;
            PG8_STAGE(PG8_SB(0, 1), b2 + hstep, voffB);
            PG8_WAIT_V(6); PG8_BAR; PG8_MMA(1, 1, At, B1); PG8_BAR;
            PG8_LDB(B0, 1, 0); PG8_SCHED; PG8_LDA(At, 1, 0); PG8_STAGE(PG8_SA(0, 1), a2 + hstep, voffA);
            PG8_WAIT_L(8); PG8_BAR; PG8_WAIT_L(0); PG8_MMA(0, 0, At, B0); PG8_BAR; PG8_SCHED;
            PG8_LDB(B1, 1, 1); PG8_STAGE(PG8_SB(1, 0), b3, voffB);
            PG8_BAR; PG8_WAIT_L(0); PG8_MMA(0, 1, At, B1); PG8_BAR;
            PG8_LDA(At, 1, 1); PG8_STAGE(PG8_SA(1, 0), a3, voffA);
            PG8_BAR; PG8_WAIT_L(0); PG8_MMA(1, 0, At, B0); PG8_BAR; PG8_SCHED;
            PG8_STAGE(PG8_SB(1, 1), b3 + hstep, voffB);
            PG8_WAIT_V(6); PG8_BAR; PG8_MMA(1, 1, At, B1); PG8_BAR;
            }
        }
        if constexpr (ALIGN_EPI) { if (wr == 0) PG8_BAR; }
        if constexpr (!Epi::AFTER_DRAIN) { E(acc, cur, wr, wc, fr, fq); S.done(cur); }
        if (!has_next) break;
#pragma unroll
        for (int a = 0; a < 2; ++a)
#pragma unroll
            for (int b = 0; b < 2; ++b)
#pragma unroll
                for (int m = 0; m < 4; ++m)
#pragma unroll
                    for (int n = 0; n < 2; ++n) acc[a][b][m][n] = (f32x4){0.f, 0.f, 0.f, 0.f};
        cur = nxt; cA = nA; cB = nB; ++ui;
        if constexpr (ALIGN_EPI) { if (wr == 1) PG8_BAR; }
    }
    PG8_WAIT_V(0);
    if constexpr (!ALIGN_EPI) { if (wr == 0) PG8_BAR; }
    PG8_BAR;
    if constexpr (Epi::AFTER_DRAIN) { E.fused(acc, cur, wr, wc, fr, fq, lds, wid, lane); S.done(cur); }
#undef PG8_SA
#undef PG8_SB
#undef PG8_STAGE
#undef PG8_LDA
#undef PG8_LDB
#undef PG8_MMA
#undef PG8_WAIT_V
#undef PG8_WAIT_L
#undef PG8_BAR
#undef PG8_SCHED
}
}
#define GAS __attribute__((address_space(1)))
#define LAS __attribute__((address_space(3)))
typedef unsigned short bf16_t;
typedef short bf16x8 __attribute__((ext_vector_type(8)));
typedef short s16x4 __attribute__((ext_vector_type(4)));
typedef float f32x4 __attribute__((ext_vector_type(4)));
typedef unsigned u32x4 __attribute__((ext_vector_type(4)));
typedef unsigned u32x2 __attribute__((ext_vector_type(2)));
typedef _Float16 h16;
typedef _Float16 h16x4 __attribute__((ext_vector_type(4)));

constexpr int NW = 8, NT = 512;
constexpr int DM = 2048, TSEQ = 4096, MP = 8192, MS = 8, MTOT = 8200, MPAD = 8448;
constexpr int SHW = 3264, NPAD = 8448, DR = 1024;
constexpr size_t MiB = 1u << 20;
constexpr size_t WS_XN = 0, WS_WIN = 33 * MiB, WS_E = 0, WS_WOUT = 97 * MiB, WS_WUP = 105 * MiB, WS_AUP = 105 * MiB + 512 * 1024;
constexpr size_t WS_ZS = 106 * MiB, WS_YR = 106 * MiB, WS_MIX = 159 * MiB, WS_QN = 192 * MiB, WS_KN = WS_QN + 17301504, WS_VA = WS_KN + 17301504, WS_PART = 242 * MiB, WS_BAR = 243 * MiB, WS_END = 244 * MiB;
constexpr int O_Y = 0, O_YS = 16777216, O_WKVP = 16793600, O_SHP = 16924672, O_KP = 16931200, O_VP = 21125504, O_WKVS = 25319808, O_SHS = 25844096, O_KS = 25870208, O_VS = 25878400;
constexpr int LDS_BYTES = 147456;
constexpr int ESTRIDE = 768;

__device__ __forceinline__ unsigned f2bf(float f) { unsigned u = __builtin_bit_cast(unsigned, f); return (u + 0x7fffu + ((u >> 16) & 1u)) >> 16; }
typedef __bf16 bf16x2_hw __attribute__((ext_vector_type(2)));
typedef float f32x2_hw __attribute__((ext_vector_type(2)));
__device__ __forceinline__ unsigned pk2(float lo, float hi) { const f32x2_hw v = {lo, hi}; const bf16x2_hw b = __builtin_convertvector(v, bf16x2_hw); return __builtin_bit_cast(unsigned, b); }
__device__ __forceinline__ float bf2f(unsigned short b) { return __builtin_bit_cast(float, (unsigned)b << 16); }
__device__ __forceinline__ float bflo(unsigned w) { return __builtin_bit_cast(float, w << 16); }
__device__ __forceinline__ float bfhi(unsigned w) { return __builtin_bit_cast(float, w & 0xffff0000u); }
__device__ __forceinline__ float wave_sum(float v) {
#pragma unroll
    for (int o = 1; o < 64; o <<= 1) v += __shfl_xor(v, o);
    return v;
}
__device__ __forceinline__ float wave_max(float v) {
#pragma unroll
    for (int o = 1; o < 64; o <<= 1) v = fmaxf(v, __shfl_xor(v, o));
    return v;
}
__device__ __forceinline__ float silu_f(float x) { return x / (1.f + __expf(-x)); }
__device__ __forceinline__ float sigmoid_f(float x) { return 1.f / (1.f + __expf(-x)); }
#define LDS_WAIT() asm volatile("s_waitcnt lgkmcnt(0)" ::: "memory")

struct EpiIn {
    static constexpr bool PERM = true, AFTER_DRAIN = false;
    bf16_t *zs, *mixg, *qn, *kn, *va; float* out; const float *qnw, *knw;
    __device__ __forceinline__ void shift_out(int row, int col, f32x4 v0, f32x4 v1) const {
        float* dst = nullptr;
        if (row == TSEQ - 1) dst = out + O_SHP + col;
        else if (row == 2 * TSEQ - 1) dst = out + O_SHP + SHW + col;
        else if (row >= MP && row < MTOT) dst = out + O_SHS + (row - MP) * SHW + col;
        if (dst) { *(f32x4*)dst = v0; *(f32x4*)(dst + 4) = v1; }
    }
    __device__ __forceinline__ void operator()(const f32x4 (&acc)[2][2][4][2], const pg8::Unit& u, int wr, int wc, int fr, int fq) const {
        const int pn = u.pn, sec = pn >> 2;
        const int rowb = u.pm * 256 + wr * 64 + fr;
        if (pn == 32) {
#pragma unroll
            for (int ai = 0; ai < 2; ++ai)
#pragma unroll
                for (int m = 0; m < 4; ++m) { const int row = rowb + ai * 128 + m * 16;
#pragma unroll
                    for (int bj = 0; bj < 2; ++bj) { const int p0 = 128 * bj + 32 * wc + 8 * fq;
                        if (p0 < 192) { const f32x4 v0 = acc[ai][bj][m][0], v1 = acc[ai][bj][m][1];
                            u32x4 w; w.x = pk2(v0[0], v0[1]); w.y = pk2(v0[2], v0[3]); w.z = pk2(v1[0], v1[1]); w.w = pk2(v1[2], v1[3]);
                            *(u32x4*)(zs + (size_t)row * SHW + 3072 + p0) = w;
                            shift_out(row, 3072 + p0, v0, v1); } } }
            return;
        }
        const int lcb = (pn & 3) * 256 + wc * 64 + fq * 8;
        if (sec <= 2) {
#pragma unroll
            for (int ai = 0; ai < 2; ++ai)
#pragma unroll
                for (int m = 0; m < 4; ++m) { const int row = rowb + ai * 128 + m * 16;
#pragma unroll
                    for (int bj = 0; bj < 2; ++bj) { const int col = sec * 1024 + lcb + bj * 32; const f32x4 v0 = acc[ai][bj][m][0], v1 = acc[ai][bj][m][1];
                        u32x4 w; w.x = pk2(v0[0], v0[1]); w.y = pk2(v0[2], v0[3]); w.z = pk2(v1[0], v1[1]); w.w = pk2(v1[2], v1[3]);
                        *(u32x4*)(zs + (size_t)row * SHW + col) = w;
                        shift_out(row, col, v0, v1); } }
        } else if (sec == 3 || sec == 7) {
            const int cb = (sec == 7 ? 1024 : 0) + lcb;
#pragma unroll
            for (int ai = 0; ai < 2; ++ai)
#pragma unroll
                for (int m = 0; m < 4; ++m) { const int row = rowb + ai * 128 + m * 16;
#pragma unroll
                    for (int bj = 0; bj < 2; ++bj) { const f32x4 v0 = acc[ai][bj][m][0], v1 = acc[ai][bj][m][1];
                        u32x4 w; w.x = pk2(silu_f(v0[0]), silu_f(v0[1])); w.y = pk2(silu_f(v0[2]), silu_f(v0[3])); w.z = pk2(silu_f(v1[0]), silu_f(v1[1])); w.w = pk2(silu_f(v1[2]), silu_f(v1[3]));
                        *(u32x4*)(mixg + (size_t)row * 2048 + cb + bj * 32) = w; } }
        } else if (sec == 6) {
#pragma unroll
            for (int ai = 0; ai < 2; ++ai)
#pragma unroll
                for (int m = 0; m < 4; ++m) { const int row = rowb + ai * 128 + m * 16;
                    float* dst = nullptr; const int t = row & (TSEQ - 1);
                    if (row < MP) { if (t >= 2048) dst = out + O_VP + ((size_t)((row >> 12) * 2048 + (t - 2048))) * 1024; }
                    else if (row < MTOT) dst = out + O_VS + (size_t)(row - MP) * 1024;
#pragma unroll
                    for (int bj = 0; bj < 2; ++bj) { const int col = lcb + bj * 32; const f32x4 v0 = acc[ai][bj][m][0], v1 = acc[ai][bj][m][1];
                        u32x4 w; w.x = pk2(v0[0], v0[1]); w.y = pk2(v0[2], v0[3]); w.z = pk2(v1[0], v1[1]); w.w = pk2(v1[2], v1[3]);
                        *(u32x4*)(va + (size_t)row * 1024 + col) = w;
                        if (dst) { *(f32x4*)(dst + col) = v0; *(f32x4*)(dst + col + 4) = v1; } } }
        } else {
            const bool isq = (sec == 4);
            const float* nwp = isq ? qnw : knw; const float sc = isq ? 0.125f : 1.0f;
            f32x4 nw[2][2];
#pragma unroll
            for (int bj = 0; bj < 2; ++bj) { nw[bj][0] = *(const f32x4*)(nwp + bj * 32 + fq * 8); nw[bj][1] = *(const f32x4*)(nwp + bj * 32 + fq * 8 + 4); }
            bf16_t* ob = isq ? qn : kn;
#pragma unroll
            for (int ai = 0; ai < 2; ++ai)
#pragma unroll
                for (int m = 0; m < 4; ++m) { const int row = rowb + ai * 128 + m * 16;
                    float ss = 0.f;
#pragma unroll
                    for (int bj = 0; bj < 2; ++bj)
#pragma unroll
                        for (int n = 0; n < 2; ++n) { const f32x4 x = acc[ai][bj][m][n]; ss += (x[0] * x[0] + x[1] * x[1]) + (x[2] * x[2] + x[3] * x[3]); }
                    ss += __shfl_xor(ss, 16); ss += __shfl_xor(ss, 32);
                    const float rs = rsqrtf(ss * (1.f / 64.f) + 1e-6f) * sc;
                    float* dst = nullptr; const int t = row & (TSEQ - 1);
                    if (!isq) { if (row < MP) { if (t >= 2048) dst = out + O_KP + ((size_t)((row >> 12) * 2048 + (t - 2048))) * 1024; }
                                else if (row < MTOT) dst = out + O_KS + (size_t)(row - MP) * 1024; }
#pragma unroll
                    for (int bj = 0; bj < 2; ++bj) { const int col = lcb + bj * 32; const f32x4 v0 = acc[ai][bj][m][0] * rs * nw[bj][0], v1 = acc[ai][bj][m][1] * rs * nw[bj][1];
                        u32x4 w; w.x = pk2(v0[0], v0[1]); w.y = pk2(v0[2], v0[3]); w.z = pk2(v1[0], v1[1]); w.w = pk2(v1[2], v1[3]);
                        *(u32x4*)(ob + (size_t)row * 1024 + col) = w;
                        if (dst) { *(f32x4*)(dst + col) = v0; *(f32x4*)(dst + col + 4) = v1; } } }
        }
    }
};
struct EpiOut {
    static constexpr bool PERM = true, AFTER_DRAIN = false;
    const float *xp, *xs; float* out;
    __device__ __forceinline__ void operator()(const f32x4 (&acc)[2][2][4][2], const pg8::Unit& u, int wr, int wc, int fr, int fq) const {
        const int rowb = u.pm * 256 + wr * 64 + fr, colb = u.pn * 256 + wc * 32 + fq * 8;
#pragma unroll
        for (int ai = 0; ai < 2; ++ai)
#pragma unroll
            for (int m = 0; m < 4; ++m) { const int row = rowb + ai * 128 + m * 16;
                const float* xr; float* orow;
                if (row < MP) { xr = xp + (size_t)row * DM; orow = out + O_Y + (size_t)row * DM; }
                else if (row < MTOT) { xr = xs + (size_t)(row - MP) * DM; orow = out + O_YS + (size_t)(row - MP) * DM; }
                else continue;
#pragma unroll
                for (int bj = 0; bj < 2; ++bj) { const int col = colb + bj * 128;
                    *(f32x4*)(orow + col) = acc[ai][bj][m][0] + *(const f32x4*)(xr + col);
                    *(f32x4*)(orow + col + 4) = acc[ai][bj][m][1] + *(const f32x4*)(xr + col + 4); } }
    }
};

__device__ __forceinline__ void p0_transpose_item(const float* W, int Nsrc, int src_n0, int k0, bf16_t* WT, int dst_row0, int Kdst, LAS float* scr, int lane) {
    if (src_n0 < 0) {
        const int c = lane & 7;
#pragma unroll
        for (int j = 0; j < 4; ++j) { const int n = (lane >> 3) + 8 * j; *(u32x4*)(WT + (size_t)(dst_row0 + n) * Kdst + k0 + 8 * c) = (u32x4){0u, 0u, 0u, 0u}; }
        return;
    }
    {
        f32x4 t[8];
#pragma unroll
        for (int i = 0; i < 8; ++i) { const int kk = 8 * i + (lane >> 3); t[i] = *(const f32x4*)(W + (size_t)(k0 + kk) * Nsrc + src_n0 + 4 * (lane & 7)); }
#pragma unroll
        for (int i = 0; i < 8; ++i) { const int kk = 8 * i + (lane >> 3); LAS float* d = scr + kk * 33 + 4 * (lane & 7); d[0] = t[i].x; d[1] = t[i].y; d[2] = t[i].z; d[3] = t[i].w; }
    }
    LDS_WAIT(); asm volatile("" ::: "memory");
    const int c = lane & 7;
#pragma unroll
    for (int j = 0; j < 4; ++j) { const int n = (lane >> 3) + 8 * j; const LAS float* s = scr + (8 * c) * 33 + n;
        u32x4 o; o.x = pk2(s[0 * 33], s[1 * 33]); o.y = pk2(s[2 * 33], s[3 * 33]); o.z = pk2(s[4 * 33], s[5 * 33]); o.w = pk2(s[6 * 33], s[7 * 33]);
        *(u32x4*)(WT + (size_t)(dst_row0 + n) * Kdst + k0 + 8 * c) = o; }
    LDS_WAIT(); asm volatile("" ::: "memory");
}
__device__ __forceinline__ int win_src_col(int n0) {
    const int T = n0 >> 8, p = n0 & 255;
    if (T < 32) { const int s = T >> 2, ts = T & 3, bj = p >> 7, wc = (p & 127) >> 5; const int lc = ts * 256 + wc * 64 + bj * 32;
        return (s < 3 ? s * 1024 : SHW + (s - 3) * 1024) + lc; }
    return p < 192 ? 3072 + p : -1;
}
__device__ __forceinline__ void p0_prologue(const float* xp, const float* xs, const float* nwp, const float* w_in, const float* w_up, const float* a_up, const float* w_out, unsigned char* ws, LAS unsigned char* lds, int G, int bx, int wave, int lane, int tid) {
    LAS float* scr = (LAS float*)(lds + wave * 16384);
    const int gw = bx * NW + wave, NGW = G * NW;
    bf16_t* winT = (bf16_t*)(ws + WS_WIN); bf16_t* woutT = (bf16_t*)(ws + WS_WOUT);
    constexpr int I_IN = 32 * (NPAD / 32), I_OUT = 32 * (DM / 32);
    for (int it = gw; it < I_IN + I_OUT; it += NGW) {
        if (it < I_IN) { const int kb = it / (NPAD / 32), nb = it % (NPAD / 32); p0_transpose_item(w_in, 8384, win_src_col(nb * 32), kb * 64, winT, nb * 32, DM, scr, lane); }
        else { const int r = it - I_IN; const int kb = r / (DM / 32), nb = r % (DM / 32); p0_transpose_item(w_out, DM, nb * 32, kb * 64, woutT, nb * 32, DM, scr, lane); }
    }
    { bf16_t* wupT = (bf16_t*)(ws + WS_WUP); bf16_t* aupT = (bf16_t*)(ws + WS_AUP);
      for (int i = bx * NT + tid; i < 2 * 1024 * 12; i += G * NT) { const int which = i / 12288, r = i % 12288, n = r / 12, c = r % 12;
          const float* W = which ? a_up : w_up; bf16_t* D = which ? aupT : wupT;
          u32x4 o; o.x = pk2(W[(8 * c + 0) * 1024 + n], W[(8 * c + 1) * 1024 + n]); o.y = pk2(W[(8 * c + 2) * 1024 + n], W[(8 * c + 3) * 1024 + n]);
          o.z = pk2(W[(8 * c + 4) * 1024 + n], W[(8 * c + 5) * 1024 + n]); o.w = pk2(W[(8 * c + 6) * 1024 + n], W[(8 * c + 7) * 1024 + n]);
          *(u32x4*)(D + n * 96 + 8 * c) = o; } }
    bf16_t* xn = (bf16_t*)(ws + WS_XN);
    for (int m = gw; m < MPAD; m += NGW) {
        u32x2* o8 = (u32x2*)(xn + (size_t)m * DM) + lane;
        if (m >= MTOT) {
#pragma unroll
            for (int j = 0; j < 8; ++j) o8[64 * j] = (u32x2){0u, 0u};
            continue; }
        const float* xrow = m < MP ? xp + (size_t)m * DM : xs + (size_t)(m - MP) * DM;
        const f32x4* xr = (const f32x4*)xrow + lane;
        f32x4 v[8]; float s = 0.f;
#pragma unroll
        for (int j = 0; j < 8; ++j) { v[j] = xr[64 * j]; s += (v[j].x * v[j].x + v[j].y * v[j].y) + (v[j].z * v[j].z + v[j].w * v[j].w); }
        const float rstd = rsqrtf(wave_sum(s) * (1.f / DM) + 1e-6f);
#pragma unroll
        for (int j = 0; j < 8; ++j) { const f32x4 g = ((const f32x4*)nwp)[lane + 64 * j]; const f32x4 y = v[j] * rstd * g;
            o8[64 * j] = (u32x2){pk2(y.x, y.y), pk2(y.z, y.w)}; }
    }
}
__device__ __forceinline__ size_t e_rec(int m, int h) { return m < MP ? ((size_t)((m >> 12) * 16 + h) * TSEQ + (m & (TSEQ - 1))) : ((size_t)32 * TSEQ + (size_t)(m - MP) * 16 + h); }
struct F8 { f32x4 a, b; };
__device__ __forceinline__ F8 ld_bf8(const bf16_t* p) { const u32x4 w = *(const u32x4*)p; F8 r; r.a = (f32x4){bflo(w.x), bfhi(w.x), bflo(w.y), bfhi(w.y)}; r.b = (f32x4){bflo(w.z), bfhi(w.z), bflo(w.w), bfhi(w.w)}; return r; }
__device__ __forceinline__ F8 ld_prev8(const bf16_t* zs, const float* sst, int m, int col) {
    F8 r;
    if (m >= MP) { const float* p = sst + (m - MP) * SHW + col; r.a = *(const f32x4*)p; r.b = *(const f32x4*)(p + 4); return r; }
    if ((m & (TSEQ - 1)) == 0) { r.a = (f32x4){0.f, 0.f, 0.f, 0.f}; r.b = r.a; return r; }
    return ld_bf8(zs + (size_t)(m - 1) * SHW + col);
}
__device__ __forceinline__ float ld_prev1(const bf16_t* zs, const float* sst, int m, int col) {
    if (m >= MP) return sst[(m - MP) * SHW + col];
    if ((m & (TSEQ - 1)) == 0) return 0.f;
    return bf2f(zs[(size_t)(m - 1) * SHW + col]);
}
__device__ __forceinline__ float tanh_f(float x) { return 1.f - 2.f / (1.f + __expf(2.f * x)); }
__device__ __forceinline__ bf16x8 pack_bf8(f32x4 a, f32x4 b) { u32x4 w; w.x = pk2(a[0], a[1]); w.y = pk2(a[2], a[3]); w.z = pk2(b[0], b[1]); w.w = pk2(b[2], b[3]); return __builtin_bit_cast(bf16x8, w); }

struct F4 { float v[4]; };
__device__ __forceinline__ f32x4 cv_bf4(u32x2 w) { return (f32x4){bflo(w.x), bfhi(w.x), bflo(w.y), bfhi(w.y)}; }
__device__ __forceinline__ f32x4 ld_bf4(const bf16_t* p) { const u32x2 w = *(const u32x2*)p; return (f32x4){bflo(w.x), bfhi(w.x), bflo(w.y), bfhi(w.y)}; }
__device__ __forceinline__ f32x4 ld_prev4(const bf16_t* zs, const float* sst, int m, int col) {
    if (m >= MP) return *(const f32x4*)(sst + (m - MP) * SHW + col);
    if ((m & (TSEQ - 1)) == 0) return (f32x4){0.f, 0.f, 0.f, 0.f};
    return ld_bf4(zs + (size_t)(m - 1) * SHW + col);
}
typedef _Float16 h16x4s __attribute__((ext_vector_type(4)));
__device__ __forceinline__ void st_h4l(LAS unsigned char* p, f32x4 v) { h16x4s h; h[0] = (h16)v[0]; h[1] = (h16)v[1]; h[2] = (h16)v[2]; h[3] = (h16)v[3]; *(LAS h16x4s*)p = h; }
__device__ __forceinline__ void st_h4(unsigned char* p, f32x4 v) { h16x4s h; h[0] = (h16)v[0]; h[1] = (h16)v[1]; h[2] = (h16)v[2]; h[3] = (h16)v[3]; *(h16x4s*)p = h; }
__device__ __forceinline__ int m_of(int tg, int lane) { return 16 * tg + (lane & 15); }
template <bool SAMP> __device__ __forceinline__ F8 prev8(const bf16_t* zs, const float* sst, int m, int col, bool first) {
    if (SAMP) { const float* p = sst + (m - MP) * SHW + col; F8 r; r.a = *(const f32x4*)p; r.b = *(const f32x4*)(p + 4); return r; }
    F8 r = ld_bf8(zs + (size_t)(m - (first ? 0 : 1)) * SHW + col); const float z = first ? 0.f : 1.f; r.a = r.a * z; r.b = r.b * z; return r;
}
template <bool SAMP> __device__ __forceinline__ f32x4 prev4(const bf16_t* zs, const float* sst, int m, int col, bool first) {
    if (SAMP) return *(const f32x4*)(sst + (m - MP) * SHW + col);
    const f32x4 r = ld_bf4(zs + (size_t)(m - (first ? 0 : 1)) * SHW + col); return r * (first ? 0.f : 1.f);
}
template <bool SAMP> __device__ __forceinline__ void prep_unit_t(int tg, const bf16_t* __restrict__ zs, unsigned char* __restrict__ Eb, const bf16_t* wupT, const bf16_t* aupT, const float* sst, const float* mu,
                                          const float* w0, const float* a0, const float* k_k, const float* k_a, int wave, int lane, LAS unsigned char* stg, bool do_store = true) {
    const int q = lane & 15, g = lane >> 4;
    constexpr bool samp = SAMP;
    const bool first = !SAMP && ((m_of(tg, lane) & (TSEQ - 1)) == 0);
    const int m = samp ? MP + (q < 8 ? q : 7) : 16 * tg + q;
    const bool wr_ok = !(samp && q >= 8) && do_store;
    bf16x8 Bw[3], Ba[3];
#pragma unroll
    for (int ks = 0; ks < 3; ++ks) {
        { const int col = 3072 + 32 * ks + 8 * g; const F8 c = ld_bf8(zs + (size_t)m * SHW + col), p = prev8<SAMP>(zs, sst, m, col, first);
          const f32x4 m0 = *(const f32x4*)(mu + col), m1 = *(const f32x4*)(mu + col + 4);
          f32x4 xa = c.a + m0 * (p.a - c.a), xb = c.b + m1 * (p.b - c.b);
#pragma unroll
          for (int i = 0; i < 4; ++i) { xa[i] = tanh_f(xa[i]); xb[i] = tanh_f(xb[i]); }
          Bw[ks] = pack_bf8(xa, xb); }
        { const int col = 3168 + 32 * ks + 8 * g; const F8 c = ld_bf8(zs + (size_t)m * SHW + col), p = prev8<SAMP>(zs, sst, m, col, first);
          const f32x4 m0 = *(const f32x4*)(mu + col), m1 = *(const f32x4*)(mu + col + 4);
          const f32x4 xa = c.a + m0 * (p.a - c.a), xb = c.b + m1 * (p.b - c.b);
          Ba[ks] = pack_bf8(xa, xb); }
    }
#pragma unroll 1
    for (int hh = 0; hh < (SAMP ? 1 : 2); ++hh) {
        const int h = SAMP ? wave : 2 * wave + hh;
        unsigned char* erec = Eb + e_rec(m, h) * ESTRIDE;
        f32x4 kkr[4], av[4]; float ss = 0.f;
        u32x2 zrc[4], zkc[4], zvc[4], zrp[4], zkp[4], zvp[4];
        const size_t prow = (size_t)(SAMP ? m : m - (first ? 0 : 1)) * SHW;
#pragma unroll
        for (int j = 0; j < 4; ++j) { const int ch = h * 64 + 16 * j + 4 * g;
            zrc[j] = *(const u32x2*)(zs + (size_t)m * SHW + ch); zkc[j] = *(const u32x2*)(zs + (size_t)m * SHW + 1024 + ch); zvc[j] = *(const u32x2*)(zs + (size_t)m * SHW + 2048 + ch);
            zrp[j] = *(const u32x2*)(zs + prow + ch); zkp[j] = *(const u32x2*)(zs + prow + 1024 + ch); zvp[j] = *(const u32x2*)(zs + prow + 2048 + ch); }
#pragma unroll
        for (int j = 0; j < 4; ++j) {
            const int chA = h * 64 + 16 * j + q;
            const int ch = h * 64 + 16 * j + 4 * g;
            f32x4 cw = (f32x4){0.f, 0.f, 0.f, 0.f}, ca = cw;
#pragma unroll
            for (int ks = 0; ks < 3; ++ks) {
                const bf16x8 aw = *(const bf16x8*)(wupT + chA * 96 + 32 * ks + 8 * g), aa = *(const bf16x8*)(aupT + chA * 96 + 32 * ks + 8 * g);
                cw = __builtin_amdgcn_mfma_f32_16x16x32_bf16(aw, Bw[ks], cw, 0, 0, 0);
                ca = __builtin_amdgcn_mfma_f32_16x16x32_bf16(aa, Ba[ks], ca, 0, 0, 0);
            }
            const f32x4 w0c = *(const f32x4*)(w0 + ch), a0c = *(const f32x4*)(a0 + ch), kkc = *(const f32x4*)(k_k + ch), kac = *(const f32x4*)(k_a + ch);
            const f32x4 mur = *(const f32x4*)(mu + ch), muk = *(const f32x4*)(mu + 1024 + ch), muv = *(const f32x4*)(mu + 2048 + ch);
            const f32x4 rc = cv_bf4(zrc[j]), kc = cv_bf4(zkc[j]), vc = cv_bf4(zvc[j]);
            f32x4 rp, kp, vp;
            if (SAMP) { rp = *(const f32x4*)(sst + (m - MP) * SHW + ch); kp = *(const f32x4*)(sst + (m - MP) * SHW + 1024 + ch); vp = *(const f32x4*)(sst + (m - MP) * SHW + 2048 + ch); }
            else { const float z = first ? 0.f : 1.f; rp = cv_bf4(zrp[j]) * z; kp = cv_bf4(zkp[j]) * z; vp = cv_bf4(zvp[j]) * z; }
            const f32x4 rv = rc + mur * (rp - rc), vv = vc + muv * (vp - vc), km = kc + muk * (kp - kc);
            f32x4 a, u;
#pragma unroll
            for (int c = 0; c < 4; ++c) { a[c] = sigmoid_f(a0c[c] + ca[c]); u[c] = expm1f(-0.60653065971f * sigmoid_f(w0c[c] + cw[c])); }
            const f32x4 kr = km * kkc; kkr[j] = kr; av[j] = a; ss += (kr[0] * kr[0] + kr[1] * kr[1]) + (kr[2] * kr[2] + kr[3] * kr[3]);
            if (SAMP) { if (wr_ok) { unsigned char* e = erec + (16 * j + 4 * g) * 2;
                st_h4(e, u); st_h4(e + 128, km * (1.f + (a - 1.f) * kac)); st_h4(e + 512, rv); st_h4(e + 640, vv); } }
            else { LAS unsigned char* e = stg + q * 784 + (16 * j + 4 * g) * 2;
                st_h4l(e, u); st_h4l(e + 128, km * (1.f + (a - 1.f) * kac)); st_h4l(e + 512, rv); st_h4l(e + 640, vv); }
        }
        ss += __shfl_xor(ss, 16); ss += __shfl_xor(ss, 32);
        const float inv = 1.f / fmaxf(sqrtf(ss), 1e-12f);
        if (SAMP) { if (wr_ok) {
#pragma unroll
            for (int j = 0; j < 4; ++j) { unsigned char* e = erec + (16 * j + 4 * g) * 2; const f32x4 kk = kkr[j] * inv;
                st_h4(e + 256, -kk); st_h4(e + 384, kk * av[j]); } } }
        else {
#pragma unroll
            for (int j = 0; j < 4; ++j) { LAS unsigned char* e = stg + q * 784 + (16 * j + 4 * g) * 2; const f32x4 kk = kkr[j] * inv;
                st_h4l(e + 256, -kk); st_h4l(e + 384, kk * av[j]); }
            LDS_WAIT(); asm volatile("" ::: "memory");
            unsigned char* gb = Eb + e_rec(16 * tg, h) * ESTRIDE;
            if (do_store) {
#pragma unroll
                for (int it = 0; it < 12; ++it) { const int x = it * 64 + lane; const u32x4 w = *(const LAS u32x4*)(stg + (x / 48) * 784 + (x % 48) * 16); *(u32x4*)(gb + (size_t)x * 16) = w; }
            }
            LDS_WAIT(); asm volatile("" ::: "memory");
        }
    }
}

__device__ __forceinline__ void prep_unit(int tg, const bf16_t* zs, unsigned char* Eb, const bf16_t* wupT, const bf16_t* aupT, const float* sst, const float* mu,
                                          const float* w0, const float* a0, const float* k_k, const float* k_a, int wave, int lane, LAS unsigned char* lds, bool do_store = true) {
    LAS unsigned char* stg = lds + wave * (16 * 784);
    if (tg >= 512) prep_unit_t<true>(tg, zs, Eb, wupT, aupT, sst, mu, w0, a0, k_k, k_a, wave  , lane, stg, do_store);
    else prep_unit_t<false>(tg, zs, Eb, wupT, aupT, sst, mu, w0, a0, k_k, k_a, wave, lane, stg, do_store);
}

__device__ __forceinline__ s16x4 tr_read(LAS unsigned char* p) { return __builtin_bit_cast(s16x4, __builtin_amdgcn_ds_read_tr16_b64_v4i16((LAS s16x4*)p)); }
constexpr int ACC_PITCH = 68;
__device__ __forceinline__ void attn_pair_shared(int p, int wave, int mb, int tb, int h, float slope, const bf16_t* qn, const bf16_t* kn, const bf16_t* va,
                                                 LAS float* accL, LAS float* mL, LAS float* lL, LAS unsigned char* vst, int lane) {
    const int q = lane & 15, g = lane >> 4;
    const int d = p == 0 ? 1 : 4;
    const float sd = slope * (float)d;
    const int base = p == 0 ? 32 * wave : (wave & 3) + 128 * (wave >> 2);
    const int tok0 = tb + base;
    bf16x8 qa[2], qb[2]; float m_run[2], l_run[2]; f32x4 O[2][4];
#pragma unroll
    for (int j = 0; j < 2; ++j) {
        const bf16_t* qp = qn + (size_t)(mb + tok0 + (16 * j + q) * d) * 1024 + h * 64 + 8 * g;
        qa[j] = *(const bf16x8*)qp; qb[j] = *(const bf16x8*)(qp + 32);
        m_run[j] = -INFINITY; l_run[j] = 0.f;
#pragma unroll
        for (int i = 0; i < 4; ++i) O[j][i] = (f32x4){0.f, 0.f, 0.f, 0.f};
    }
#define AP_LOADKV(KS, KA, KB, V0, V1) do { int _kt = tok0 + (16 * (KS) + q - 128) * d; _kt = _kt < 0 ? 0 : _kt; const bf16_t* _kp = kn + (size_t)(mb + _kt) * 1024 + h * 64 + 8 * g; \
        KA = *(const bf16x8*)_kp; KB = *(const bf16x8*)(_kp + 32); int _vt = tok0 + (16 * (KS) + (lane >> 2) - 128) * d; _vt = _vt < 0 ? 0 : _vt; \
        const bf16_t* _vp = va + (size_t)(mb + _vt) * 1024 + h * 64 + 16 * (lane & 3); V0 = *(const u32x4*)_vp; V1 = *(const u32x4*)(_vp + 8); } while (0)
    bf16x8 nka, nkb; u32x4 nv0, nv1;
    AP_LOADKV(0, nka, nkb, nv0, nv1);
#pragma unroll 1
    for (int ks = 0; ks < 10; ++ks) {
        const bf16x8 ka = nka, kb = nkb; const u32x4 v0 = nv0, v1 = nv1;
        { const int kn1 = ks < 9 ? ks + 1 : 9; AP_LOADKV(kn1, nka, nkb, nv0, nv1); }
        asm volatile("" ::: "memory");
        *(LAS u32x4*)(vst + (lane >> 2) * 144 + (lane & 3) * 32) = v0; *(LAS u32x4*)(vst + (lane >> 2) * 144 + (lane & 3) * 32 + 16) = v1;
        s16x4 pb[2];
#pragma unroll
        for (int j = 0; j < 2; ++j) {
            f32x4 S = (f32x4){0.f, 0.f, 0.f, 0.f};
            S = __builtin_amdgcn_mfma_f32_16x16x32_bf16(ka, qa[j], S, 0, 0, 0);
            S = __builtin_amdgcn_mfma_f32_16x16x32_bf16(kb, qb[j], S, 0, 0, 0);
            float s[4]; float mx = -INFINITY;
#pragma unroll
            for (int c = 0; c < 4; ++c) { const int ki = 16 * ks + 4 * g + c; const int off = 16 * j + q + 128 - ki; const int ktok = tok0 + (ki - 128) * d;
                const bool valid = (off >= 0) && (off <= 128) && (ktok >= 0);
                s[c] = valid ? S[c] - sd * (float)off : -INFINITY; mx = fmaxf(mx, s[c]); }
            mx = fmaxf(mx, __shfl_xor(mx, 16)); mx = fmaxf(mx, __shfl_xor(mx, 32));
            const float m_new = fmaxf(m_run[j], mx);
            float sc = 1.f, pe[4] = {0.f, 0.f, 0.f, 0.f};
            if (m_new > -INFINITY) { sc = __expf(m_run[j] - m_new);
#pragma unroll
                for (int c = 0; c < 4; ++c) pe[c] = __expf(s[c] - m_new); }
            l_run[j] = l_run[j] * sc + ((pe[0] + pe[1]) + (pe[2] + pe[3])); m_run[j] = m_new;
#pragma unroll
            for (int i = 0; i < 4; ++i) O[j][i] = O[j][i] * sc;
            u32x2 pw; pw.x = pk2(pe[0], pe[1]); pw.y = pk2(pe[2], pe[3]);
            pb[j] = __builtin_bit_cast(s16x4, pw);
        }
        LDS_WAIT(); asm volatile("" ::: "memory");
#pragma unroll
        for (int blk = 0; blk < 4; ++blk) {
            const s16x4 vtr = tr_read(vst + (4 * g + ((lane & 15) >> 2)) * 144 + (16 * blk + 4 * (lane & 3)) * 2);
            O[0][blk] = __builtin_amdgcn_mfma_f32_16x16x16bf16_1k(vtr, pb[0], O[0][blk], 0, 0, 0);
            O[1][blk] = __builtin_amdgcn_mfma_f32_16x16x16bf16_1k(vtr, pb[1], O[1][blk], 0, 0, 0);
        }
        LDS_WAIT(); asm volatile("" ::: "memory");
    }
#undef AP_LOADKV
#pragma unroll
    for (int j = 0; j < 2; ++j) {
        float lr = l_run[j]; lr += __shfl_xor(lr, 16); lr += __shfl_xor(lr, 32);
        const int ti = base + (16 * j + q) * d;
        LAS float* ar = accL + ti * ACC_PITCH + 4 * g;
        if (p == 0) {
#pragma unroll
            for (int blk = 0; blk < 4; ++blk) *(LAS f32x4*)(ar + 16 * blk) = O[j][blk];
            if (g == 0) { mL[ti] = m_run[j]; lL[ti] = lr; }
        } else {
            const float mo = mL[ti], lo = lL[ti];
            const float mn = fmaxf(mo, m_run[j]), ao = __expf(mo - mn), an = __expf(m_run[j] - mn);
#pragma unroll
            for (int blk = 0; blk < 4; ++blk) { const f32x4 old = *(LAS f32x4*)(ar + 16 * blk); *(LAS f32x4*)(ar + 16 * blk) = old * ao + O[j][blk] * an; }
            LDS_WAIT(); asm volatile("" ::: "memory");
            if (g == 0) { mL[ti] = mn; lL[ti] = lo * ao + lr * an; }
        }
    }
}
__device__ __forceinline__ void attn_unit(int unit, const bf16_t* qn, const bf16_t* kn, const bf16_t* va, const bf16_t* mixg, bf16_t* mixo, LAS unsigned char* lds, int wave, int lane, int tid) {
    const int b = unit >> 8, h = (unit >> 4) & 15, sp = unit & 15;
    const int mb = b * TSEQ, tb = sp * 256;
    LAS float* accL = (LAS float*)lds; LAS float* mL = (LAS float*)(lds + 256 * ACC_PITCH * 4); LAS float* lL = mL + 256;
    LAS unsigned char* vst = lds + 256 * ACC_PITCH * 4 + 2048 + wave * 2304;
    const int q = lane & 15, g = lane >> 4;
    const float slope = exp2f(-0.5f * (float)(h + 1));
#pragma unroll 1
    for (int p = 0; p < 3; ++p) {
        const int d = p == 0 ? 1 : (p == 1 ? 4 : 16);
        const float sd = slope * (float)d;
        if (p < 2) { attn_pair_shared(p, wave, mb, tb, h, slope, qn, kn, va, accL, mL, lL, vst, lane); __syncthreads(); continue; }
#pragma unroll 1
        for (int tt = 0; tt < 2; ++tt) {
            const int tile = 2 * wave + tt;
            const int base = p == 0 ? 16 * tile : (p == 1 ? 64 * (tile >> 2) + (tile & 3) : tile);
            const int tok0 = tb + base;
            const bf16_t* qp = qn + (size_t)(mb + tok0 + q * d) * 1024 + h * 64 + 8 * g;
            const bf16x8 qa = *(const bf16x8*)qp, qb = *(const bf16x8*)(qp + 32);
            float m_run = -INFINITY, l_run = 0.f;
            f32x4 O[4];
#pragma unroll
            for (int i = 0; i < 4; ++i) O[i] = (f32x4){0.f, 0.f, 0.f, 0.f};
#define AT_LOADKV(KS, KA, KB, V0, V1) do { int _kt = tok0 + (16 * (KS) + q - 128) * d; _kt = _kt < 0 ? 0 : _kt; const bf16_t* _kp = kn + (size_t)(mb + _kt) * 1024 + h * 64 + 8 * g; \
                KA = *(const bf16x8*)_kp; KB = *(const bf16x8*)(_kp + 32); int _vt = tok0 + (16 * (KS) + (lane >> 2) - 128) * d; _vt = _vt < 0 ? 0 : _vt; \
                const bf16_t* _vp = va + (size_t)(mb + _vt) * 1024 + h * 64 + 16 * (lane & 3); V0 = *(const u32x4*)_vp; V1 = *(const u32x4*)(_vp + 8); } while (0)
            bf16x8 nka, nkb; u32x4 nv0, nv1;
            AT_LOADKV(0, nka, nkb, nv0, nv1);
#pragma unroll 1
            for (int ks = 0; ks < 9; ++ks) {
                const bf16x8 ka = nka, kb = nkb; const u32x4 v0 = nv0, v1 = nv1;
                { const int kn1 = ks < 8 ? ks + 1 : 8; AT_LOADKV(kn1, nka, nkb, nv0, nv1); }
                asm volatile("" ::: "memory");
                *(LAS u32x4*)(vst + (lane >> 2) * 144 + (lane & 3) * 32) = v0; *(LAS u32x4*)(vst + (lane >> 2) * 144 + (lane & 3) * 32 + 16) = v1;
                f32x4 S = (f32x4){0.f, 0.f, 0.f, 0.f};
                S = __builtin_amdgcn_mfma_f32_16x16x32_bf16(ka, qa, S, 0, 0, 0);
                S = __builtin_amdgcn_mfma_f32_16x16x32_bf16(kb, qb, S, 0, 0, 0);
                float s[4]; float mx = -INFINITY;
                if (ks >= 1 && ks <= 7 && tok0 >= 128 * d) {
#pragma unroll
                    for (int c = 0; c < 4; ++c) { const int off = q + 128 - (16 * ks + 4 * g + c); s[c] = S[c] - sd * (float)off; mx = fmaxf(mx, s[c]); }
                } else {
#pragma unroll
                for (int c = 0; c < 4; ++c) { const int ki = 16 * ks + 4 * g + c; const int off = q + 128 - ki; const int ktok = tok0 + (ki - 128) * d;
                    const bool valid = (off >= 0) && (off <= 128) && (ktok >= 0);
                    s[c] = valid ? S[c] - sd * (float)off : -INFINITY; mx = fmaxf(mx, s[c]); }
                }
                mx = fmaxf(mx, __shfl_xor(mx, 16)); mx = fmaxf(mx, __shfl_xor(mx, 32));
                const float m_new = fmaxf(m_run, mx);
                float sc = 1.f, pe[4] = {0.f, 0.f, 0.f, 0.f};
                if (m_new > -INFINITY) { sc = __expf(m_run - m_new);
#pragma unroll
                    for (int c = 0; c < 4; ++c) pe[c] = __expf(s[c] - m_new); }
                l_run = l_run * sc + ((pe[0] + pe[1]) + (pe[2] + pe[3])); m_run = m_new;
#pragma unroll
                for (int i = 0; i < 4; ++i) O[i] = O[i] * sc;
                u32x2 pw; pw.x = pk2(pe[0], pe[1]); pw.y = pk2(pe[2], pe[3]);
                const s16x4 pb = __builtin_bit_cast(s16x4, pw);
                LDS_WAIT(); asm volatile("" ::: "memory");
#pragma unroll
                for (int blk = 0; blk < 4; ++blk) {
                    const s16x4 vtr = tr_read(vst + (4 * g + ((lane & 15) >> 2)) * 144 + (16 * blk + 4 * (lane & 3)) * 2);
                    O[blk] = __builtin_amdgcn_mfma_f32_16x16x16bf16_1k(vtr, pb, O[blk], 0, 0, 0);
                }
                LDS_WAIT(); asm volatile("" ::: "memory");
            }
            l_run += __shfl_xor(l_run, 16); l_run += __shfl_xor(l_run, 32);
            const int ti = base + q * d;
            LAS float* ar = accL + ti * ACC_PITCH + 4 * g;
            if (p == 0) {
#pragma unroll
                for (int blk = 0; blk < 4; ++blk) *(LAS f32x4*)(ar + 16 * blk) = O[blk];
                if (g == 0) { mL[ti] = m_run; lL[ti] = l_run; }
            } else {
                const float mo = mL[ti], lo = lL[ti];
                const float mn = fmaxf(mo, m_run), ao = __expf(mo - mn), an = __expf(m_run - mn);
#pragma unroll
                for (int blk = 0; blk < 4; ++blk) { const f32x4 old = *(LAS f32x4*)(ar + 16 * blk); *(LAS f32x4*)(ar + 16 * blk) = old * ao + O[blk] * an; }
                LDS_WAIT(); asm volatile("" ::: "memory");
                if (g == 0) { mL[ti] = mn; lL[ti] = lo * ao + l_run * an; }
            }
        }
        __syncthreads();
    }
    {
        const int ti = tid >> 1, hf = tid & 1;
        const float inv = 1.f / lL[ti];
        const size_t go = (size_t)(mb + tb + ti) * 2048 + 1024 + h * 64 + 32 * hf; const bf16_t* gp = mixg + go; bf16_t* op = mixo + go;
        const LAS float* ar = accL + ti * ACC_PITCH + 32 * hf;
#pragma unroll
        for (int c8 = 0; c8 < 4; ++c8) { const F8 gt = ld_bf8(gp + 8 * c8); const f32x4 o0 = *(const LAS f32x4*)(ar + 8 * c8) * inv * gt.a, o1 = *(const LAS f32x4*)(ar + 8 * c8 + 4) * inv * gt.b;
            u32x4 w; w.x = pk2(o0[0], o0[1]); w.y = pk2(o0[2], o0[3]); w.z = pk2(o1[0], o1[1]); w.w = pk2(o1[2], o1[3]);
            *(u32x4*)(op + 8 * c8) = w; }
    }
    __syncthreads();
}

constexpr int SA_KC = 26, SA_NKC = 5, SA_NPART = 15, SA_TASKS = 128 * SA_NPART, SA_PSTRIDE = 66;
__device__ __forceinline__ void attn_sample_part(int task, const bf16_t* qn, const bf16_t* kn, const bf16_t* va, const float* ck, const float* cv, float* part, int lane) {
    const int sbh = task / SA_NPART, pk = task % SA_NPART, p = pk / SA_NKC, kc = pk % SA_NKC;
    const int sb = sbh >> 4, h = sbh & 15, m = MP + sb; const int d = p == 0 ? 1 : (p == 1 ? 4 : 16);
    const float ql = bf2f(qn[(size_t)m * 1024 + h * 64 + lane]);
    const float slope = exp2f(-0.5f * (float)(h + 1));
    float kv[SA_KC];
#pragma unroll
    for (int jj = 0; jj < SA_KC; ++jj) { const int j = SA_KC * kc + jj; const int jc = j > 128 ? 128 : j;
        kv[jj] = (jc == 0) ? bf2f(kn[(size_t)m * 1024 + h * 64 + lane]) : ck[(((size_t)sb * 2048 + (2048 - jc * d)) * 16 + h) * 64 + lane]; }
    float sc[SA_KC]; float mx = -INFINITY;
#pragma unroll
    for (int jj = 0; jj < SA_KC; ++jj) { const int j = SA_KC * kc + jj; const float dot = wave_sum(ql * kv[jj]);
        sc[jj] = (j <= 128) ? dot - slope * (float)(j * d) : -INFINITY; mx = fmaxf(mx, sc[jj]); }
#pragma unroll
    for (int jj = 0; jj < SA_KC; ++jj) { const int j = SA_KC * kc + jj; const int jc = j > 128 ? 128 : j;
        kv[jj] = (jc == 0) ? bf2f(va[(size_t)m * 1024 + h * 64 + lane]) : cv[(((size_t)sb * 2048 + (2048 - jc * d)) * 16 + h) * 64 + lane]; }
    float o = 0.f, l = 0.f;
#pragma unroll
    for (int jj = 0; jj < SA_KC; ++jj) { const float pe = __expf(sc[jj] - mx); l += pe; o = fmaf(pe, kv[jj], o); }
    float* pp = part + (size_t)task * SA_PSTRIDE;
    pp[lane] = o; if (lane == 0) { pp[64] = mx; pp[65] = l; }
}
__device__ __forceinline__ void attn_sample_combine(int sbh, const float* part, bf16_t* mixg, int lane) {
    const float* pp = part + (size_t)sbh * SA_NPART * SA_PSTRIDE;
    float M = -INFINITY;
#pragma unroll
    for (int i = 0; i < SA_NPART; ++i) M = fmaxf(M, pp[i * SA_PSTRIDE + 64]);
    float o = 0.f, l = 0.f;
#pragma unroll
    for (int i = 0; i < SA_NPART; ++i) { const float w = __expf(pp[i * SA_PSTRIDE + 64] - M); o = fmaf(w, pp[i * SA_PSTRIDE + lane], o); l = fmaf(w, pp[i * SA_PSTRIDE + 65], l); }
    const size_t go = (size_t)(MP + (sbh >> 4)) * 2048 + 1024 + (sbh & 15) * 64 + lane;
    mixg[go] = (bf16_t)f2bf(o / l * bf2f(mixg[go]));
}

template <int CTRL> __device__ __forceinline__ float dpp_mov(float v) { return __builtin_bit_cast(float, __builtin_amdgcn_update_dpp(0, __builtin_bit_cast(int, v), CTRL, 0xF, 0xF, true)); }
__device__ __forceinline__ float red16(float v) { v += dpp_mov<0xB1>(v); v += dpp_mov<0x4E>(v); v += dpp_mov<0x141>(v); v += dpp_mov<0x140>(v); return v; }
struct StepIn { h16x4 w, k, a, b, r; h16 v; };
__device__ __forceinline__ float do_step(float (&S)[4], const StepIn& in) {
    float sa = 0.f;
#pragma unroll
    for (int c = 0; c < 4; ++c) sa = fmaf(S[c], (float)in.a[c], sa);
    sa = red16(sa);
    const float v = (float)in.v; float y = 0.f;
#pragma unroll
    for (int c = 0; c < 4; ++c) { float t = fmaf(v, (float)in.k[c], S[c]); asm("" : "+v"(t)); t = fmaf(sa, (float)in.b[c], t); asm("" : "+v"(t));
        S[c] = fmaf((float)in.w[c], S[c], t); asm("" : "+v"(S[c])); y = fmaf(S[c], (float)in.r[c], y); }
    return red16(y);
}
#define FMIX_DECL(NAME, MODS, ZERO) \
__device__ __forceinline__ float NAME(float a, unsigned h, float c) { float d; asm("v_fma_mix_f32 %0, %1, %2, " ZERO " " MODS : "=v"(d) : "v"(a), "v"(h), "v"(c)); return d; }
FMIX_DECL(mix_lo, "op_sel_hi:[0,1,0]", "%3")
FMIX_DECL(mix_hi, "op_sel:[0,1,0] op_sel_hi:[0,1,0]", "%3")
__device__ __forceinline__ float mix0_lo(float a, unsigned h) { float d; asm("v_fma_mix_f32 %0, %1, %2, 0 op_sel_hi:[0,1,0]" : "=v"(d) : "v"(a), "v"(h)); return d; }
__device__ __forceinline__ float mix0_hi(float a, unsigned h) { float d; asm("v_fma_mix_f32 %0, %1, %2, 0 op_sel:[0,1,0] op_sel_hi:[0,1,0]" : "=v"(d) : "v"(a), "v"(h)); return d; }
__device__ __forceinline__ float mixh_lo(unsigned vh, unsigned h, float c) { float d; asm("v_fma_mix_f32 %0, %1, %2, %3 op_sel_hi:[1,1,0]" : "=v"(d) : "v"(vh), "v"(h), "v"(c)); return d; }
__device__ __forceinline__ float mixh_hi(unsigned vh, unsigned h, float c) { float d; asm("v_fma_mix_f32 %0, %1, %2, %3 op_sel:[0,1,0] op_sel_hi:[1,1,0]" : "=v"(d) : "v"(vh), "v"(h), "v"(c)); return d; }
struct StepRaw { u32x2 w, k, a, b, r; unsigned v; };
__device__ __forceinline__ float do_step2(float (&S)[4], const StepRaw& in, float& yprev) {
    float pre[4];
    pre[0] = mix_lo(S[0], in.w.x, mixh_lo(in.v, in.k.x, S[0])); pre[1] = mix_hi(S[1], in.w.x, mixh_hi(in.v, in.k.x, S[1]));
    pre[2] = mix_lo(S[2], in.w.y, mixh_lo(in.v, in.k.y, S[2])); pre[3] = mix_hi(S[3], in.w.y, mixh_hi(in.v, in.k.y, S[3]));
    const float s01 = mix_hi(S[1], in.a.x, mix0_lo(S[0], in.a.x)), s23 = mix_hi(S[3], in.a.y, mix0_lo(S[2], in.a.y));
    float sa = s01 + s23, yp = yprev;
    sa += dpp_mov<0xB1>(sa); yp += dpp_mov<0xB1>(yp);
    sa += dpp_mov<0x4E>(sa); yp += dpp_mov<0x4E>(yp);
    sa += dpp_mov<0x141>(sa); yp += dpp_mov<0x141>(yp);
    sa += dpp_mov<0x140>(sa); yp += dpp_mov<0x140>(yp);
    yprev = yp;
    S[0] = mix_lo(sa, in.b.x, pre[0]); S[1] = mix_hi(sa, in.b.x, pre[1]); S[2] = mix_lo(sa, in.b.y, pre[2]); S[3] = mix_hi(sa, in.b.y, pre[3]);
    const float y01 = mix_hi(S[1], in.r.x, mix0_lo(S[0], in.r.x)), y23 = mix_hi(S[3], in.r.y, mix0_lo(S[2], in.r.y));
    return y01 + y23;
}
__device__ __forceinline__ void scan_one(const unsigned char* rec, int rq, const float* S0, float* Sout, float* yp, int lane) {
    const int rr = lane >> 4, jq = lane & 15, i = 4 * rq + rr;
    float S[4]; { const f32x4 s = *(const f32x4*)(S0 + i * 64 + 4 * jq); S[0] = s.x; S[1] = s.y; S[2] = s.z; S[3] = s.w; }
    StepIn in; in.w = *(const h16x4*)(rec + jq * 8); in.k = *(const h16x4*)(rec + 128 + jq * 8); in.a = *(const h16x4*)(rec + 256 + jq * 8); in.b = *(const h16x4*)(rec + 384 + jq * 8);
    in.r = *(const h16x4*)(rec + 512 + jq * 8); in.v = *(const h16*)(rec + 640 + i * 2);
    const float y = do_step(S, in); if (jq == 0) yp[i] = y;
    *(f32x4*)(Sout + i * 64 + 4 * jq) = (f32x4){S[0], S[1], S[2], S[3]};
}
constexpr int SC_CH = 64, SC_CHB = SC_CH * ESTRIDE, SC_NCH = TSEQ / SC_CH;
__device__ __forceinline__ void scan_pair(int pair, const unsigned char* Eb, float* out, float* yraw, LAS unsigned char* lds, int wave, int lane) {
    const int bh = pair >> 3, rq = ((pair & 7) << 1) + (wave & 1);
    const unsigned char* base = Eb + (size_t)bh * TSEQ * ESTRIDE;
    const int rr = lane >> 4, jq = lane & 15, i = 4 * rq + rr;
    float S[4] = {0.f, 0.f, 0.f, 0.f};
    float* yp = yraw + (size_t)((bh >> 4) * TSEQ) * 1024 + (bh & 15) * 64 + i;
    float ypart = 0.f, ycap = 0.f; float* dummy = yraw + (size_t)(MPAD - 1) * 1024 + (bh & 15) * 64 + i;
#define SC_ISSUE(kc) do { const int _kc = (kc) < SC_NCH ? (kc) : SC_NCH - 1; const unsigned char* _g = base + (size_t)_kc * SC_CHB; LAS unsigned char* _l = lds + ((kc) & 1) * SC_CHB; \
        _Pragma("unroll") for (int _p = 0; _p < 8; ++_p) { const int _x = (8 * (wave - 2) + _p) * 64; \
            __builtin_amdgcn_global_load_lds((const unsigned*)(_g + (size_t)(_x + lane) * 16), (LAS unsigned*)(_l + _x * 16), 16, 0, 0); } } while (0)
    if (wave >= 2) { SC_ISSUE(0); asm volatile("s_waitcnt vmcnt(0)" ::: "memory"); }
    __builtin_amdgcn_s_barrier(); asm volatile("" ::: "memory");
#pragma unroll 1
    for (int k = 0; k < SC_NCH; ++k) {
        if (wave >= 2) { SC_ISSUE(k + 1); asm volatile("s_waitcnt vmcnt(0)" ::: "memory"); }
        else {
            const LAS unsigned char* bp = lds + (k & 1) * SC_CHB;
#pragma unroll 8
            for (int s = 0; s < SC_CH; ++s) {
                const LAS unsigned char* p = bp + s * ESTRIDE;
                StepRaw in; in.w = *(const LAS u32x2*)(p + jq * 8); in.k = *(const LAS u32x2*)(p + 128 + jq * 8); in.a = *(const LAS u32x2*)(p + 256 + jq * 8); in.b = *(const LAS u32x2*)(p + 384 + jq * 8);
                in.r = *(const LAS u32x2*)(p + 512 + jq * 8); in.v = *(const LAS unsigned short*)(p + 640 + i * 2);
                float yr = ypart; ypart = do_step2(S, in, yr);
                { const int tp = k * SC_CH + s - 1;
                  ycap = ((jq & 3) == (tp & 3)) ? yr : ycap;
                  if (((s - 1) & 3) == 3) { float* dst = tp < 0 ? dummy : yp + (size_t)(tp - 3 + (jq & 3)) * 1024; *dst = ycap; } }
            }
        }
        asm volatile("" ::: "memory"); __builtin_amdgcn_s_barrier(); asm volatile("" ::: "memory");
    }
    if (wave >= 2) asm volatile("s_waitcnt vmcnt(0)" ::: "memory");
    if (wave < 2) { const float yl = red16(ypart); ycap = ((jq & 3) == 3) ? yl : ycap; yp[(size_t)(TSEQ - 4 + (jq & 3)) * 1024] = ycap; *(f32x4*)(out + O_WKVP + (size_t)bh * 4096 + i * 64 + 4 * jq) = (f32x4){S[0], S[1], S[2], S[3]}; }
    __builtin_amdgcn_s_barrier(); asm volatile("" ::: "memory");
#undef SC_ISSUE
}

template <int CTRL> __device__ __forceinline__ float dpp_mov(float v);
__device__ __forceinline__ float quad_sum(float v) { v += dpp_mov<0xB1>(v); v += dpp_mov<0x4E>(v); return v; }
__device__ __forceinline__ void fin_token(int m, const float* yraw, const unsigned char* Eb, bf16_t* mixg, const float* gn_w, const float* gn_b, const float* r_k, int lane) {
    const int h = lane >> 2, qt = lane & 3, ch0 = lane * 16;
    f32x4 y[4];
#pragma unroll
    for (int i = 0; i < 4; ++i) y[i] = *(const f32x4*)(yraw + (size_t)m * 1024 + ch0 + 4 * i);
    const unsigned char* e = Eb + e_rec(m, h) * ESTRIDE + qt * 32;
    const u32x4 rr0 = *(const u32x4*)(e + 512), rr1 = *(const u32x4*)(e + 528), kk0 = *(const u32x4*)(e + 128), kk1 = *(const u32x4*)(e + 144), vv0 = *(const u32x4*)(e + 640), vv1 = *(const u32x4*)(e + 656);
    bf16_t* gp = mixg + (size_t)m * 2048 + ch0;
    const F8 g0 = ld_bf8(gp), g1 = ld_bf8(gp + 8);
    float s = 0.f;
#pragma unroll
    for (int i = 0; i < 4; ++i) s += (y[i].x + y[i].y) + (y[i].z + y[i].w);
    const float mean = quad_sum(s) * (1.f / 64.f);
    float q = 0.f;
#pragma unroll
    for (int i = 0; i < 4; ++i) { y[i] = y[i] - mean; q += (y[i].x * y[i].x + y[i].y * y[i].y) + (y[i].z * y[i].z + y[i].w * y[i].w); }
    const float rstd = rsqrtf(quad_sum(q) * (1.f / 64.f) + 64e-5f);
    typedef _Float16 h16x8 __attribute__((ext_vector_type(8)));
    const h16x8 r0 = __builtin_bit_cast(h16x8, rr0), r1 = __builtin_bit_cast(h16x8, rr1), k0 = __builtin_bit_cast(h16x8, kk0), k1 = __builtin_bit_cast(h16x8, kk1), v0 = __builtin_bit_cast(h16x8, vv0), v1 = __builtin_bit_cast(h16x8, vv1);
    float bs = 0.f;
#pragma unroll
    for (int i = 0; i < 8; ++i) { bs = fmaf((float)r0[i] * (float)k0[i], r_k[ch0 + i], bs); bs = fmaf((float)r1[i] * (float)k1[i], r_k[ch0 + 8 + i], bs); }
    bs = quad_sum(bs);
    float o[16];
#pragma unroll
    for (int i = 0; i < 16; ++i) { const float yn = y[i >> 2][i & 3] * rstd * gn_w[ch0 + i] + gn_b[ch0 + i];
        const float vv = i < 8 ? (float)v0[i & 7] : (float)v1[i & 7]; const float gt = i < 4 ? g0.a[i & 3] : (i < 8 ? g0.b[i & 3] : (i < 12 ? g1.a[i & 3] : g1.b[i & 3]));
        o[i] = (yn + bs * vv) * gt; }
    u32x4 w0, w1; w0.x = pk2(o[0], o[1]); w0.y = pk2(o[2], o[3]); w0.z = pk2(o[4], o[5]); w0.w = pk2(o[6], o[7]); w1.x = pk2(o[8], o[9]); w1.y = pk2(o[10], o[11]); w1.z = pk2(o[12], o[13]); w1.w = pk2(o[14], o[15]);
    *(u32x4*)gp = w0; *(u32x4*)(gp + 8) = w1;
}
__device__ __forceinline__ void outproj_sample_col(int d, const bf16_t* mixg, const bf16_t* woutT, const float* xs, float* out, int lane) {
    float acc[8] = {0.f, 0.f, 0.f, 0.f, 0.f, 0.f, 0.f, 0.f};
#pragma unroll
    for (int i = 0; i < 4; ++i) { const int e0 = 8 * lane + 512 * i; const F8 w = ld_bf8(woutT + (size_t)d * DM + e0);
#pragma unroll
        for (int r = 0; r < 8; ++r) { const F8 x = ld_bf8(mixg + (size_t)(MP + r) * DM + e0);
            acc[r] += (w.a[0] * x.a[0] + w.a[1] * x.a[1]) + (w.a[2] * x.a[2] + w.a[3] * x.a[3]) + (w.b[0] * x.b[0] + w.b[1] * x.b[1]) + (w.b[2] * x.b[2] + w.b[3] * x.b[3]); } }
#pragma unroll
    for (int r = 0; r < 8; ++r) { const float t = wave_sum(acc[r]); if (lane == r) out[O_YS + r * DM + d] = t + xs[r * DM + d]; }
}

#define XB_TMO      128
#define XB_XCNT(j)  (256  + 64 * (j))
#define XB_XSUB(j)  (1280 + 64 * (j))
#define XB_XGEN(j)  (2304 + 64 * (j))
#define XB_TOP      3328
#define XB_TOPGEN   3392
#define XCD_BAR_WORDS 3456
#define XB_SPIN_CAP (1u << 18)

__device__ __forceinline__ unsigned xb_ld(unsigned* p)              { return __hip_atomic_load(p, __ATOMIC_RELAXED, __HIP_MEMORY_SCOPE_AGENT); }
__device__ __forceinline__ unsigned xb_add(unsigned* p, unsigned v) { return __hip_atomic_fetch_add(p, v, __ATOMIC_RELAXED, __HIP_MEMORY_SCOPE_AGENT); }
__device__ __forceinline__ unsigned xb_xcc_id() { return (unsigned)__builtin_amdgcn_s_getreg((3 << 11) | 20) & 0xFu; }
#define XB_SPIN(cond, bar) do { unsigned _sp = 0; while (cond) { __builtin_amdgcn_s_sleep(1); \
    if ((++_sp & 255u) == 0u) { if (xb_ld(&(bar)[XB_TMO])) break; if (_sp > XB_SPIN_CAP) { atomicAdd(&(bar)[XB_TMO], 1u); break; } } } } while (0)

struct XcdBarrier {
    unsigned* bar; unsigned x;
    volatile LAS unsigned* st;
};

__device__ __forceinline__ XcdBarrier xcd_barrier_post(unsigned* bar, volatile LAS unsigned* st) {
    XcdBarrier b; b.bar = bar; b.x = xb_xcc_id(); b.st = st;
    if (threadIdx.x == 0) (void)xb_add(&bar[XB_XCNT(b.x)], 1u);
    return b;
}
__device__ __forceinline__ void xcd_barrier_complete(unsigned* bar, unsigned x, unsigned& nloc, unsigned& nx) {
    const unsigned G = gridDim.x * gridDim.y * gridDim.z;
    unsigned sum, cnt, mine, sp = 0u;
    for (;;) {
        sum = 0u; cnt = 0u; mine = 0u;
#pragma unroll
        for (unsigned j = 0; j < 16; ++j) { const unsigned c = xb_ld(&bar[XB_XCNT(j)]); sum += c; cnt += (c > 0u) ? 1u : 0u; mine = (j == x) ? c : mine; }
        if (sum == G) break;
        __builtin_amdgcn_s_sleep(1);
        if ((++sp & 255u) == 0u) { if (xb_ld(&bar[XB_TMO])) break; if (sp > XB_SPIN_CAP) { atomicAdd(&bar[XB_TMO], 1u); break; } }
    }
    nloc = mine > 0u ? mine : 1u; nx = cnt > 0u ? cnt : 1u;
}

__device__ __forceinline__ void xcd_barrier(const XcdBarrier& b) {
    asm volatile("s_waitcnt vmcnt(0)" ::: "memory");
    __syncthreads();
    if (threadIdx.x == 0) {
        unsigned* bar = b.bar;
        __builtin_amdgcn_s_waitcnt(0);
        unsigned nloc = b.st[0], nx = b.st[1];
        if (nloc == 0u) { xcd_barrier_complete(bar, b.x, nloc, nx); b.st[0] = nloc; b.st[1] = nx; }
        const unsigned old = xb_add(&bar[XB_XSUB(b.x)], 1u);
        const unsigned gen = old / nloc;
        if (old + 1u == (gen + 1u) * nloc) {
            __builtin_amdgcn_fence(__ATOMIC_RELEASE, "agent");
            asm volatile("s_waitcnt vmcnt(0)" ::: "memory");
            const unsigned og = xb_add(&bar[XB_TOP], 1u);
            const unsigned tg = og / nx;
            if (og + 1u == (tg + 1u) * nx) xb_add(&bar[XB_TOPGEN], 1u);
            else XB_SPIN(xb_ld(&bar[XB_TOPGEN]) == tg, bar);
            __builtin_amdgcn_fence(__ATOMIC_ACQUIRE, "agent");
            xb_add(&bar[XB_XGEN(b.x)], 1u);
            asm volatile("s_waitcnt vmcnt(0)" ::: "memory");
        } else {
            XB_SPIN(xb_ld(&bar[XB_XGEN(b.x)]) == gen, bar);
            __builtin_amdgcn_fence(__ATOMIC_ACQUIRE, "agent");
            asm volatile("s_waitcnt vmcnt(0)" ::: "memory");
        }
    }
    __syncthreads();
}


struct Args { const float* in[21]; float* out; unsigned char* ws; };
__global__ void __launch_bounds__(NT, 2) mk_fwd(Args a) {
    extern __shared__ __attribute__((aligned(16))) unsigned char lds_raw[];
    LAS unsigned char* lds = (LAS unsigned char*)lds_raw;
    cg::grid_group grid = cg::this_grid();
    const int tid = threadIdx.x, lane = tid & 63, wave = __builtin_amdgcn_readfirstlane(tid >> 6);
    const int G = gridDim.x, bx = blockIdx.x;
    unsigned char* ws = a.ws; float* out = a.out;
    bf16_t* xn = (bf16_t*)(ws + WS_XN); bf16_t* winT = (bf16_t*)(ws + WS_WIN); bf16_t* woutT = (bf16_t*)(ws + WS_WOUT);
    bf16_t* wupT = (bf16_t*)(ws + WS_WUP); bf16_t* aupT = (bf16_t*)(ws + WS_AUP);
    bf16_t* zs = (bf16_t*)(ws + WS_ZS); float* yraw = (float*)(ws + WS_YR); bf16_t* mixg = (bf16_t*)(ws + WS_MIX);
    bf16_t* qn = (bf16_t*)(ws + WS_QN); bf16_t* kn = (bf16_t*)(ws + WS_KN); bf16_t* va = (bf16_t*)(ws + WS_VA);
    unsigned char* Eb = ws + WS_E; float* part = (float*)(ws + WS_PART);
    { volatile LAS unsigned* xst = (volatile LAS unsigned*)(lds + 147328);
      if (tid == 0) { xst[0] = 0u; xst[1] = 0u; }
      __syncthreads();
      (void)xcd_barrier_post((unsigned*)(ws + WS_BAR), xst); }
#define GBAR() do { XcdBarrier _b; _b.bar = (unsigned*)(a.ws + WS_BAR); _b.x = xb_xcc_id(); _b.st = (volatile LAS unsigned*)(lds + 147328); xcd_barrier(_b); } while (0)

#ifndef PROBE_DUP
#define PROBE_DUP 0
#endif
    p0_prologue(a.in[0], a.in[1], a.in[6], a.in[7], a.in[10], a.in[12], a.in[20], ws, lds, G, bx, wave, lane, tid);
    if (a.out == nullptr) grid.sync();
    GBAR();
    { pg8::Gemm g{xn, winT, MPAD, NPAD, DM}; pg8::StaticOrder S; S.init(MPAD, NPAD, G, bx);
      EpiIn E{zs, mixg, qn, kn, va, out, a.in[18], a.in[19]};
      pg8::gemm_phase<EpiIn, pg8::StaticOrder, true, true>(lds, g, S, E); }
    GBAR();
    for (int t = bx * NW + wave; t < SA_TASKS; t += G * NW) attn_sample_part(t, qn, kn, va, a.in[4], a.in[5], part, lane);
    for (int u = bx; u < 512; u += G) prep_unit(u, zs, Eb, wupT, aupT, a.in[3], a.in[8], a.in[9], a.in[11], a.in[13], a.in[14], wave, lane, lds);
    if (G >= 16) { if (bx >= G - 16 && wave == 0) prep_unit(512, zs, Eb, wupT, aupT, a.in[3], a.in[8], a.in[9], a.in[11], a.in[13], a.in[14], bx - (G - 16), lane, lds); }
    else if (bx == G - 1) { for (int hd = wave; hd < 16; hd += NW) prep_unit(512, zs, Eb, wupT, aupT, a.in[3], a.in[8], a.in[9], a.in[11], a.in[13], a.in[14], hd, lane, lds); }
    __syncthreads();
    { const int vcu2 = (G % 8 == 0) ? (bx % 8) * (G / 8) + bx / 8 : bx;
      for (int u = vcu2; u < 512; u += G) attn_unit(u, qn, kn, va, mixg, mixg, lds, wave, lane, tid); }
    GBAR();
    {
        for (int gw = bx * NW + wave; gw < 2048; gw += G * NW) { const int sbh = gw >> 4, rq = gw & 15, sb = sbh >> 4, h = sbh & 15;
            scan_one(Eb + e_rec(MP + sb, h) * ESTRIDE, rq, a.in[2] + (size_t)sbh * 4096, out + O_WKVS + (size_t)sbh * 4096, yraw + (size_t)(MP + sb) * 1024 + h * 64, lane); }
        const int vcu = (G % 8 == 0) ? (bx % 8) * (G / 8) + bx / 8 : bx;
        for (int pair = vcu; pair < 256; pair += G) scan_pair(pair, Eb, out, yraw, lds, wave, lane);
    }
    GBAR();
    for (int t = bx * NW + wave; t < MTOT + 128; t += G * NW) { if (t < MTOT) fin_token(t, yraw, Eb, mixg, a.in[16], a.in[17], a.in[15], lane); else attn_sample_combine(t - MTOT, part, mixg, lane); }
    GBAR();
    { pg8::Gemm g{mixg, woutT, MP, DM, DM}; pg8::StaticOrder S; S.init(MP, DM, G, bx);
      EpiOut E{a.in[0], a.in[1], out};
      pg8::gemm_phase<EpiOut, pg8::StaticOrder, false, true>(lds, g, S, E); }
    for (int d = bx * NW + wave; d < DM; d += G * NW) outproj_sample_col(d, mixg, woutT, a.in[1], out, lane);
}

extern "C" void kernel_launch(void* const* d_in, const int* in_sizes, int n_in, void* d_out, int out_size, void* d_ws, size_t ws_size, hipStream_t stream) {
    static int grid = 0;
    if (grid == 0) {
        if (n_in != 21 || ws_size < WS_END) { fprintf(stderr, "kernel_launch: unexpected n_in %d / ws %zu\n", n_in, ws_size); grid = -1; return; }
        int dev = 0, cus = 0, per_cu = 0;
        (void)hipGetDevice(&dev); (void)hipDeviceGetAttribute(&cus, hipDeviceAttributeMultiprocessorCount, dev);
        (void)hipFuncSetAttribute((const void*)mk_fwd, hipFuncAttributeMaxDynamicSharedMemorySize, LDS_BYTES);
        (void)hipOccupancyMaxActiveBlocksPerMultiprocessor(&per_cu, (const void*)mk_fwd, NT, LDS_BYTES);
        if (per_cu < 1) { fprintf(stderr, "kernel_launch: occupancy query reports %d\n", per_cu); per_cu = 1; }
        grid = cus * 1;
        (void)hipGetLastError();
    }
    if (grid < 0) return;
    if (hipMemsetAsync((char*)d_ws + WS_BAR, 0, 16384, stream) != hipSuccess) { fprintf(stderr, "kernel_launch: memset of barrier words failed\n"); return; }
    Args a{};
    for (int i = 0; i < 21; ++i) a.in[i] = (const float*)d_in[i];
    a.out = (float*)d_out; a.ws = (unsigned char*)d_ws;
    void* args[] = {&a};
    hipError_t e = hipLaunchCooperativeKernel((const void*)mk_fwd, dim3(grid), dim3(NT), args, LDS_BYTES, stream);
    if (e != hipSuccess) fprintf(stderr, "cooperative launch failed: %s (grid %d)\n", hipGetErrorString(e), grid);
}
```

```cpp
#include <hip/hip_runtime.h>
#include <hip/hip_cooperative_groups.h>
#include <cstdio>
#include <cstdint>
namespace cg = cooperative_groups;
namespace pg8 {
#define PG8_LAS __attribute__((address_space(3)))
typedef unsigned short bf16_t;
typedef short bf16x8 __attribute__((ext_vector_type(8)));
typedef float f32x4 __attribute__((ext_vector_type(4)));
typedef unsigned u32x4 __attribute__((ext_vector_type(4)));
constexpr int BM = 256, BK = 64, HALF = 128, HTB = HALF * BK * 2, STAGE_BYTES = 8 * HTB, NXCD = 8, WGM = 8;
__host__ __device__ __forceinline__ int lds_byte(int r, int c) { const int st = (r >> 4) * 2 + (c >> 5), rr = r & 15, cc = c & 31, ob = rr * 64 + cc * 2; return st * 1024 + (ob ^ (((ob >> 9) & 1) << 5)); }
__host__ __device__ __forceinline__ void stage_rc(int b, int& R, int& C) { const int st = b / 1024, sb = b % 1024, swz = sb ^ (((sb >> 9) & 1) << 5); R = (st >> 1) * 16 + swz / 64; C = (st & 1) * 32 + (swz % 64) / 2; }
__host__ __device__ __forceinline__ int perm32(int rho) { const int n = rho >> 4, i = rho & 15; return 8 * (i >> 2) + 4 * n + (i & 3); }

struct Unit { int pm, pn; };
struct Gemm { const bf16_t* A; const bf16_t* Bt; int M, N, K; };

struct StaticOrder {
    int nM, nN, nwg, G, c;
    __host__ __device__ void init(int M, int N, int G_, int c_) { nM = M / BM; nN = N / BM; nwg = nM * nN; G = G_; c = c_; }
    __host__ __device__ bool next(int i, Unit& u) const {
        const long L = (long)i * G + c; if (L >= nwg) return false;
        int wgid = (int)L; { const int q = nwg / NXCD, r = nwg % NXCD, xcd = wgid % NXCD, off = wgid / NXCD; wgid = (xcd < r ? xcd * (q + 1) : r * (q + 1) + (xcd - r) * q) + off; }
        const int nig = WGM * nN, gid = wgid / nig, fm = gid * WGM, gsz = (nM - fm) < WGM ? (nM - fm) : WGM;
        u.pm = fm + ((wgid % nig) % gsz); u.pn = (wgid % nig) / gsz; return true;
    }
    __device__ __forceinline__ void a_ready(const Unit&) const {}
    __device__ __forceinline__ void done(const Unit&) const {}
};
template <class Epi, class Sched, bool ALIGN_EPI = false, bool SP2 = false>
__device__ __forceinline__ void gemm_phase(PG8_LAS unsigned char* lds, const Gemm g, const Sched& S, const Epi& E) {
    const int tid = threadIdx.x, wid = __builtin_amdgcn_readfirstlane(tid >> 6), lane = tid & 63, wr = wid >> 2, wc = wid & 3, fr = lane & 15, fq = lane >> 4;
    const int K = g.K, nt = K / BK;
    unsigned voffA[2], voffB[2];
#pragma unroll
    for (int i = 0; i < 2; ++i) { int R, C; stage_rc(tid * 16 + i * 8192, R, C); const int Rb = Epi::PERM ? ((R & ~31) + perm32(R & 31)) : R;
        voffA[i] = (unsigned)(R * K + C) * 2u; voffB[i] = (unsigned)(Rb * K + C) * 2u; }
    const size_t kstep = (size_t)(BK * 2);
    const size_t hstep = (size_t)HALF * K * 2;
    const size_t tstep = 2 * hstep;
    const unsigned ldsw = (unsigned)wid * 1024u;
    const int aoff = lds_byte(wr * 64 + fr, fq * 8), boff = lds_byte(wc * 32 + fr, fq * 8);
#define PG8_SA(b, h) (((b) * 2 + (h)) * HTB)
#define PG8_SB(b, h) ((4 + (b) * 2 + (h)) * HTB)
#define PG8_STAGE(bufoff, gbase, voff) do { _Pragma("unroll") for (int _i = 0; _i < 2; ++_i) \
        __builtin_amdgcn_global_load_lds((const unsigned*)((const char*)(gbase) + (voff)[_i]), (PG8_LAS unsigned*)(lds + (bufoff) + ldsw + _i * 8192), 16, 0, 0); } while (0)
#define PG8_LDA(dst, b, h) do { _Pragma("unroll") for (int m = 0; m < 4; ++m) _Pragma("unroll") for (int k = 0; k < 2; ++k) dst[m][k] = *(const PG8_LAS bf16x8*)(lds + PG8_SA(b, h) + aoff + m * 2048 + k * 1024); } while (0)
#define PG8_LDB(dst, b, h) do { _Pragma("unroll") for (int n = 0; n < 2; ++n) _Pragma("unroll") for (int k = 0; k < 2; ++k) dst[n][k] = *(const PG8_LAS bf16x8*)(lds + PG8_SB(b, h) + boff + n * 2048 + k * 1024); } while (0)
#define PG8_MMA(ai, bj, At, Bt) do { __builtin_amdgcn_s_setprio(1); _Pragma("unroll") for (int m = 0; m < 4; ++m) _Pragma("unroll") for (int n = 0; n < 2; ++n) _Pragma("unroll") for (int k = 0; k < 2; ++k) \
        acc[ai][bj][m][n] = __builtin_amdgcn_mfma_f32_16x16x32_bf16(Bt[n][k], At[m][k], acc[ai][bj][m][n], 0, 0, 0); __builtin_amdgcn_s_setprio(0); } while (0)
#define PG8_WAIT_V(n) asm volatile("s_waitcnt vmcnt(" #n ")" ::: "memory")
#define PG8_WAIT_L(n) asm volatile("s_waitcnt lgkmcnt(" #n ")" ::: "memory")
#define PG8_BAR __builtin_amdgcn_s_barrier()
#define PG8_SCHED __builtin_amdgcn_sched_barrier(0)
    Unit cur, nxt; int ui = 0;
    if (!S.next(0, cur)) return;
    f32x4 acc[2][2][4][2];
#pragma unroll
    for (int a = 0; a < 2; ++a)
#pragma unroll
        for (int b = 0; b < 2; ++b)
#pragma unroll
            for (int m = 0; m < 4; ++m)
#pragma unroll
                for (int n = 0; n < 2; ++n) acc[a][b][m][n] = (f32x4){0.f, 0.f, 0.f, 0.f};
    bf16x8 At[4][2], B0[2][2], B1[2][2];
    const char* cA = (const char*)g.A + (size_t)cur.pm * tstep; const char* cB = (const char*)g.Bt + (size_t)cur.pn * tstep;
    S.a_ready(cur);
    if constexpr (SP2) {
        PG8_STAGE(PG8_SB(0, 0), cB, voffB); PG8_STAGE(PG8_SB(0, 1), cB + hstep, voffB); PG8_STAGE(PG8_SA(0, 0), cA, voffA); PG8_STAGE(PG8_SA(0, 1), cA + hstep, voffA);
        if (wr == 1) PG8_BAR;
        PG8_WAIT_V(2); PG8_BAR;
        PG8_STAGE(PG8_SB(1, 0), cB + kstep, voffB); PG8_STAGE(PG8_SA(1, 0), cA + kstep, voffA); PG8_STAGE(PG8_SB(1, 1), cB + hstep + kstep, voffB);
        PG8_WAIT_V(6); PG8_BAR;
    } else {
        PG8_STAGE(PG8_SB(0, 0), cB, voffB); PG8_STAGE(PG8_SA(0, 0), cA, voffA); PG8_STAGE(PG8_SB(0, 1), cB + hstep, voffB); PG8_STAGE(PG8_SA(0, 1), cA + hstep, voffA);
        if (wr == 1) PG8_BAR;
        PG8_WAIT_V(4); PG8_BAR;
        PG8_STAGE(PG8_SB(1, 0), cB + kstep, voffB); PG8_STAGE(PG8_SA(1, 0), cA + kstep, voffA); PG8_STAGE(PG8_SB(1, 1), cB + hstep + kstep, voffB);
        PG8_WAIT_V(6); PG8_BAR;
    }
    for (;;) {
        const bool has_next = S.next(ui + 1, nxt);
        const char* nA = has_next ? (const char*)g.A + (size_t)nxt.pm * tstep : cA; const char* nB = has_next ? (const char*)g.Bt + (size_t)nxt.pn * tstep : cB;
        for (int t = 0; t < nt; t += 2) {
            const bool last = (t == nt - 2);
            const char* a1 = cA + (size_t)(t + 1) * kstep;
            const char* a2 = last ? nA : cA + (size_t)(t + 2) * kstep; const char* b2 = last ? nB : cB + (size_t)(t + 2) * kstep;
            const char* a3 = a2 + kstep; const char* b3 = b2 + kstep;
            if (last && has_next) S.a_ready(nxt);
            if constexpr (SP2) {
            PG8_LDB(B0, 0, 0); PG8_LDB(B1, 0, 1); PG8_SCHED; PG8_LDA(At, 0, 0); PG8_STAGE(PG8_SA(1, 1), a1 + hstep, voffA);
            PG8_WAIT_V(8); PG8_WAIT_L(0); PG8_BAR; PG8_MMA(0, 0, At, B0); PG8_MMA(0, 1, At, B1); PG8_BAR; PG8_SCHED;
            PG8_LDA(At, 0, 1); PG8_STAGE(PG8_SB(0, 0), b2, voffB); PG8_STAGE(PG8_SB(0, 1), b2 + hstep, voffB); PG8_STAGE(PG8_SA(0, 0), a2, voffA);
            PG8_WAIT_V(8); PG8_WAIT_L(0); PG8_BAR; PG8_MMA(1, 0, At, B0); PG8_MMA(1, 1, At, B1); PG8_BAR; PG8_SCHED;
            PG8_LDB(B0, 1, 0); PG8_LDB(B1, 1, 1); PG8_SCHED; PG8_LDA(At, 1, 0); PG8_STAGE(PG8_SA(0, 1), a2 + hstep, voffA);
            PG8_WAIT_V(8); PG8_WAIT_L(0); PG8_BAR; PG8_MMA(0, 0, At, B0); PG8_MMA(0, 1, At, B1); PG8_BAR; PG8_SCHED;
            PG8_LDA(At, 1, 1); PG8_STAGE(PG8_SB(1, 0), b3, voffB); PG8_STAGE(PG8_SB(1, 1), b3 + hstep, voffB); PG8_STAGE(PG8_SA(1, 0), a3, voffA);
            PG8_WAIT_V(8); PG8_WAIT_L(0); PG8_BAR; PG8_MMA(1, 0, At, B0); PG8_MMA(1, 1, At, B1); PG8_BAR; PG8_SCHED;
            } else {
            PG8_LDB(B0, 0, 0); PG8_SCHED; PG8_LDA(At, 0, 0); PG8_STAGE(PG8_SA(1, 1), a1 + hstep, voffA);
            PG8_WAIT_L(8); PG8_BAR; PG8_WAIT_L(0); PG8_MMA(0, 0, At, B0); PG8_BAR; PG8_SCHED;
            PG8_LDB(B1, 0, 1); PG8_STAGE(PG8_SB(0, 0), b2, voffB);
            PG8_BAR; PG8_WAIT_L(0); PG8_MMA(0, 1, At, B1); PG8_BAR;
            PG8_LDA(At, 0, 1); PG8_STAGE(PG8_SA(0, 0), a2, voffA);
            PG8_BAR; PG8_WAIT_L(0); PG8_MMA(1, 0, At, B0); PG8_BAR; PG8_SCHED;
            PG8_STAGE(PG8_SB(0, 1), b2 + hstep, voffB);
            PG8_WAIT_V(6); PG8_BAR; PG8_MMA(1, 1, At, B1); PG8_BAR;
            PG8_LDB(B0, 1, 0); PG8_SCHED; PG8_LDA(At, 1, 0); PG8_STAGE(PG8_SA(0, 1), a2 + hstep, voffA);
            PG8_WAIT_L(8); PG8_BAR; PG8_WAIT_L(0); PG8_MMA(0, 0, At, B0); PG8_BAR; PG8_SCHED;
            PG8_LDB(B1, 1, 1); PG8_STAGE(PG8_SB(1, 0), b3, voffB);
            PG8_BAR; PG8_WAIT_L(0); PG8_MMA(0, 1, At, B1); PG8_BAR;
            PG8_LDA(At, 1, 1); PG8_STAGE(PG8_SA(1, 0), a3, voffA);
            PG8_BAR; PG8_WAIT_L(0); PG8_MMA(1, 0, At, B0); PG8_BAR; PG8_SCHED;
            PG8_STAGE(PG8_SB(1, 1), b3 + hstep, voffB);
            PG8_WAIT_V(6); PG8_BAR; PG8_MMA(1, 1, At, B1); PG8_BAR;
            }
        }
        if constexpr (ALIGN_EPI) { if (wr == 0) PG8_BAR; }
        if constexpr (!Epi::AFTER_DRAIN) { E(acc, cur, wr, wc, fr, fq); S.done(cur); }
        if (!has_next) break;
#pragma unroll
        for (int a = 0; a < 2; ++a)
#pragma unroll
            for (int b = 0; b < 2; ++b)
#pragma unroll
                for (int m = 0; m < 4; ++m)
#pragma unroll
                    for (int n = 0; n < 2; ++n) acc[a][b][m][n] = (f32x4){0.f, 0.f, 0.f, 0.f};
        cur = nxt; cA = nA; cB = nB; ++ui;
        if constexpr (ALIGN_EPI) { if (wr == 1) PG8_BAR; }
    }
    PG8_WAIT_V(0);
    if constexpr (!ALIGN_EPI) { if (wr == 0) PG8_BAR; }
    PG8_BAR;
    if constexpr (Epi::AFTER_DRAIN) { E.fused(acc, cur, wr, wc, fr, fq, lds, wid, lane); S.done(cur); }
#undef PG8_SA
#undef PG8_SB
#undef PG8_STAGE
#undef PG8_LDA
#undef PG8_LDB
#undef PG8_MMA
#undef PG8_WAIT_V
#undef PG8_WAIT_L
#undef PG8_BAR
#undef PG8_SCHED
}
}
#define GAS __attribute__((address_space(1)))
#define LAS __attribute__((address_space(3)))
typedef unsigned short bf16_t;
typedef short bf16x8 __attribute__((ext_vector_type(8)));
typedef short s16x4 __attribute__((ext_vector_type(4)));
typedef float f32x4 __attribute__((ext_vector_type(4)));
typedef unsigned u32x4 __attribute__((ext_vector_type(4)));
typedef unsigned u32x2 __attribute__((ext_vector_type(2)));
typedef _Float16 h16;
typedef _Float16 h16x4 __attribute__((ext_vector_type(4)));

constexpr int NW = 8, NT = 512;
constexpr int DM = 2048, TSEQ = 4096, MP = 8192, MS = 8, MTOT = 8200, MPAD = 8448;
constexpr int SHW = 3264, NPAD = 8448, DR = 1024;
constexpr size_t MiB = 1u << 20;
constexpr size_t WS_XN = 0, WS_WIN = 33 * MiB, WS_E = 0, WS_WOUT = 97 * MiB, WS_WUP = 105 * MiB, WS_AUP = 105 * MiB + 512 * 1024;
constexpr size_t WS_ZS = 106 * MiB, WS_YR = 106 * MiB, WS_MIX = 159 * MiB, WS_QN = 192 * MiB, WS_KN = WS_QN + 17301504, WS_VA = WS_KN + 17301504, WS_PART = 242 * MiB, WS_BAR = 243 * MiB, WS_END = 244 * MiB;
constexpr int O_Y = 0, O_YS = 16777216, O_WKVP = 16793600, O_SHP = 16924672, O_KP = 16931200, O_VP = 21125504, O_WKVS = 25319808, O_SHS = 25844096, O_KS = 25870208, O_VS = 25878400;
constexpr int LDS_BYTES = 147456;
constexpr int ESTRIDE = 768;

__device__ __forceinline__ unsigned f2bf(float f) { unsigned u = __builtin_bit_cast(unsigned, f); return (u + 0x7fffu + ((u >> 16) & 1u)) >> 16; }
typedef __bf16 bf16x2_hw __attribute__((ext_vector_type(2)));
typedef float f32x2_hw __attribute__((ext_vector_type(2)));
__device__ __forceinline__ unsigned pk2(float lo, float hi) { const f32x2_hw v = {lo, hi}; const bf16x2_hw b = __builtin_convertvector(v, bf16x2_hw); return __builtin_bit_cast(unsigned, b); }
__device__ __forceinline__ float bf2f(unsigned short b) { return __builtin_bit_cast(float, (unsigned)b << 16); }
__device__ __forceinline__ float bflo(unsigned w) { return __builtin_bit_cast(float, w << 16); }
__device__ __forceinline__ float bfhi(unsigned w) { return __builtin_bit_cast(float, w & 0xffff0000u); }
__device__ __forceinline__ float wave_sum(float v) {
#pragma unroll
    for (int o = 1; o < 64; o <<= 1) v += __shfl_xor(v, o);
    return v;
}
__device__ __forceinline__ float wave_max(float v) {
#pragma unroll
    for (int o = 1; o < 64; o <<= 1) v = fmaxf(v, __shfl_xor(v, o));
    return v;
}
__device__ __forceinline__ float silu_f(float x) { return x / (1.f + __expf(-x)); }
__device__ __forceinline__ float sigmoid_f(float x) { return 1.f / (1.f + __expf(-x)); }
#define LDS_WAIT() asm volatile("s_waitcnt lgkmcnt(0)" ::: "memory")

struct EpiIn {
    static constexpr bool PERM = true, AFTER_DRAIN = false;
    bf16_t *zs, *mixg, *qn, *kn, *va; float* out; const float *qnw, *knw;
    __device__ __forceinline__ void shift_out(int row, int col, f32x4 v0, f32x4 v1) const {
        float* dst = nullptr;
        if (row == TSEQ - 1) dst = out + O_SHP + col;
        else if (row == 2 * TSEQ - 1) dst = out + O_SHP + SHW + col;
        else if (row >= MP && row < MTOT) dst = out + O_SHS + (row - MP) * SHW + col;
        if (dst) { *(f32x4*)dst = v0; *(f32x4*)(dst + 4) = v1; }
    }
    __device__ __forceinline__ void operator()(const f32x4 (&acc)[2][2][4][2], const pg8::Unit& u, int wr, int wc, int fr, int fq) const {
        const int pn = u.pn, sec = pn >> 2;
        const int rowb = u.pm * 256 + wr * 64 + fr;
        if (pn == 32) {
#pragma unroll
            for (int ai = 0; ai < 2; ++ai)
#pragma unroll
                for (int m = 0; m < 4; ++m) { const int row = rowb + ai * 128 + m * 16;
#pragma unroll
                    for (int bj = 0; bj < 2; ++bj) { const int p0 = 128 * bj + 32 * wc + 8 * fq;
                        if (p0 < 192) { const f32x4 v0 = acc[ai][bj][m][0], v1 = acc[ai][bj][m][1];
                            u32x4 w; w.x = pk2(v0[0], v0[1]); w.y = pk2(v0[2], v0[3]); w.z = pk2(v1[0], v1[1]); w.w = pk2(v1[2], v1[3]);
                            *(u32x4*)(zs + (size_t)row * SHW + 3072 + p0) = w;
                            shift_out(row, 3072 + p0, v0, v1); } } }
            return;
        }
        const int lcb = (pn & 3) * 256 + wc * 64 + fq * 8;
        if (sec <= 2) {
#pragma unroll
            for (int ai = 0; ai < 2; ++ai)
#pragma unroll
                for (int m = 0; m < 4; ++m) { const int row = rowb + ai * 128 + m * 16;
#pragma unroll
                    for (int bj = 0; bj < 2; ++bj) { const int col = sec * 1024 + lcb + bj * 32; const f32x4 v0 = acc[ai][bj][m][0], v1 = acc[ai][bj][m][1];
                        u32x4 w; w.x = pk2(v0[0], v0[1]); w.y = pk2(v0[2], v0[3]); w.z = pk2(v1[0], v1[1]); w.w = pk2(v1[2], v1[3]);
                        *(u32x4*)(zs + (size_t)row * SHW + col) = w;
                        shift_out(row, col, v0, v1); } }
        } else if (sec == 3 || sec == 7) {
            const int cb = (sec == 7 ? 1024 : 0) + lcb;
#pragma unroll
            for (int ai = 0; ai < 2; ++ai)
#pragma unroll
                for (int m = 0; m < 4; ++m) { const int row = rowb + ai * 128 + m * 16;
#pragma unroll
                    for (int bj = 0; bj < 2; ++bj) { const f32x4 v0 = acc[ai][bj][m][0], v1 = acc[ai][bj][m][1];
                        u32x4 w; w.x = pk2(silu_f(v0[0]), silu_f(v0[1])); w.y = pk2(silu_f(v0[2]), silu_f(v0[3])); w.z = pk2(silu_f(v1[0]), silu_f(v1[1])); w.w = pk2(silu_f(v1[2]), silu_f(v1[3]));
                        *(u32x4*)(mixg + (size_t)row * 2048 + cb + bj * 32) = w; } }
        } else if (sec == 6) {
#pragma unroll
            for (int ai = 0; ai < 2; ++ai)
#pragma unroll
                for (int m = 0; m < 4; ++m) { const int row = rowb + ai * 128 + m * 16;
                    float* dst = nullptr; const int t = row & (TSEQ - 1);
                    if (row < MP) { if (t >= 2048) dst = out + O_VP + ((size_t)((row >> 12) * 2048 + (t - 2048))) * 1024; }
                    else if (row < MTOT) dst = out + O_VS + (size_t)(row - MP) * 1024;
#pragma unroll
                    for (int bj = 0; bj < 2; ++bj) { const int col = lcb + bj * 32; const f32x4 v0 = acc[ai][bj][m][0], v1 = acc[ai][bj][m][1];
                        u32x4 w; w.x = pk2(v0[0], v0[1]); w.y = pk2(v0[2], v0[3]); w.z = pk2(v1[0], v1[1]); w.w = pk2(v1[2], v1[3]);
                        *(u32x4*)(va + (size_t)row * 1024 + col) = w;
                        if (dst) { *(f32x4*)(dst + col) = v0; *(f32x4*)(dst + col + 4) = v1; } } }
        } else {
            const bool isq = (sec == 4);
            const float* nwp = isq ? qnw : knw; const float sc = isq ? 0.125f : 1.0f;
            f32x4 nw[2][2];
#pragma unroll
            for (int bj = 0; bj < 2; ++bj) { nw[bj][0] = *(const f32x4*)(nwp + bj * 32 + fq * 8); nw[bj][1] = *(const f32x4*)(nwp + bj * 32 + fq * 8 + 4); }
            bf16_t* ob = isq ? qn : kn;
#pragma unroll
            for (int ai = 0; ai < 2; ++ai)
#pragma unroll
                for (int m = 0; m < 4; ++m) { const int row = rowb + ai * 128 + m * 16;
                    float ss = 0.f;
#pragma unroll
                    for (int bj = 0; bj < 2; ++bj)
#pragma unroll
                        for (int n = 0; n < 2; ++n) { const f32x4 x = acc[ai][bj][m][n]; ss += (x[0] * x[0] + x[1] * x[1]) + (x[2] * x[2] + x[3] * x[3]); }
                    ss += __shfl_xor(ss, 16); ss += __shfl_xor(ss, 32);
                    const float rs = rsqrtf(ss * (1.f / 64.f) + 1e-6f) * sc;
                    float* dst = nullptr; const int t = row & (TSEQ - 1);
                    if (!isq) { if (row < MP) { if (t >= 2048) dst = out + O_KP + ((size_t)((row >> 12) * 2048 + (t - 2048))) * 1024; }
                                else if (row < MTOT) dst = out + O_KS + (size_t)(row - MP) * 1024; }
#pragma unroll
                    for (int bj = 0; bj < 2; ++bj) { const int col = lcb + bj * 32; const f32x4 v0 = acc[ai][bj][m][0] * rs * nw[bj][0], v1 = acc[ai][bj][m][1] * rs * nw[bj][1];
                        u32x4 w; w.x = pk2(v0[0], v0[1]); w.y = pk2(v0[2], v0[3]); w.z = pk2(v1[0], v1[1]); w.w = pk2(v1[2], v1[3]);
                        *(u32x4*)(ob + (size_t)row * 1024 + col) = w;
                        if (dst) { *(f32x4*)(dst + col) = v0; *(f32x4*)(dst + col + 4) = v1; } } }
        }
    }
};
struct EpiOut {
    static constexpr bool PERM = true, AFTER_DRAIN = false;
    const float *xp, *xs; float* out;
    __device__ __forceinline__ void operator()(const f32x4 (&acc)[2][2][4][2], const pg8::Unit& u, int wr, int wc, int fr, int fq) const {
        const int rowb = u.pm * 256 + wr * 64 + fr, colb = u.pn * 256 + wc * 32 + fq * 8;
#pragma unroll
        for (int ai = 0; ai < 2; ++ai)
#pragma unroll
            for (int m = 0; m < 4; ++m) { const int row = rowb + ai * 128 + m * 16;
                const float* xr; float* orow;
                if (row < MP) { xr = xp + (size_t)row * DM; orow = out + O_Y + (size_t)row * DM; }
                else if (row < MTOT) { xr = xs + (size_t)(row - MP) * DM; orow = out + O_YS + (size_t)(row - MP) * DM; }
                else continue;
#pragma unroll
                for (int bj = 0; bj < 2; ++bj) { const int col = colb + bj * 128;
                    *(f32x4*)(orow + col) = acc[ai][bj][m][0] + *(const f32x4*)(xr + col);
                    *(f32x4*)(orow + col + 4) = acc[ai][bj][m][1] + *(const f32x4*)(xr + col + 4); } }
    }
};

__device__ __forceinline__ void p0_transpose_item(const float* W, int Nsrc, int src_n0, int k0, bf16_t* WT, int dst_row0, int Kdst, LAS float* scr, int lane) {
    if (src_n0 < 0) {
        const int c = lane & 7;
#pragma unroll
        for (int j = 0; j < 4; ++j) { const int n = (lane >> 3) + 8 * j; *(u32x4*)(WT + (size_t)(dst_row0 + n) * Kdst + k0 + 8 * c) = (u32x4){0u, 0u, 0u, 0u}; }
        return;
    }
    {
        f32x4 t[8];
#pragma unroll
        for (int i = 0; i < 8; ++i) { const int kk = 8 * i + (lane >> 3); t[i] = *(const f32x4*)(W + (size_t)(k0 + kk) * Nsrc + src_n0 + 4 * (lane & 7)); }
#pragma unroll
        for (int i = 0; i < 8; ++i) { const int kk = 8 * i + (lane >> 3); LAS float* d = scr + kk * 33 + 4 * (lane & 7); d[0] = t[i].x; d[1] = t[i].y; d[2] = t[i].z; d[3] = t[i].w; }
    }
    LDS_WAIT(); asm volatile("" ::: "memory");
    const int c = lane & 7;
#pragma unroll
    for (int j = 0; j < 4; ++j) { const int n = (lane >> 3) + 8 * j; const LAS float* s = scr + (8 * c) * 33 + n;
        u32x4 o; o.x = pk2(s[0 * 33], s[1 * 33]); o.y = pk2(s[2 * 33], s[3 * 33]); o.z = pk2(s[4 * 33], s[5 * 33]); o.w = pk2(s[6 * 33], s[7 * 33]);
        *(u32x4*)(WT + (size_t)(dst_row0 + n) * Kdst + k0 + 8 * c) = o; }
    LDS_WAIT(); asm volatile("" ::: "memory");
}
__device__ __forceinline__ int win_src_col(int n0) {
    const int T = n0 >> 8, p = n0 & 255;
    if (T < 32) { const int s = T >> 2, ts = T & 3, bj = p >> 7, wc = (p & 127) >> 5; const int lc = ts * 256 + wc * 64 + bj * 32;
        return (s < 3 ? s * 1024 : SHW + (s - 3) * 1024) + lc; }
    return p < 192 ? 3072 + p : -1;
}
__device__ __forceinline__ void p0_prologue(const float* xp, const float* xs, const float* nwp, const float* w_in, const float* w_up, const float* a_up, const float* w_out, unsigned char* ws, LAS unsigned char* lds, int G, int bx, int wave, int lane, int tid) {
    LAS float* scr = (LAS float*)(lds + wave * 16384);
    const int gw = bx * NW + wave, NGW = G * NW;
    bf16_t* winT = (bf16_t*)(ws + WS_WIN); bf16_t* woutT = (bf16_t*)(ws + WS_WOUT);
    constexpr int I_IN = 32 * (NPAD / 32), I_OUT = 32 * (DM / 32);
    for (int it = gw; it < I_IN + I_OUT; it += NGW) {
        if (it < I_IN) { const int kb = it / (NPAD / 32), nb = it % (NPAD / 32); p0_transpose_item(w_in, 8384, win_src_col(nb * 32), kb * 64, winT, nb * 32, DM, scr, lane); }
        else { const int r = it - I_IN; const int kb = r / (DM / 32), nb = r % (DM / 32); p0_transpose_item(w_out, DM, nb * 32, kb * 64, woutT, nb * 32, DM, scr, lane); }
    }
    { bf16_t* wupT = (bf16_t*)(ws + WS_WUP); bf16_t* aupT = (bf16_t*)(ws + WS_AUP);
      for (int i = bx * NT + tid; i < 2 * 1024 * 12; i += G * NT) { const int which = i / 12288, r = i % 12288, n = r / 12, c = r % 12;
          const float* W = which ? a_up : w_up; bf16_t* D = which ? aupT : wupT;
          u32x4 o; o.x = pk2(W[(8 * c + 0) * 1024 + n], W[(8 * c + 1) * 1024 + n]); o.y = pk2(W[(8 * c + 2) * 1024 + n], W[(8 * c + 3) * 1024 + n]);
          o.z = pk2(W[(8 * c + 4) * 1024 + n], W[(8 * c + 5) * 1024 + n]); o.w = pk2(W[(8 * c + 6) * 1024 + n], W[(8 * c + 7) * 1024 + n]);
          *(u32x4*)(D + n * 96 + 8 * c) = o; } }
    bf16_t* xn = (bf16_t*)(ws + WS_XN);
    for (int m = gw; m < MPAD; m += NGW) {
        u32x2* o8 = (u32x2*)(xn + (size_t)m * DM) + lane;
        if (m >= MTOT) {
#pragma unroll
            for (int j = 0; j < 8; ++j) o8[64 * j] = (u32x2){0u, 0u};
            continue; }
        const float* xrow = m < MP ? xp + (size_t)m * DM : xs + (size_t)(m - MP) * DM;
        const f32x4* xr = (const f32x4*)xrow + lane;
        f32x4 v[8]; float s = 0.f;
#pragma unroll
        for (int j = 0; j < 8; ++j) { v[j] = xr[64 * j]; s += (v[j].x * v[j].x + v[j].y * v[j].y) + (v[j].z * v[j].z + v[j].w * v[j].w); }
        const float rstd = rsqrtf(wave_sum(s) * (1.f / DM) + 1e-6f);
#pragma unroll
        for (int j = 0; j < 8; ++j) { const f32x4 g = ((const f32x4*)nwp)[lane + 64 * j]; const f32x4 y = v[j] * rstd * g;
            o8[64 * j] = (u32x2){pk2(y.x, y.y), pk2(y.z, y.w)}; }
    }
}
__device__ __forceinline__ size_t e_rec(int m, int h) { return m < MP ? ((size_t)((m >> 12) * 16 + h) * TSEQ + (m & (TSEQ - 1))) : ((size_t)32 * TSEQ + (size_t)(m - MP) * 16 + h); }
struct F8 { f32x4 a, b; };
__device__ __forceinline__ F8 ld_bf8(const bf16_t* p) { const u32x4 w = *(const u32x4*)p; F8 r; r.a = (f32x4){bflo(w.x), bfhi(w.x), bflo(w.y), bfhi(w.y)}; r.b = (f32x4){bflo(w.z), bfhi(w.z), bflo(w.w), bfhi(w.w)}; return r; }
__device__ __forceinline__ F8 ld_prev8(const bf16_t* zs, const float* sst, int m, int col) {
    F8 r;
    if (m >= MP) { const float* p = sst + (m - MP) * SHW + col; r.a = *(const f32x4*)p; r.b = *(const f32x4*)(p + 4); return r; }
    if ((m & (TSEQ - 1)) == 0) { r.a = (f32x4){0.f, 0.f, 0.f, 0.f}; r.b = r.a; return r; }
    return ld_bf8(zs + (size_t)(m - 1) * SHW + col);
}
__device__ __forceinline__ float ld_prev1(const bf16_t* zs, const float* sst, int m, int col) {
    if (m >= MP) return sst[(m - MP) * SHW + col];
    if ((m & (TSEQ - 1)) == 0) return 0.f;
    return bf2f(zs[(size_t)(m - 1) * SHW + col]);
}
__device__ __forceinline__ float tanh_f(float x) { return 1.f - 2.f / (1.f + __expf(2.f * x)); }
__device__ __forceinline__ bf16x8 pack_bf8(f32x4 a, f32x4 b) { u32x4 w; w.x = pk2(a[0], a[1]); w.y = pk2(a[2], a[3]); w.z = pk2(b[0], b[1]); w.w = pk2(b[2], b[3]); return __builtin_bit_cast(bf16x8, w); }

struct F4 { float v[4]; };
__device__ __forceinline__ f32x4 cv_bf4(u32x2 w) { return (f32x4){bflo(w.x), bfhi(w.x), bflo(w.y), bfhi(w.y)}; }
__device__ __forceinline__ f32x4 ld_bf4(const bf16_t* p) { const u32x2 w = *(const u32x2*)p; return (f32x4){bflo(w.x), bfhi(w.x), bflo(w.y), bfhi(w.y)}; }
__device__ __forceinline__ f32x4 ld_prev4(const bf16_t* zs, const float* sst, int m, int col) {
    if (m >= MP) return *(const f32x4*)(sst + (m - MP) * SHW + col);
    if ((m & (TSEQ - 1)) == 0) return (f32x4){0.f, 0.f, 0.f, 0.f};
    return ld_bf4(zs + (size_t)(m - 1) * SHW + col);
}
typedef _Float16 h16x4s __attribute__((ext_vector_type(4)));
__device__ __forceinline__ void st_h4l(LAS unsigned char* p, f32x4 v) { h16x4s h; h[0] = (h16)v[0]; h[1] = (h16)v[1]; h[2] = (h16)v[2]; h[3] = (h16)v[3]; *(LAS h16x4s*)p = h; }
__device__ __forceinline__ void st_h4(unsigned char* p, f32x4 v) { h16x4s h; h[0] = (h16)v[0]; h[1] = (h16)v[1]; h[2] = (h16)v[2]; h[3] = (h16)v[3]; *(h16x4s*)p = h; }
__device__ __forceinline__ int m_of(int tg, int lane) { return 16 * tg + (lane & 15); }
template <bool SAMP> __device__ __forceinline__ F8 prev8(const bf16_t* zs, const float* sst, int m, int col, bool first) {
    if (SAMP) { const float* p = sst + (m - MP) * SHW + col; F8 r; r.a = *(const f32x4*)p; r.b = *(const f32x4*)(p + 4); return r; }
    F8 r = ld_bf8(zs + (size_t)(m - (first ? 0 : 1)) * SHW + col); const float z = first ? 0.f : 1.f; r.a = r.a * z; r.b = r.b * z; return r;
}
template <bool SAMP> __device__ __forceinline__ f32x4 prev4(const bf16_t* zs, const float* sst, int m, int col, bool first) {
    if (SAMP) return *(const f32x4*)(sst + (m - MP) * SHW + col);
    const f32x4 r = ld_bf4(zs + (size_t)(m - (first ? 0 : 1)) * SHW + col); return r * (first ? 0.f : 1.f);
}
template <bool SAMP> __device__ __forceinline__ void prep_unit_t(int tg, const bf16_t* __restrict__ zs, unsigned char* __restrict__ Eb, const bf16_t* wupT, const bf16_t* aupT, const float* sst, const float* mu,
                                          const float* w0, const float* a0, const float* k_k, const float* k_a, int wave, int lane, LAS unsigned char* stg, bool do_store = true) {
    const int q = lane & 15, g = lane >> 4;
    constexpr bool samp = SAMP;
    const bool first = !SAMP && ((m_of(tg, lane) & (TSEQ - 1)) == 0);
    const int m = samp ? MP + (q < 8 ? q : 7) : 16 * tg + q;
    const bool wr_ok = !(samp && q >= 8) && do_store;
    bf16x8 Bw[3], Ba[3];
#pragma unroll
    for (int ks = 0; ks < 3; ++ks) {
        { const int col = 3072 + 32 * ks + 8 * g; const F8 c = ld_bf8(zs + (size_t)m * SHW + col), p = prev8<SAMP>(zs, sst, m, col, first);
          const f32x4 m0 = *(const f32x4*)(mu + col), m1 = *(const f32x4*)(mu + col + 4);
          f32x4 xa = c.a + m0 * (p.a - c.a), xb = c.b + m1 * (p.b - c.b);
#pragma unroll
          for (int i = 0; i < 4; ++i) { xa[i] = tanh_f(xa[i]); xb[i] = tanh_f(xb[i]); }
          Bw[ks] = pack_bf8(xa, xb); }
        { const int col = 3168 + 32 * ks + 8 * g; const F8 c = ld_bf8(zs + (size_t)m * SHW + col), p = prev8<SAMP>(zs, sst, m, col, first);
          const f32x4 m0 = *(const f32x4*)(mu + col), m1 = *(const f32x4*)(mu + col + 4);
          const f32x4 xa = c.a + m0 * (p.a - c.a), xb = c.b + m1 * (p.b - c.b);
          Ba[ks] = pack_bf8(xa, xb); }
    }
#pragma unroll 1
    for (int hh = 0; hh < (SAMP ? 1 : 2); ++hh) {
        const int h = SAMP ? wave : 2 * wave + hh;
        unsigned char* erec = Eb + e_rec(m, h) * ESTRIDE;
        f32x4 kkr[4], av[4]; float ss = 0.f;
        u32x2 zrc[4], zkc[4], zvc[4], zrp[4], zkp[4], zvp[4];
        const size_t prow = (size_t)(SAMP ? m : m - (first ? 0 : 1)) * SHW;
#pragma unroll
        for (int j = 0; j < 4; ++j) { const int ch = h * 64 + 16 * j + 4 * g;
            zrc[j] = *(const u32x2*)(zs + (size_t)m * SHW + ch); zkc[j] = *(const u32x2*)(zs + (size_t)m * SHW + 1024 + ch); zvc[j] = *(const u32x2*)(zs + (size_t)m * SHW + 2048 + ch);
            zrp[j] = *(const u32x2*)(zs + prow + ch); zkp[j] = *(const u32x2*)(zs + prow + 1024 + ch); zvp[j] = *(const u32x2*)(zs + prow + 2048 + ch); }
#pragma unroll
        for (int j = 0; j < 4; ++j) {
            const int chA = h * 64 + 16 * j + q;
            const int ch = h * 64 + 16 * j + 4 * g;
            f32x4 cw = (f32x4){0.f, 0.f, 0.f, 0.f}, ca = cw;
#pragma unroll
            for (int ks = 0; ks < 3; ++ks) {
                const bf16x8 aw = *(const bf16x8*)(wupT + chA * 96 + 32 * ks + 8 * g), aa = *(const bf16x8*)(aupT + chA * 96 + 32 * ks + 8 * g);
                cw = __builtin_amdgcn_mfma_f32_16x16x32_bf16(aw, Bw[ks], cw, 0, 0, 0);
                ca = __builtin_amdgcn_mfma_f32_16x16x32_bf16(aa, Ba[ks], ca, 0, 0, 0);
            }
            const f32x4 w0c = *(const f32x4*)(w0 + ch), a0c = *(const f32x4*)(a0 + ch), kkc = *(const f32x4*)(k_k + ch), kac = *(const f32x4*)(k_a + ch);
            const f32x4 mur = *(const f32x4*)(mu + ch), muk = *(const f32x4*)(mu + 1024 + ch), muv = *(const f32x4*)(mu + 2048 + ch);
            const f32x4 rc = cv_bf4(zrc[j]), kc = cv_bf4(zkc[j]), vc = cv_bf4(zvc[j]);
            f32x4 rp, kp, vp;
            if (SAMP) { rp = *(const f32x4*)(sst + (m - MP) * SHW + ch); kp = *(const f32x4*)(sst + (m - MP) * SHW + 1024 + ch); vp = *(const f32x4*)(sst + (m - MP) * SHW + 2048 + ch); }
            else { const float z = first ? 0.f : 1.f; rp = cv_bf4(zrp[j]) * z; kp = cv_bf4(zkp[j]) * z; vp = cv_bf4(zvp[j]) * z; }
            const f32x4 rv = rc + mur * (rp - rc), vv = vc + muv * (vp - vc), km = kc + muk * (kp - kc);
            f32x4 a, u;
#pragma unroll
            for (int c = 0; c < 4; ++c) { a[c] = sigmoid_f(a0c[c] + ca[c]); u[c] = expm1f(-0.60653065971f * sigmoid_f(w0c[c] + cw[c])); }
            const f32x4 kr = km * kkc; kkr[j] = kr; av[j] = a; ss += (kr[0] * kr[0] + kr[1] * kr[1]) + (kr[2] * kr[2] + kr[3] * kr[3]);
            if (SAMP) { if (wr_ok) { unsigned char* e = erec + (16 * j + 4 * g) * 2;
                st_h4(e, u); st_h4(e + 128, km * (1.f + (a - 1.f) * kac)); st_h4(e + 512, rv); st_h4(e + 640, vv); } }
            else { LAS unsigned char* e = stg + q * 784 + (16 * j + 4 * g) * 2;
                st_h4l(e, u); st_h4l(e + 128, km * (1.f + (a - 1.f) * kac)); st_h4l(e + 512, rv); st_h4l(e + 640, vv); }
        }
        ss += __shfl_xor(ss, 16); ss += __shfl_xor(ss, 32);
        const float inv = 1.f / fmaxf(sqrtf(ss), 1e-12f);
        if (SAMP) { if (wr_ok) {
#pragma unroll
            for (int j = 0; j < 4; ++j) { unsigned char* e = erec + (16 * j + 4 * g) * 2; const f32x4 kk = kkr[j] * inv;
                st_h4(e + 256, -kk); st_h4(e + 384, kk * av[j]); } } }
        else {
#pragma unroll
            for (int j = 0; j < 4; ++j) { LAS unsigned char* e = stg + q * 784 + (16 * j + 4 * g) * 2; const f32x4 kk = kkr[j] * inv;
                st_h4l(e + 256, -kk); st_h4l(e + 384, kk * av[j]); }
            LDS_WAIT(); asm volatile("" ::: "memory");
            unsigned char* gb = Eb + e_rec(16 * tg, h) * ESTRIDE;
            if (do_store) {
#pragma unroll
                for (int it = 0; it < 12; ++it) { const int x = it * 64 + lane; const u32x4 w = *(const LAS u32x4*)(stg + (x / 48) * 784 + (x % 48) * 16); *(u32x4*)(gb + (size_t)x * 16) = w; }
            }
            LDS_WAIT(); asm volatile("" ::: "memory");
        }
    }
}

__device__ __forceinline__ void prep_unit(int tg, const bf16_t* zs, unsigned char* Eb, const bf16_t* wupT, const bf16_t* aupT, const float* sst, const float* mu,
                                          const float* w0, const float* a0, const float* k_k, const float* k_a, int wave, int lane, LAS unsigned char* lds, bool do_store = true) {
    LAS unsigned char* stg = lds + wave * (16 * 784);
    if (tg >= 512) prep_unit_t<true>(tg, zs, Eb, wupT, aupT, sst, mu, w0, a0, k_k, k_a, wave  , lane, stg, do_store);
    else prep_unit_t<false>(tg, zs, Eb, wupT, aupT, sst, mu, w0, a0, k_k, k_a, wave, lane, stg, do_store);
}

__device__ __forceinline__ s16x4 tr_read(LAS unsigned char* p) { return __builtin_bit_cast(s16x4, __builtin_amdgcn_ds_read_tr16_b64_v4i16((LAS s16x4*)p)); }
constexpr int ACC_PITCH = 68;
__device__ __forceinline__ float rowmax4(float v) {
    float a = v, b = v;
    asm volatile("s_nop 1\n\tv_permlane16_swap_b32 %0, %1" : "+v"(a), "+v"(b));
    float m = fmaxf(a, b); a = m; b = m;
    asm volatile("s_nop 1\n\tv_permlane32_swap_b32 %0, %1" : "+v"(a), "+v"(b));
    return fmaxf(a, b);
}
__device__ __forceinline__ void attn_pair_shared(int p, int wave, int mb, int tb, int h, float slope, const bf16_t* qn, const bf16_t* kn, const bf16_t* va,
                                                 LAS float* accL, LAS float* mL, LAS float* lL, LAS unsigned char* vst, int lane) {
    const int q = lane & 15, g = lane >> 4;
    const int d = p == 0 ? 1 : 4;
    const float sd = slope * (float)d;
    const int base = p == 0 ? 32 * wave : (wave & 3) + 128 * (wave >> 2);
    const int tok0 = tb + base;
    bf16x8 qa[2], qb[2]; float m_run[2], l_run[2]; f32x4 O[2][4];
#pragma unroll
    for (int j = 0; j < 2; ++j) {
        const bf16_t* qp = qn + (size_t)(mb + tok0 + (16 * j + q) * d) * 1024 + h * 64 + 8 * g;
        qa[j] = *(const bf16x8*)qp; qb[j] = *(const bf16x8*)(qp + 32);
        m_run[j] = -INFINITY; l_run[j] = 0.f;
#pragma unroll
        for (int i = 0; i < 4; ++i) O[j][i] = (f32x4){0.f, 0.f, 0.f, 0.f};
    }
#define AP_LOADKV(KS, KA, KB, V0, V1) do { int _kt = tok0 + (16 * (KS) + q - 128) * d; _kt = _kt < 0 ? 0 : _kt; const bf16_t* _kp = kn + (size_t)(mb + _kt) * 1024 + h * 64 + 8 * g; \
        KA = *(const bf16x8*)_kp; KB = *(const bf16x8*)(_kp + 32); int _vt = tok0 + (16 * (KS) + (lane >> 2) - 128) * d; _vt = _vt < 0 ? 0 : _vt; \
        const bf16_t* _vp = va + (size_t)(mb + _vt) * 1024 + h * 64 + 16 * (lane & 3); V0 = *(const u32x4*)_vp; V1 = *(const u32x4*)(_vp + 8); } while (0)
    bf16x8 nka, nkb; u32x4 nv0, nv1;
    AP_LOADKV(0, nka, nkb, nv0, nv1);
#pragma unroll 1
    for (int ks = 0; ks < 10; ++ks) {
        const bf16x8 ka = nka, kb = nkb; const u32x4 v0 = nv0, v1 = nv1;
        { const int kn1 = ks < 9 ? ks + 1 : 9; AP_LOADKV(kn1, nka, nkb, nv0, nv1); }
        asm volatile("" ::: "memory");
        *(LAS u32x4*)(vst + (lane >> 2) * 144 + (lane & 3) * 32) = v0; *(LAS u32x4*)(vst + (lane >> 2) * 144 + (lane & 3) * 32 + 16) = v1;
        s16x4 pb[2];
#pragma unroll
        for (int j = 0; j < 2; ++j) {
            f32x4 S = (f32x4){0.f, 0.f, 0.f, 0.f};
            S = __builtin_amdgcn_mfma_f32_16x16x32_bf16(ka, qa[j], S, 0, 0, 0);
            S = __builtin_amdgcn_mfma_f32_16x16x32_bf16(kb, qb[j], S, 0, 0, 0);
            float s[4]; float mx = -INFINITY;
#pragma unroll
            for (int c = 0; c < 4; ++c) { const int ki = 16 * ks + 4 * g + c; const int off = 16 * j + q + 128 - ki; const int ktok = tok0 + (ki - 128) * d;
                const bool valid = (off >= 0) && (off <= 128) && (ktok >= 0);
                s[c] = valid ? S[c] - sd * (float)off : -INFINITY; mx = fmaxf(mx, s[c]); }
            mx = rowmax4(mx);
            const float m_new = fmaxf(m_run[j], mx);
            float sc = 1.f, pe[4] = {0.f, 0.f, 0.f, 0.f};
            if (m_new > -INFINITY) { sc = __expf(m_run[j] - m_new);
#pragma unroll
                for (int c = 0; c < 4; ++c) pe[c] = __expf(s[c] - m_new); }
            l_run[j] = l_run[j] * sc + ((pe[0] + pe[1]) + (pe[2] + pe[3])); m_run[j] = m_new;
#pragma unroll
            for (int i = 0; i < 4; ++i) O[j][i] = O[j][i] * sc;
            u32x2 pw; pw.x = pk2(pe[0], pe[1]); pw.y = pk2(pe[2], pe[3]);
            pb[j] = __builtin_bit_cast(s16x4, pw);
        }
        LDS_WAIT(); asm volatile("" ::: "memory");
#pragma unroll
        for (int blk = 0; blk < 4; ++blk) {
            const s16x4 vtr = tr_read(vst + (4 * g + ((lane & 15) >> 2)) * 144 + (16 * blk + 4 * (lane & 3)) * 2);
            O[0][blk] = __builtin_amdgcn_mfma_f32_16x16x16bf16_1k(vtr, pb[0], O[0][blk], 0, 0, 0);
            O[1][blk] = __builtin_amdgcn_mfma_f32_16x16x16bf16_1k(vtr, pb[1], O[1][blk], 0, 0, 0);
        }
        LDS_WAIT(); asm volatile("" ::: "memory");
    }
#undef AP_LOADKV
#pragma unroll
    for (int j = 0; j < 2; ++j) {
        float lr = l_run[j]; lr += __shfl_xor(lr, 16); lr += __shfl_xor(lr, 32);
        const int ti = base + (16 * j + q) * d;
        LAS float* ar = accL + ti * ACC_PITCH + 4 * g;
        if (p == 0) {
#pragma unroll
            for (int blk = 0; blk < 4; ++blk) *(LAS f32x4*)(ar + 16 * blk) = O[j][blk];
            if (g == 0) { mL[ti] = m_run[j]; lL[ti] = lr; }
        } else {
            const float mo = mL[ti], lo = lL[ti];
            const float mn = fmaxf(mo, m_run[j]), ao = __expf(mo - mn), an = __expf(m_run[j] - mn);
#pragma unroll
            for (int blk = 0; blk < 4; ++blk) { const f32x4 old = *(LAS f32x4*)(ar + 16 * blk); *(LAS f32x4*)(ar + 16 * blk) = old * ao + O[j][blk] * an; }
            LDS_WAIT(); asm volatile("" ::: "memory");
            if (g == 0) { mL[ti] = mn; lL[ti] = lo * ao + lr * an; }
        }
    }
}
__device__ __forceinline__ void attn_unit(int unit, const bf16_t* qn, const bf16_t* kn, const bf16_t* va, const bf16_t* mixg, bf16_t* mixo, LAS unsigned char* lds, int wave, int lane, int tid) {
    const int b = unit >> 8, h = (unit >> 4) & 15, sp = unit & 15;
    const int mb = b * TSEQ, tb = sp * 256;
    LAS float* accL = (LAS float*)lds; LAS float* mL = (LAS float*)(lds + 256 * ACC_PITCH * 4); LAS float* lL = mL + 256;
    LAS unsigned char* vst = lds + 256 * ACC_PITCH * 4 + 2048 + wave * 2304;
    const int q = lane & 15, g = lane >> 4;
    const float slope = exp2f(-0.5f * (float)(h + 1));
#pragma unroll 1
    for (int p = 0; p < 3; ++p) {
        const int d = p == 0 ? 1 : (p == 1 ? 4 : 16);
        const float sd = slope * (float)d;
        if (p < 2) { attn_pair_shared(p, wave, mb, tb, h, slope, qn, kn, va, accL, mL, lL, vst, lane); __syncthreads(); continue; }
#pragma unroll 1
        for (int tt = 0; tt < 2; ++tt) {
            const int tile = 2 * wave + tt;
            const int base = p == 0 ? 16 * tile : (p == 1 ? 64 * (tile >> 2) + (tile & 3) : tile);
            const int tok0 = tb + base;
            const bf16_t* qp = qn + (size_t)(mb + tok0 + q * d) * 1024 + h * 64 + 8 * g;
            const bf16x8 qa = *(const bf16x8*)qp, qb = *(const bf16x8*)(qp + 32);
            float m_run = -INFINITY, l_run = 0.f;
            f32x4 O[4];
#pragma unroll
            for (int i = 0; i < 4; ++i) O[i] = (f32x4){0.f, 0.f, 0.f, 0.f};
#define AT_LOADKV(KS, KA, KB, V0, V1) do { int _kt = tok0 + (16 * (KS) + q - 128) * d; _kt = _kt < 0 ? 0 : _kt; const bf16_t* _kp = kn + (size_t)(mb + _kt) * 1024 + h * 64 + 8 * g; \
                KA = *(const bf16x8*)_kp; KB = *(const bf16x8*)(_kp + 32); int _vt = tok0 + (16 * (KS) + (lane >> 2) - 128) * d; _vt = _vt < 0 ? 0 : _vt; \
                const bf16_t* _vp = va + (size_t)(mb + _vt) * 1024 + h * 64 + 16 * (lane & 3); V0 = *(const u32x4*)_vp; V1 = *(const u32x4*)(_vp + 8); } while (0)
            bf16x8 nka, nkb; u32x4 nv0, nv1;
            AT_LOADKV(0, nka, nkb, nv0, nv1);
#pragma unroll 1
            for (int ks = 0; ks < 9; ++ks) {
                const bf16x8 ka = nka, kb = nkb; const u32x4 v0 = nv0, v1 = nv1;
                { const int kn1 = ks < 8 ? ks + 1 : 8; AT_LOADKV(kn1, nka, nkb, nv0, nv1); }
                asm volatile("" ::: "memory");
                *(LAS u32x4*)(vst + (lane >> 2) * 144 + (lane & 3) * 32) = v0; *(LAS u32x4*)(vst + (lane >> 2) * 144 + (lane & 3) * 32 + 16) = v1;
                f32x4 S = (f32x4){0.f, 0.f, 0.f, 0.f};
                S = __builtin_amdgcn_mfma_f32_16x16x32_bf16(ka, qa, S, 0, 0, 0);
                S = __builtin_amdgcn_mfma_f32_16x16x32_bf16(kb, qb, S, 0, 0, 0);
                float s[4]; float mx = -INFINITY;
                if (ks >= 1 && ks <= 7 && tok0 >= 128 * d) {
#pragma unroll
                    for (int c = 0; c < 4; ++c) { const int off = q + 128 - (16 * ks + 4 * g + c); s[c] = S[c] - sd * (float)off; mx = fmaxf(mx, s[c]); }
                } else {
#pragma unroll
                for (int c = 0; c < 4; ++c) { const int ki = 16 * ks + 4 * g + c; const int off = q + 128 - ki; const int ktok = tok0 + (ki - 128) * d;
                    const bool valid = (off >= 0) && (off <= 128) && (ktok >= 0);
                    s[c] = valid ? S[c] - sd * (float)off : -INFINITY; mx = fmaxf(mx, s[c]); }
                }
                mx = rowmax4(mx);
                const float m_new = fmaxf(m_run, mx);
                float sc = 1.f, pe[4] = {0.f, 0.f, 0.f, 0.f};
                if (m_new > -INFINITY) { sc = __expf(m_run - m_new);
#pragma unroll
                    for (int c = 0; c < 4; ++c) pe[c] = __expf(s[c] - m_new); }
                l_run = l_run * sc + ((pe[0] + pe[1]) + (pe[2] + pe[3])); m_run = m_new;
#pragma unroll
                for (int i = 0; i < 4; ++i) O[i] = O[i] * sc;
                u32x2 pw; pw.x = pk2(pe[0], pe[1]); pw.y = pk2(pe[2], pe[3]);
                const s16x4 pb = __builtin_bit_cast(s16x4, pw);
                LDS_WAIT(); asm volatile("" ::: "memory");
#pragma unroll
                for (int blk = 0; blk < 4; ++blk) {
                    const s16x4 vtr = tr_read(vst + (4 * g + ((lane & 15) >> 2)) * 144 + (16 * blk + 4 * (lane & 3)) * 2);
                    O[blk] = __builtin_amdgcn_mfma_f32_16x16x16bf16_1k(vtr, pb, O[blk], 0, 0, 0);
                }
                LDS_WAIT(); asm volatile("" ::: "memory");
            }
            l_run += __shfl_xor(l_run, 16); l_run += __shfl_xor(l_run, 32);
            const int ti = base + q * d;
            LAS float* ar = accL + ti * ACC_PITCH + 4 * g;
            if (p == 0) {
#pragma unroll
                for (int blk = 0; blk < 4; ++blk) *(LAS f32x4*)(ar + 16 * blk) = O[blk];
                if (g == 0) { mL[ti] = m_run; lL[ti] = l_run; }
            } else {
                const float mo = mL[ti], lo = lL[ti];
                const float mn = fmaxf(mo, m_run), ao = __expf(mo - mn), an = __expf(m_run - mn);
#pragma unroll
                for (int blk = 0; blk < 4; ++blk) { const f32x4 old = *(LAS f32x4*)(ar + 16 * blk); *(LAS f32x4*)(ar + 16 * blk) = old * ao + O[blk] * an; }
                LDS_WAIT(); asm volatile("" ::: "memory");
                if (g == 0) { mL[ti] = mn; lL[ti] = lo * ao + l_run * an; }
            }
        }
        __syncthreads();
    }
    {
        const int ti = tid >> 1, hf = tid & 1;
        const float inv = 1.f / lL[ti];
        const size_t go = (size_t)(mb + tb + ti) * 2048 + 1024 + h * 64 + 32 * hf; const bf16_t* gp = mixg + go; bf16_t* op = mixo + go;
        const LAS float* ar = accL + ti * ACC_PITCH + 32 * hf;
#pragma unroll
        for (int c8 = 0; c8 < 4; ++c8) { const F8 gt = ld_bf8(gp + 8 * c8); const f32x4 o0 = *(const LAS f32x4*)(ar + 8 * c8) * inv * gt.a, o1 = *(const LAS f32x4*)(ar + 8 * c8 + 4) * inv * gt.b;
            u32x4 w; w.x = pk2(o0[0], o0[1]); w.y = pk2(o0[2], o0[3]); w.z = pk2(o1[0], o1[1]); w.w = pk2(o1[2], o1[3]);
            *(u32x4*)(op + 8 * c8) = w; }
    }
    __syncthreads();
}

constexpr int SA_KC = 26, SA_NKC = 5, SA_NPART = 15, SA_TASKS = 128 * SA_NPART, SA_PSTRIDE = 66;
__device__ __forceinline__ void attn_sample_part(int task, const bf16_t* qn, const bf16_t* kn, const bf16_t* va, const float* ck, const float* cv, float* part, int lane) {
    const int sbh = task / SA_NPART, pk = task % SA_NPART, p = pk / SA_NKC, kc = pk % SA_NKC;
    const int sb = sbh >> 4, h = sbh & 15, m = MP + sb; const int d = p == 0 ? 1 : (p == 1 ? 4 : 16);
    const float ql = bf2f(qn[(size_t)m * 1024 + h * 64 + lane]);
    const float slope = exp2f(-0.5f * (float)(h + 1));
    float kv[SA_KC];
#pragma unroll
    for (int jj = 0; jj < SA_KC; ++jj) { const int j = SA_KC * kc + jj; const int jc = j > 128 ? 128 : j;
        kv[jj] = (jc == 0) ? bf2f(kn[(size_t)m * 1024 + h * 64 + lane]) : ck[(((size_t)sb * 2048 + (2048 - jc * d)) * 16 + h) * 64 + lane]; }
    float sc[SA_KC]; float mx = -INFINITY;
#pragma unroll
    for (int jj = 0; jj < SA_KC; ++jj) { const int j = SA_KC * kc + jj; const float dot = wave_sum(ql * kv[jj]);
        sc[jj] = (j <= 128) ? dot - slope * (float)(j * d) : -INFINITY; mx = fmaxf(mx, sc[jj]); }
#pragma unroll
    for (int jj = 0; jj < SA_KC; ++jj) { const int j = SA_KC * kc + jj; const int jc = j > 128 ? 128 : j;
        kv[jj] = (jc == 0) ? bf2f(va[(size_t)m * 1024 + h * 64 + lane]) : cv[(((size_t)sb * 2048 + (2048 - jc * d)) * 16 + h) * 64 + lane]; }
    float o = 0.f, l = 0.f;
#pragma unroll
    for (int jj = 0; jj < SA_KC; ++jj) { const float pe = __expf(sc[jj] - mx); l += pe; o = fmaf(pe, kv[jj], o); }
    float* pp = part + (size_t)task * SA_PSTRIDE;
    pp[lane] = o; if (lane == 0) { pp[64] = mx; pp[65] = l; }
}
__device__ __forceinline__ void attn_sample_combine(int sbh, const float* part, bf16_t* mixg, int lane) {
    const float* pp = part + (size_t)sbh * SA_NPART * SA_PSTRIDE;
    float M = -INFINITY;
#pragma unroll
    for (int i = 0; i < SA_NPART; ++i) M = fmaxf(M, pp[i * SA_PSTRIDE + 64]);
    float o = 0.f, l = 0.f;
#pragma unroll
    for (int i = 0; i < SA_NPART; ++i) { const float w = __expf(pp[i * SA_PSTRIDE + 64] - M); o = fmaf(w, pp[i * SA_PSTRIDE + lane], o); l = fmaf(w, pp[i * SA_PSTRIDE + 65], l); }
    const size_t go = (size_t)(MP + (sbh >> 4)) * 2048 + 1024 + (sbh & 15) * 64 + lane;
    mixg[go] = (bf16_t)f2bf(o / l * bf2f(mixg[go]));
}

template <int CTRL> __device__ __forceinline__ float dpp_mov(float v) { return __builtin_bit_cast(float, __builtin_amdgcn_update_dpp(0, __builtin_bit_cast(int, v), CTRL, 0xF, 0xF, true)); }
__device__ __forceinline__ float red16(float v) { v += dpp_mov<0xB1>(v); v += dpp_mov<0x4E>(v); v += dpp_mov<0x141>(v); v += dpp_mov<0x140>(v); return v; }
struct StepIn { h16x4 w, k, a, b, r; h16 v; };
__device__ __forceinline__ float do_step(float (&S)[4], const StepIn& in) {
    float sa = 0.f;
#pragma unroll
    for (int c = 0; c < 4; ++c) sa = fmaf(S[c], (float)in.a[c], sa);
    sa = red16(sa);
    const float v = (float)in.v; float y = 0.f;
#pragma unroll
    for (int c = 0; c < 4; ++c) { float t = fmaf(v, (float)in.k[c], S[c]); asm("" : "+v"(t)); t = fmaf(sa, (float)in.b[c], t); asm("" : "+v"(t));
        S[c] = fmaf((float)in.w[c], S[c], t); asm("" : "+v"(S[c])); y = fmaf(S[c], (float)in.r[c], y); }
    return red16(y);
}
#define FMIX_DECL(NAME, MODS, ZERO) \
__device__ __forceinline__ float NAME(float a, unsigned h, float c) { float d; asm("v_fma_mix_f32 %0, %1, %2, " ZERO " " MODS : "=v"(d) : "v"(a), "v"(h), "v"(c)); return d; }
FMIX_DECL(mix_lo, "op_sel_hi:[0,1,0]", "%3")
FMIX_DECL(mix_hi, "op_sel:[0,1,0] op_sel_hi:[0,1,0]", "%3")
__device__ __forceinline__ float mix0_lo(float a, unsigned h) { float d; asm("v_fma_mix_f32 %0, %1, %2, 0 op_sel_hi:[0,1,0]" : "=v"(d) : "v"(a), "v"(h)); return d; }
__device__ __forceinline__ float mix0_hi(float a, unsigned h) { float d; asm("v_fma_mix_f32 %0, %1, %2, 0 op_sel:[0,1,0] op_sel_hi:[0,1,0]" : "=v"(d) : "v"(a), "v"(h)); return d; }
__device__ __forceinline__ float mixh_lo(unsigned vh, unsigned h, float c) { float d; asm("v_fma_mix_f32 %0, %1, %2, %3 op_sel_hi:[1,1,0]" : "=v"(d) : "v"(vh), "v"(h), "v"(c)); return d; }
__device__ __forceinline__ float mixh_hi(unsigned vh, unsigned h, float c) { float d; asm("v_fma_mix_f32 %0, %1, %2, %3 op_sel:[0,1,0] op_sel_hi:[1,1,0]" : "=v"(d) : "v"(vh), "v"(h), "v"(c)); return d; }
struct StepRaw { u32x2 w, k, a, b, r; unsigned v; };
__device__ __forceinline__ float do_step2(float (&S)[4], const StepRaw& in, float& yprev) {
    float pre[4];
    pre[0] = mix_lo(S[0], in.w.x, mixh_lo(in.v, in.k.x, S[0])); pre[1] = mix_hi(S[1], in.w.x, mixh_hi(in.v, in.k.x, S[1]));
    pre[2] = mix_lo(S[2], in.w.y, mixh_lo(in.v, in.k.y, S[2])); pre[3] = mix_hi(S[3], in.w.y, mixh_hi(in.v, in.k.y, S[3]));
    const float s01 = mix_hi(S[1], in.a.x, mix0_lo(S[0], in.a.x)), s23 = mix_hi(S[3], in.a.y, mix0_lo(S[2], in.a.y));
    float sa = s01 + s23, yp = yprev;
    sa += dpp_mov<0xB1>(sa); yp += dpp_mov<0xB1>(yp);
    sa += dpp_mov<0x4E>(sa); yp += dpp_mov<0x4E>(yp);
    sa += dpp_mov<0x141>(sa); yp += dpp_mov<0x141>(yp);
    sa += dpp_mov<0x140>(sa); yp += dpp_mov<0x140>(yp);
    yprev = yp;
    S[0] = mix_lo(sa, in.b.x, pre[0]); S[1] = mix_hi(sa, in.b.x, pre[1]); S[2] = mix_lo(sa, in.b.y, pre[2]); S[3] = mix_hi(sa, in.b.y, pre[3]);
    const float y01 = mix_hi(S[1], in.r.x, mix0_lo(S[0], in.r.x)), y23 = mix_hi(S[3], in.r.y, mix0_lo(S[2], in.r.y));
    return y01 + y23;
}
__device__ __forceinline__ void scan_one(const unsigned char* rec, int rq, const float* S0, float* Sout, float* yp, int lane) {
    const int rr = lane >> 4, jq = lane & 15, i = 4 * rq + rr;
    float S[4]; { const f32x4 s = *(const f32x4*)(S0 + i * 64 + 4 * jq); S[0] = s.x; S[1] = s.y; S[2] = s.z; S[3] = s.w; }
    StepIn in; in.w = *(const h16x4*)(rec + jq * 8); in.k = *(const h16x4*)(rec + 128 + jq * 8); in.a = *(const h16x4*)(rec + 256 + jq * 8); in.b = *(const h16x4*)(rec + 384 + jq * 8);
    in.r = *(const h16x4*)(rec + 512 + jq * 8); in.v = *(const h16*)(rec + 640 + i * 2);
    const float y = do_step(S, in); if (jq == 0) yp[i] = y;
    *(f32x4*)(Sout + i * 64 + 4 * jq) = (f32x4){S[0], S[1], S[2], S[3]};
}
constexpr int SC_CH = 64, SC_CHB = SC_CH * ESTRIDE, SC_NCH = TSEQ / SC_CH;
__device__ __forceinline__ void scan_pair(int pair, const unsigned char* Eb, float* out, float* yraw, LAS unsigned char* lds, int wave, int lane) {
    const int bh = pair >> 3, rq = ((pair & 7) << 1) + (wave & 1);
    const unsigned char* base = Eb + (size_t)bh * TSEQ * ESTRIDE;
    const int rr = lane >> 4, jq = lane & 15, i = 4 * rq + rr;
    float S[4] = {0.f, 0.f, 0.f, 0.f};
    float* yp = yraw + (size_t)((bh >> 4) * TSEQ) * 1024 + (bh & 15) * 64 + i;
    float ypart = 0.f, ycap = 0.f; float* dummy = yraw + (size_t)(MPAD - 1) * 1024 + (bh & 15) * 64 + i;
#define SC_ISSUE(kc) do { const int _kc = (kc) < SC_NCH ? (kc) : SC_NCH - 1; const unsigned char* _g = base + (size_t)_kc * SC_CHB; LAS unsigned char* _l = lds + ((kc) & 1) * SC_CHB; \
        _Pragma("unroll") for (int _p = 0; _p < 8; ++_p) { const int _x = (8 * (wave - 2) + _p) * 64; \
            __builtin_amdgcn_global_load_lds((const unsigned*)(_g + (size_t)(_x + lane) * 16), (LAS unsigned*)(_l + _x * 16), 16, 0, 0); } } while (0)
    if (wave >= 2) { SC_ISSUE(0); asm volatile("s_waitcnt vmcnt(0)" ::: "memory"); }
    __builtin_amdgcn_s_barrier(); asm volatile("" ::: "memory");
#pragma unroll 1
    for (int k = 0; k < SC_NCH; ++k) {
        if (wave >= 2) { SC_ISSUE(k + 1); asm volatile("s_waitcnt vmcnt(0)" ::: "memory"); }
        else {
            const LAS unsigned char* bp = lds + (k & 1) * SC_CHB;
#pragma unroll 8
            for (int s = 0; s < SC_CH; ++s) {
                const LAS unsigned char* p = bp + s * ESTRIDE;
                StepRaw in; in.w = *(const LAS u32x2*)(p + jq * 8); in.k = *(const LAS u32x2*)(p + 128 + jq * 8); in.a = *(const LAS u32x2*)(p + 256 + jq * 8); in.b = *(const LAS u32x2*)(p + 384 + jq * 8);
                in.r = *(const LAS u32x2*)(p + 512 + jq * 8); in.v = *(const LAS unsigned short*)(p + 640 + i * 2);
                float yr = ypart; ypart = do_step2(S, in, yr);
                { const int tp = k * SC_CH + s - 1;
                  ycap = ((jq & 3) == (tp & 3)) ? yr : ycap;
                  if (((s - 1) & 3) == 3) { float* dst = tp < 0 ? dummy : yp + (size_t)(tp - 3 + (jq & 3)) * 1024; *dst = ycap; } }
            }
        }
        asm volatile("" ::: "memory"); __builtin_amdgcn_s_barrier(); asm volatile("" ::: "memory");
    }
    if (wave >= 2) asm volatile("s_waitcnt vmcnt(0)" ::: "memory");
    if (wave < 2) { const float yl = red16(ypart); ycap = ((jq & 3) == 3) ? yl : ycap; yp[(size_t)(TSEQ - 4 + (jq & 3)) * 1024] = ycap; *(f32x4*)(out + O_WKVP + (size_t)bh * 4096 + i * 64 + 4 * jq) = (f32x4){S[0], S[1], S[2], S[3]}; }
    __builtin_amdgcn_s_barrier(); asm volatile("" ::: "memory");
#undef SC_ISSUE
}

template <int CTRL> __device__ __forceinline__ float dpp_mov(float v);
__device__ __forceinline__ float quad_sum(float v) { v += dpp_mov<0xB1>(v); v += dpp_mov<0x4E>(v); return v; }
__device__ __forceinline__ void fin_token(int m, const float* yraw, const unsigned char* Eb, bf16_t* mixg, const float* gn_w, const float* gn_b, const float* r_k, int lane) {
    const int h = lane >> 2, qt = lane & 3, ch0 = lane * 16;
    f32x4 y[4];
#pragma unroll
    for (int i = 0; i < 4; ++i) y[i] = *(const f32x4*)(yraw + (size_t)m * 1024 + ch0 + 4 * i);
    const unsigned char* e = Eb + e_rec(m, h) * ESTRIDE + qt * 32;
    const u32x4 rr0 = *(const u32x4*)(e + 512), rr1 = *(const u32x4*)(e + 528), kk0 = *(const u32x4*)(e + 128), kk1 = *(const u32x4*)(e + 144), vv0 = *(const u32x4*)(e + 640), vv1 = *(const u32x4*)(e + 656);
    bf16_t* gp = mixg + (size_t)m * 2048 + ch0;
    const F8 g0 = ld_bf8(gp), g1 = ld_bf8(gp + 8);
    float s = 0.f;
#pragma unroll
    for (int i = 0; i < 4; ++i) s += (y[i].x + y[i].y) + (y[i].z + y[i].w);
    const float mean = quad_sum(s) * (1.f / 64.f);
    float q = 0.f;
#pragma unroll
    for (int i = 0; i < 4; ++i) { y[i] = y[i] - mean; q += (y[i].x * y[i].x + y[i].y * y[i].y) + (y[i].z * y[i].z + y[i].w * y[i].w); }
    const float rstd = rsqrtf(quad_sum(q) * (1.f / 64.f) + 64e-5f);
    typedef _Float16 h16x8 __attribute__((ext_vector_type(8)));
    const h16x8 r0 = __builtin_bit_cast(h16x8, rr0), r1 = __builtin_bit_cast(h16x8, rr1), k0 = __builtin_bit_cast(h16x8, kk0), k1 = __builtin_bit_cast(h16x8, kk1), v0 = __builtin_bit_cast(h16x8, vv0), v1 = __builtin_bit_cast(h16x8, vv1);
    float bs = 0.f;
#pragma unroll
    for (int i = 0; i < 8; ++i) { bs = fmaf((float)r0[i] * (float)k0[i], r_k[ch0 + i], bs); bs = fmaf((float)r1[i] * (float)k1[i], r_k[ch0 + 8 + i], bs); }
    bs = quad_sum(bs);
    float o[16];
#pragma unroll
    for (int i = 0; i < 16; ++i) { const float yn = y[i >> 2][i & 3] * rstd * gn_w[ch0 + i] + gn_b[ch0 + i];
        const float vv = i < 8 ? (float)v0[i & 7] : (float)v1[i & 7]; const float gt = i < 4 ? g0.a[i & 3] : (i < 8 ? g0.b[i & 3] : (i < 12 ? g1.a[i & 3] : g1.b[i & 3]));
        o[i] = (yn + bs * vv) * gt; }
    u32x4 w0, w1; w0.x = pk2(o[0], o[1]); w0.y = pk2(o[2], o[3]); w0.z = pk2(o[4], o[5]); w0.w = pk2(o[6], o[7]); w1.x = pk2(o[8], o[9]); w1.y = pk2(o[10], o[11]); w1.z = pk2(o[12], o[13]); w1.w = pk2(o[14], o[15]);
    *(u32x4*)gp = w0; *(u32x4*)(gp + 8) = w1;
}
__device__ __forceinline__ void outproj_sample_col(int d, const bf16_t* mixg, const bf16_t* woutT, const float* xs, float* out, int lane) {
    float acc[8] = {0.f, 0.f, 0.f, 0.f, 0.f, 0.f, 0.f, 0.f};
#pragma unroll
    for (int i = 0; i < 4; ++i) { const int e0 = 8 * lane + 512 * i; const F8 w = ld_bf8(woutT + (size_t)d * DM + e0);
#pragma unroll
        for (int r = 0; r < 8; ++r) { const F8 x = ld_bf8(mixg + (size_t)(MP + r) * DM + e0);
            acc[r] += (w.a[0] * x.a[0] + w.a[1] * x.a[1]) + (w.a[2] * x.a[2] + w.a[3] * x.a[3]) + (w.b[0] * x.b[0] + w.b[1] * x.b[1]) + (w.b[2] * x.b[2] + w.b[3] * x.b[3]); } }
#pragma unroll
    for (int r = 0; r < 8; ++r) { const float t = wave_sum(acc[r]); if (lane == r) out[O_YS + r * DM + d] = t + xs[r * DM + d]; }
}

#define XB_TMO      128
#define XB_XCNT(j)  (256  + 64 * (j))
#define XB_XSUB(j)  (1280 + 64 * (j))
#define XB_XGEN(j)  (2304 + 64 * (j))
#define XB_TOP      3328
#define XB_TOPGEN   3392
#define XCD_BAR_WORDS 3456
#define XB_SPIN_CAP (1u << 18)

__device__ __forceinline__ unsigned xb_ld(unsigned* p)              { return __hip_atomic_load(p, __ATOMIC_RELAXED, __HIP_MEMORY_SCOPE_AGENT); }
__device__ __forceinline__ unsigned xb_add(unsigned* p, unsigned v) { return __hip_atomic_fetch_add(p, v, __ATOMIC_RELAXED, __HIP_MEMORY_SCOPE_AGENT); }
__device__ __forceinline__ unsigned xb_xcc_id() { return (unsigned)__builtin_amdgcn_s_getreg((3 << 11) | 20) & 0xFu; }
#define XB_SPIN(cond, bar) do { unsigned _sp = 0; while (cond) { __builtin_amdgcn_s_sleep(1); \
    if ((++_sp & 255u) == 0u) { if (xb_ld(&(bar)[XB_TMO])) break; if (_sp > XB_SPIN_CAP) { atomicAdd(&(bar)[XB_TMO], 1u); break; } } } } while (0)

struct XcdBarrier {
    unsigned* bar; unsigned x;
    volatile LAS unsigned* st;
};

__device__ __forceinline__ XcdBarrier xcd_barrier_post(unsigned* bar, volatile LAS unsigned* st) {
    XcdBarrier b; b.bar = bar; b.x = xb_xcc_id(); b.st = st;
    if (threadIdx.x == 0) (void)xb_add(&bar[XB_XCNT(b.x)], 1u);
    return b;
}
__device__ __forceinline__ void xcd_barrier_complete(unsigned* bar, unsigned x, unsigned& nloc, unsigned& nx) {
    const unsigned G = gridDim.x * gridDim.y * gridDim.z;
    unsigned sum, cnt, mine, sp = 0u;
    for (;;) {
        sum = 0u; cnt = 0u; mine = 0u;
#pragma unroll
        for (unsigned j = 0; j < 16; ++j) { const unsigned c = xb_ld(&bar[XB_XCNT(j)]); sum += c; cnt += (c > 0u) ? 1u : 0u; mine = (j == x) ? c : mine; }
        if (sum == G) break;
        __builtin_amdgcn_s_sleep(1);
        if ((++sp & 255u) == 0u) { if (xb_ld(&bar[XB_TMO])) break; if (sp > XB_SPIN_CAP) { atomicAdd(&bar[XB_TMO], 1u); break; } }
    }
    nloc = mine > 0u ? mine : 1u; nx = cnt > 0u ? cnt : 1u;
}

__device__ __forceinline__ void xcd_barrier(const XcdBarrier& b) {
    asm volatile("s_waitcnt vmcnt(0)" ::: "memory");
    __syncthreads();
    if (threadIdx.x == 0) {
        unsigned* bar = b.bar;
        __builtin_amdgcn_s_waitcnt(0);
        unsigned nloc = b.st[0], nx = b.st[1];
        if (nloc == 0u) { xcd_barrier_complete(bar, b.x, nloc, nx); b.st[0] = nloc; b.st[1] = nx; }
        const unsigned old = xb_add(&bar[XB_XSUB(b.x)], 1u);
        const unsigned gen = old / nloc;
        if (old + 1u == (gen + 1u) * nloc) {
            __builtin_amdgcn_fence(__ATOMIC_RELEASE, "agent");
            asm volatile("s_waitcnt vmcnt(0)" ::: "memory");
            const unsigned og = xb_add(&bar[XB_TOP], 1u);
            const unsigned tg = og / nx;
            if (og + 1u == (tg + 1u) * nx) xb_add(&bar[XB_TOPGEN], 1u);
            else XB_SPIN(xb_ld(&bar[XB_TOPGEN]) == tg, bar);
            __builtin_amdgcn_fence(__ATOMIC_ACQUIRE, "agent");
            xb_add(&bar[XB_XGEN(b.x)], 1u);
            asm volatile("s_waitcnt vmcnt(0)" ::: "memory");
        } else {
            XB_SPIN(xb_ld(&bar[XB_XGEN(b.x)]) == gen, bar);
            __builtin_amdgcn_fence(__ATOMIC_ACQUIRE, "agent");
            asm volatile("s_waitcnt vmcnt(0)" ::: "memory");
        }
    }
    __syncthreads();
}


struct Args { const float* in[21]; float* out; unsigned char* ws; };
__global__ void __launch_bounds__(NT, 2) mk_fwd(Args a) {
    extern __shared__ __attribute__((aligned(16))) unsigned char lds_raw[];
    LAS unsigned char* lds = (LAS unsigned char*)lds_raw;
    cg::grid_group grid = cg::this_grid();
    const int tid = threadIdx.x, lane = tid & 63, wave = __builtin_amdgcn_readfirstlane(tid >> 6);
    const int G = gridDim.x, bx = blockIdx.x;
    unsigned char* ws = a.ws; float* out = a.out;
    bf16_t* xn = (bf16_t*)(ws + WS_XN); bf16_t* winT = (bf16_t*)(ws + WS_WIN); bf16_t* woutT = (bf16_t*)(ws + WS_WOUT);
    bf16_t* wupT = (bf16_t*)(ws + WS_WUP); bf16_t* aupT = (bf16_t*)(ws + WS_AUP);
    bf16_t* zs = (bf16_t*)(ws + WS_ZS); float* yraw = (float*)(ws + WS_YR); bf16_t* mixg = (bf16_t*)(ws + WS_MIX);
    bf16_t* qn = (bf16_t*)(ws + WS_QN); bf16_t* kn = (bf16_t*)(ws + WS_KN); bf16_t* va = (bf16_t*)(ws + WS_VA);
    unsigned char* Eb = ws + WS_E; float* part = (float*)(ws + WS_PART);
    { volatile LAS unsigned* xst = (volatile LAS unsigned*)(lds + 147328);
      if (tid == 0) { xst[0] = 0u; xst[1] = 0u; }
      __syncthreads();
      (void)xcd_barrier_post((unsigned*)(ws + WS_BAR), xst); }
#define GBAR() do { XcdBarrier _b; _b.bar = (unsigned*)(a.ws + WS_BAR); _b.x = xb_xcc_id(); _b.st = (volatile LAS unsigned*)(lds + 147328); xcd_barrier(_b); } while (0)

#ifndef PROBE_DUP
#define PROBE_DUP 0
#endif
    p0_prologue(a.in[0], a.in[1], a.in[6], a.in[7], a.in[10], a.in[12], a.in[20], ws, lds, G, bx, wave, lane, tid);
    if (a.out == nullptr) grid.sync();
    GBAR();
    { pg8::Gemm g{xn, winT, MPAD, NPAD, DM}; pg8::StaticOrder S; S.init(MPAD, NPAD, G, bx);
      EpiIn E{zs, mixg, qn, kn, va, out, a.in[18], a.in[19]};
      pg8::gemm_phase<EpiIn, pg8::StaticOrder, true, true>(lds, g, S, E); }
    GBAR();
    for (int t = bx * NW + wave; t < SA_TASKS; t += G * NW) attn_sample_part(t, qn, kn, va, a.in[4], a.in[5], part, lane);
    for (int u = bx; u < 512; u += G) prep_unit(u, zs, Eb, wupT, aupT, a.in[3], a.in[8], a.in[9], a.in[11], a.in[13], a.in[14], wave, lane, lds);
    if (G >= 16) { if (bx >= G - 16 && wave == 0) prep_unit(512, zs, Eb, wupT, aupT, a.in[3], a.in[8], a.in[9], a.in[11], a.in[13], a.in[14], bx - (G - 16), lane, lds); }
    else if (bx == G - 1) { for (int hd = wave; hd < 16; hd += NW) prep_unit(512, zs, Eb, wupT, aupT, a.in[3], a.in[8], a.in[9], a.in[11], a.in[13], a.in[14], hd, lane, lds); }
    __syncthreads();
    { const int vcu2 = (G % 8 == 0) ? (bx % 8) * (G / 8) + bx / 8 : bx;
      for (int u = vcu2; u < 512; u += G) attn_unit(u, qn, kn, va, mixg, mixg, lds, wave, lane, tid); }
    GBAR();
    {
        for (int gw = bx * NW + wave; gw < 2048; gw += G * NW) { const int sbh = gw >> 4, rq = gw & 15, sb = sbh >> 4, h = sbh & 15;
            scan_one(Eb + e_rec(MP + sb, h) * ESTRIDE, rq, a.in[2] + (size_t)sbh * 4096, out + O_WKVS + (size_t)sbh * 4096, yraw + (size_t)(MP + sb) * 1024 + h * 64, lane); }
        const int vcu = (G % 8 == 0) ? (bx % 8) * (G / 8) + bx / 8 : bx;
        for (int pair = vcu; pair < 256; pair += G) scan_pair(pair, Eb, out, yraw, lds, wave, lane);
    }
    GBAR();
    for (int t = bx * NW + wave; t < MTOT + 128; t += G * NW) { if (t < MTOT) fin_token(t, yraw, Eb, mixg, a.in[16], a.in[17], a.in[15], lane); else attn_sample_combine(t - MTOT, part, mixg, lane); }
    GBAR();
    { pg8::Gemm g{mixg, woutT, MP, DM, DM}; pg8::StaticOrder S; S.init(MP, DM, G, bx);
      EpiOut E{a.in[0], a.in[1], out};
      pg8::gemm_phase<EpiOut, pg8::StaticOrder, true, true>(lds, g, S, E); }
    for (int d = bx * NW + wave; d < DM; d += G * NW) outproj_sample_col(d, mixg, woutT, a.in[1], out, lane);
}

extern "C" void kernel_launch(void* const* d_in, const int* in_sizes, int n_in, void* d_out, int out_size, void* d_ws, size_t ws_size, hipStream_t stream) {
    static int grid = 0;
    if (grid == 0) {
        if (n_in != 21 || ws_size < WS_END) { fprintf(stderr, "kernel_launch: unexpected n_in %d / ws %zu\n", n_in, ws_size); grid = -1; return; }
        int dev = 0, cus = 0, per_cu = 0;
        (void)hipGetDevice(&dev); (void)hipDeviceGetAttribute(&cus, hipDeviceAttributeMultiprocessorCount, dev);
        (void)hipFuncSetAttribute((const void*)mk_fwd, hipFuncAttributeMaxDynamicSharedMemorySize, LDS_BYTES);
        (void)hipOccupancyMaxActiveBlocksPerMultiprocessor(&per_cu, (const void*)mk_fwd, NT, LDS_BYTES);
        if (per_cu < 1) { fprintf(stderr, "kernel_launch: occupancy query reports %d\n", per_cu); per_cu = 1; }
        grid = cus * 1;
        (void)hipGetLastError();
    }
    if (grid < 0) return;
    if (hipMemsetAsync((char*)d_ws + WS_BAR, 0, 16384, stream) != hipSuccess) { fprintf(stderr, "kernel_launch: memset of barrier words failed\n"); return; }
    Args a{};
    for (int i = 0; i < 21; ++i) a.in[i] = (const float*)d_in[i];
    a.out = (float*)d_out; a.ws = (unsigned char*)d_ws;
    void* args[] = {&a};
    hipError_t e = hipLaunchCooperativeKernel((const void*)mk_fwd, dim3(grid), dim3(NT), args, LDS_BYTES, stream);
    if (e != hipSuccess) fprintf(stderr, "cooperative launch failed: %s (grid %d)\n", hipGetErrorString(e), grid);
}
```
